# Optimizing an MI355X kernel written in HIP

```python
import math
import jax, jax.numpy as jnp
from jax import lax
import numpy as np

D_MODEL = 4096
BATCH = 4
SEQ = 4096
DEPTH = 1

PLE_DIM = 256
D_FF = 11008
DIFF_HEADS = 8
DIFF_HEAD_DIM = 128
DIFF_Q_BLOCK = 128
DIL_PATTERNS = ((128, 1), (512, 4), (2048, 16))
DIL_GROUP_HEADS = 8
DIL_HEAD_DIM = 128
DIL_HALF_KEYS = 64
LN_EPS = 1e-5
SUBLN_EPS = 1e-5
NEG_INF = -1e30

DIFF_QK_W = DIFF_HEADS * 2 * DIFF_HEAD_DIM
DIFF_V_W = DIFF_HEADS * 2 * DIFF_HEAD_DIM
DIL_W = len(DIL_PATTERNS) * DIL_GROUP_HEADS * DIL_HEAD_DIM
DIL_OUT_W = DIL_GROUP_HEADS * DIL_HEAD_DIM
IN_PROJ_W = 2 * DIFF_QK_W + DIFF_V_W + 3 * DIL_W + 2 * D_MODEL

kernel_name = "hybrid_diffattn_dilated_macaron_deepnorm_layer"


def _alibi_slopes(n):
    return jnp.exp2(-8.0 * jnp.arange(1, n + 1, dtype=jnp.float32) / n)


def _layer_norm(x, g, b):
    xf = x.astype(jnp.float32)
    mu = jnp.mean(xf, axis=-1, keepdims=True)
    var = jnp.mean(jnp.square(xf - mu), axis=-1, keepdims=True)
    return ((xf - mu) * lax.rsqrt(var + LN_EPS) * g + b).astype(x.dtype)


def _swiglu(h, w_in, w_out):
    gate, up = jnp.split(h @ w_in, 2, axis=-1)
    return (jax.nn.silu(gate) * up) @ w_out


def _diff_attention(q, k, v, lam, slopes):
    B, S, H, _, dh = q.shape
    E = v.shape[-1]
    nb = S // DIFF_Q_BLOCK
    scale = dh ** -0.5
    qb = q.reshape(B, nb, DIFF_Q_BLOCK, H, 2, dh).transpose(1, 0, 2, 3, 4, 5)
    kpos = jnp.arange(S, dtype=jnp.int32)

    def block(args):
        qblk, bi = args
        s = jnp.einsum('bqhcd,bkhcd->bhcqk', qblk, k) * scale
        qpos = bi * DIFF_Q_BLOCK + jnp.arange(DIFF_Q_BLOCK, dtype=jnp.int32)
        dist = jnp.abs(qpos[:, None] - kpos[None, :]).astype(jnp.float32)
        s = s - slopes[None, :, None, None, None] * dist
        a = jax.nn.softmax(s, axis=-1)
        a = a[:, :, 0] - lam * a[:, :, 1]
        return jnp.einsum('bhqk,bkhe->bqhe', a, v)

    out = lax.map(block, (qb, jnp.arange(nb, dtype=jnp.int32)))
    return out.transpose(1, 0, 2, 3, 4).reshape(B, S, H, E)


def _dilated_window_attention(q, k, v, dil, slopes):
    B, S, H, Dh = q.shape
    L = S // dil
    W = DIL_HALF_KEYS
    nb = -(-L // W)
    Lp = nb * W
    N = B * dil

    def to_classes(t):
        return t.reshape(B, L, dil, H, Dh).transpose(0, 2, 1, 3, 4).reshape(N, L, H, Dh)

    qc = jnp.pad(to_classes(q), ((0, 0), (0, Lp - L), (0, 0), (0, 0))).reshape(N, nb, W, H, Dh)
    pad_kv = ((0, 0), (W, Lp - L + W), (0, 0), (0, 0))
    kc = jnp.pad(to_classes(k), pad_kv).reshape(N, nb + 2, W, H, Dh)
    vc = jnp.pad(to_classes(v), pad_kv).reshape(N, nb + 2, W, H, Dh)

    def band(t):
        return jnp.concatenate([t[:, :-2], t[:, 1:-1], t[:, 2:]], axis=2)

    kb, vb = band(kc), band(vc)
    s = jnp.einsum('nbqhd,nbkhd->nbhqk', qc, kb) * (Dh ** -0.5)
    rel = jnp.arange(3 * W)[None, :] - W - jnp.arange(W)[:, None]
    kidx = jnp.arange(nb)[:, None] * W + jnp.arange(3 * W)[None, :] - W
    valid = (jnp.abs(rel)[None] <= W) & ((kidx >= 0) & (kidx < L))[:, None, :]
    bias = -(slopes * dil)[:, None, None] * jnp.abs(rel).astype(jnp.float32)[None]
    s = jnp.where(valid[None, :, None], s + bias[None, None], NEG_INF)
    m = jnp.max(s, axis=-1, keepdims=True)
    e = jnp.exp(s - m)
    z = jnp.sum(e, axis=-1, keepdims=True)
    o = jnp.einsum('nbhqk,nbkhd->nbqhd', e / z, vb)
    lse = (m + jnp.log(z))[..., 0]
    o = o.reshape(B, dil, Lp, H, Dh)[:, :, :L].transpose(0, 2, 1, 3, 4).reshape(B, S, H, Dh)
    lse = lse.transpose(0, 1, 3, 2).reshape(B, dil, Lp, H)[:, :, :L].transpose(0, 2, 1, 3).reshape(B, S, H)
    return o, lse


def _hybrid_mixer(h, w_in, lam_q1, lam_k1, lam_q2, lam_k2, subln_g, w_branch_diff,
                  w_branch_dil, w_mix_out, lambda_init):
    B, S, _ = h.shape
    f32 = jnp.float32
    z = h @ w_in
    cuts = np.cumsum([DIFF_QK_W, DIFF_QK_W, DIFF_V_W, DIL_W, DIL_W, DIL_W, D_MODEL]).tolist()
    dq, dk, dv, lq, lk, lv, gate_a, gate_b = jnp.split(z, cuts, axis=-1)

    q = dq.reshape(B, S, DIFF_HEADS, 2, DIFF_HEAD_DIM).astype(f32)
    k = dk.reshape(B, S, DIFF_HEADS, 2, DIFF_HEAD_DIM).astype(f32)
    v = dv.reshape(B, S, DIFF_HEADS, 2 * DIFF_HEAD_DIM).astype(f32)
    lam = (jnp.exp(jnp.sum(lam_q1.astype(f32) * lam_k1.astype(f32)))
           - jnp.exp(jnp.sum(lam_q2.astype(f32) * lam_k2.astype(f32))) + lambda_init)
    oa = _diff_attention(q, k, v, lam, _alibi_slopes(DIFF_HEADS))
    oa = oa * lax.rsqrt(jnp.mean(jnp.square(oa), axis=-1, keepdims=True) + SUBLN_EPS)
    oa = (oa * subln_g.astype(f32) * (1.0 - lambda_init)).reshape(B, S, DIFF_V_W).astype(h.dtype)

    n_pat = len(DIL_PATTERNS)
    q = lq.reshape(B, S, n_pat, DIL_GROUP_HEADS, DIL_HEAD_DIM).astype(f32)
    k = lk.reshape(B, S, n_pat, DIL_GROUP_HEADS, DIL_HEAD_DIM).astype(f32)
    v = lv.reshape(B, S, n_pat, DIL_GROUP_HEADS, DIL_HEAD_DIM).astype(f32)
    dil_slopes = _alibi_slopes(n_pat * DIL_GROUP_HEADS).reshape(DIL_GROUP_HEADS, n_pat)
    outs, lses = [], []
    for g, (_window, dil) in enumerate(DIL_PATTERNS):
        o_g, lse_g = _dilated_window_attention(q[:, :, g], k[:, :, g], v[:, :, g], dil, dil_slopes[:, g])
        outs.append(o_g)
        lses.append(lse_g)
    wts = jax.nn.softmax(jnp.stack(lses, axis=0), axis=0)
    ob = jnp.sum(wts[..., None] * jnp.stack(outs, axis=0), axis=0)
    ob = ob.reshape(B, S, DIL_OUT_W).astype(h.dtype)

    y = jax.nn.sigmoid(gate_a) * (oa @ w_branch_diff) + jax.nn.sigmoid(gate_b) * (ob @ w_branch_dil)
    return y @ w_mix_out


def setup_inputs(seed: int = 0) -> dict:
    key = jax.random.key(seed)
    ks = jax.random.split(key, 32)
    f32 = jnp.float32
    beta = (8 * DEPTH) ** -0.25

    def nrm(k, shape, scale=1.0):
        return jax.random.normal(k, shape, f32) * scale

    col_scale = jnp.concatenate([
        jnp.ones((2 * DIFF_QK_W,), f32), jnp.full((DIFF_V_W,), beta, f32),
        jnp.ones((2 * DIL_W,), f32), jnp.full((DIL_W,), beta, f32),
        jnp.ones((2 * D_MODEL,), f32)])
    d = {}
    d["x"] = nrm(ks[0], (BATCH, SEQ, D_MODEL))
    d["p"] = nrm(ks[1], (DEPTH, BATCH, SEQ, PLE_DIM))
    d["ffn1_w_in"] = nrm(ks[2], (DEPTH, D_MODEL, 2 * D_FF), D_MODEL ** -0.5)
    d["ffn1_w_out"] = nrm(ks[3], (DEPTH, D_FF, D_MODEL), D_FF ** -0.5 * beta)
    d["ln1_g"] = 1.0 + nrm(ks[4], (DEPTH, D_MODEL), 0.02)
    d["ln1_b"] = nrm(ks[5], (DEPTH, D_MODEL), 0.02)
    d["w_in"] = nrm(ks[6], (DEPTH, D_MODEL, IN_PROJ_W), D_MODEL ** -0.5) * col_scale
    d["lam_q1"] = nrm(ks[7], (DEPTH, DIFF_HEAD_DIM), 0.1)
    d["lam_k1"] = nrm(ks[8], (DEPTH, DIFF_HEAD_DIM), 0.1)
    d["lam_q2"] = nrm(ks[9], (DEPTH, DIFF_HEAD_DIM), 0.1)
    d["lam_k2"] = nrm(ks[10], (DEPTH, DIFF_HEAD_DIM), 0.1)
    d["subln_g"] = 1.0 + nrm(ks[11], (DEPTH, 2 * DIFF_HEAD_DIM), 0.02)
    d["w_branch_diff"] = nrm(ks[12], (DEPTH, DIFF_V_W, D_MODEL), DIFF_V_W ** -0.5)
    d["w_branch_dil"] = nrm(ks[13], (DEPTH, DIL_OUT_W, D_MODEL), DIL_OUT_W ** -0.5)
    d["w_mix_out"] = nrm(ks[14], (DEPTH, D_MODEL, D_MODEL), D_MODEL ** -0.5 * beta)
    d["ln2_g"] = 1.0 + nrm(ks[15], (DEPTH, D_MODEL), 0.02)
    d["ln2_b"] = nrm(ks[16], (DEPTH, D_MODEL), 0.02)
    d["ffn2_w_in"] = nrm(ks[17], (DEPTH, D_MODEL, 2 * D_FF), D_MODEL ** -0.5)
    d["ffn2_w_out"] = nrm(ks[18], (DEPTH, D_FF, D_MODEL), D_FF ** -0.5 * beta)
    d["ln3_g"] = 1.0 + nrm(ks[19], (DEPTH, D_MODEL), 0.02)
    d["ln3_b"] = nrm(ks[20], (DEPTH, D_MODEL), 0.02)
    d["w_ple_gate"] = nrm(ks[21], (DEPTH, D_MODEL, D_MODEL), D_MODEL ** -0.5)
    d["w_ple_proj"] = nrm(ks[22], (DEPTH, PLE_DIM, D_MODEL), PLE_DIM ** -0.5 * beta)
    d["ln4_g"] = 1.0 + nrm(ks[23], (DEPTH, D_MODEL), 0.02)
    d["ln4_b"] = nrm(ks[24], (DEPTH, D_MODEL), 0.02)
    return d


def reference(x, p, ffn1_w_in, ffn1_w_out, ln1_g, ln1_b, w_in, lam_q1, lam_k1, lam_q2,
              lam_k2, subln_g, w_branch_diff, w_branch_dil, w_mix_out, ln2_g, ln2_b,
              ffn2_w_in, ffn2_w_out, ln3_g, ln3_b, w_ple_gate, w_ple_proj, ln4_g, ln4_b):
    alpha = (2 * DEPTH) ** 0.25
    h = x
    for i in range(DEPTH):
        lambda_init = 0.8 - 0.6 * math.exp(-0.3 * i)
        h = _layer_norm(alpha * h + 0.5 * _swiglu(h, ffn1_w_in[i], ffn1_w_out[i]), ln1_g[i], ln1_b[i])
        mix = _hybrid_mixer(h, w_in[i], lam_q1[i], lam_k1[i], lam_q2[i], lam_k2[i], subln_g[i],
                            w_branch_diff[i], w_branch_dil[i], w_mix_out[i], lambda_init)
        h = _layer_norm(alpha * h + mix, ln2_g[i], ln2_b[i])
        h = _layer_norm(alpha * h + 0.5 * _swiglu(h, ffn2_w_in[i], ffn2_w_out[i]), ln3_g[i], ln3_b[i])
        ple = jax.nn.sigmoid(h @ w_ple_gate[i]) * (p[i] @ w_ple_proj[i])
        h = _layer_norm(alpha * h + ple, ln4_g[i], ln4_b[i])
    return h
```

```cpp
#include <hip/hip_runtime.h>
#include <hip/hip_bf16.h>
#include <cstdio>
#include <cstdint>
namespace pg8 {
#define PG8_LAS __attribute__((address_space(3)))
typedef unsigned short bf16_t;
typedef short bf16x8 __attribute__((ext_vector_type(8)));
typedef float f32x4 __attribute__((ext_vector_type(4)));
typedef unsigned u32x4 __attribute__((ext_vector_type(4)));
constexpr int BM = 256, BK = 64, HALF = 128, HTB = HALF * BK * 2  , STAGE_BYTES = 8 * HTB, NXCD = 8, WGM = 8;

__host__ __device__ __forceinline__ int lds_byte(int r, int c) { const int st = (r >> 4) * 2 + (c >> 5), rr = r & 15, cc = c & 31, ob = rr * 64 + cc * 2; return st * 1024 + (ob ^ (((ob >> 9) & 1) << 5)); }
__host__ __device__ __forceinline__ void stage_rc(int b, int& R, int& C) { const int st = b / 1024, sb = b % 1024, swz = sb ^ (((sb >> 9) & 1) << 5); R = (st >> 1) * 16 + swz / 64; C = (st & 1) * 32 + (swz % 64) / 2; }
__host__ __device__ __forceinline__ int perm32(int rho) { const int n = rho >> 4, i = rho & 15; return 8 * (i >> 2) + 4 * n + (i & 3); }

struct Unit { int pm, pn; };
struct Gemm { const bf16_t* A; const bf16_t* Bt; int M, N, K; };

struct StaticOrder {
    int nM, nN, nwg, G, c;
    __host__ __device__ void init(int M, int N, int G_, int c_) { nM = M / BM; nN = N / BM; nwg = nM * nN; G = G_; c = c_; }
    __host__ __device__ bool next(int i, Unit& u) const {
        const long L = (long)i * G + c; if (L >= nwg) return false;
        int wgid = (int)L; { const int q = nwg / NXCD, r = nwg % NXCD, xcd = wgid % NXCD, off = wgid / NXCD; wgid = (xcd < r ? xcd * (q + 1) : r * (q + 1) + (xcd - r) * q) + off; }
        const int nig = WGM * nN, gid = wgid / nig, fm = gid * WGM, gsz = (nM - fm) < WGM ? (nM - fm) : WGM;
        u.pm = fm + ((wgid % nig) % gsz); u.pn = (wgid % nig) / gsz; return true;
    }
    __device__ __forceinline__ void a_ready(const Unit&) const {}
    __device__ __forceinline__ void done(const Unit&) const {}
};

__device__ __forceinline__ unsigned cvt_pk_bf16(float lo, float hi) { unsigned r; asm volatile("v_cvt_pk_bf16_f32 %0, %1, %2" : "=v"(r) : "v"(lo), "v"(hi)); return r; }
typedef unsigned u32x2 __attribute__((ext_vector_type(2)));
__device__ __forceinline__ float bf_lo(unsigned w) { return __uint_as_float(w << 16); }
__device__ __forceinline__ float bf_hi(unsigned w) { return __uint_as_float(w & 0xffff0000u); }
__device__ __forceinline__ float sigmoid_f(float x) { return __builtin_amdgcn_rcpf(1.0f + __builtin_amdgcn_exp2f(x * -1.4426950408889634f)); }
__device__ __forceinline__ f32x4 sigmoid4(f32x4 v) { return (f32x4){sigmoid_f(v[0]), sigmoid_f(v[1]), sigmoid_f(v[2]), sigmoid_f(v[3])}; }
__device__ __forceinline__ u32x4 pack8(f32x4 v0, f32x4 v1) { u32x4 w; w.x = cvt_pk_bf16(v0[0], v0[1]); w.y = cvt_pk_bf16(v0[2], v0[3]); w.z = cvt_pk_bf16(v1[0], v1[1]); w.w = cvt_pk_bf16(v1[2], v1[3]); return w; }

struct EpiSwiglu {
    static constexpr bool PERM = true, AFTER_DRAIN = false;
    bf16_t* O; int ldc;
    __device__ __forceinline__ void operator()(const f32x4 (&acc)[2][2][4][2], const Unit& u, int wr, int wc, int fr, int fq) const {
        const int row0 = u.pm * BM + wr * 64 + fr, col0 = u.pn * HALF + wc * 32 + 8 * fq;
#pragma unroll
        for (int ai = 0; ai < 2; ++ai)
#pragma unroll
            for (int m = 0; m < 4; ++m) { bf16_t* rowp = O + (size_t)(row0 + ai * HALF + m * 16) * ldc + col0;
                const f32x4 g0 = acc[ai][0][m][0], g1 = acc[ai][0][m][1], u0 = acc[ai][1][m][0], u1 = acc[ai][1][m][1];
                const f32x4 h0 = g0 * sigmoid4(g0) * u0, h1 = g1 * sigmoid4(g1) * u1;
                *(u32x4*)rowp = pack8(h0, h1); }
    }
};
struct EpiResid {
    static constexpr bool PERM = false, AFTER_DRAIN = false;
    const float* res; float* out; int ldc; float a, b;
    __device__ __forceinline__ void operator()(const f32x4 (&acc)[2][2][4][2], const Unit& u, int wr, int wc, int fr, int fq) const {
        const int row0 = u.pm * BM + wr * 64 + fr, col0 = u.pn * BM + wc * 32 + 4 * fq;
#pragma unroll
        for (int ai = 0; ai < 2; ++ai)
#pragma unroll
            for (int m = 0; m < 4; ++m) { const size_t off = (size_t)(row0 + ai * HALF + m * 16) * ldc + col0;
#pragma unroll
                for (int bj = 0; bj < 2; ++bj)
#pragma unroll
                    for (int n = 0; n < 2; ++n) { const f32x4 r = *(const f32x4*)(res + off + bj * HALF + n * 16); *(f32x4*)(out + off + bj * HALF + n * 16) = r * a + acc[ai][bj][m][n] * b; }
                if (m & 1) asm volatile("" ::: "memory"); }
    }
};
struct EpiInProj {
    static constexpr bool PERM = true, AFTER_DRAIN = false;
    bf16_t* QKV; bf16_t* G; float qscale;
    __device__ __forceinline__ void operator()(const f32x4 (&acc)[2][2][4][2], const Unit& u, int wr, int wc, int fr, int fq) const {
        const int row0 = u.pm * BM + wr * 64 + fr; const bool gate = u.pn >= 60;
        bf16_t* base = gate ? G : QKV; const int ldc = gate ? 8192 : 15360, colt = gate ? (u.pn - 60) * BM : u.pn * BM;
        const float sc = (u.pn < 8 || (u.pn >= 24 && u.pn < 36)) ? qscale : 1.0f;
        const int col0 = colt + wc * 32 + 8 * fq;
#pragma unroll
        for (int ai = 0; ai < 2; ++ai)
#pragma unroll
            for (int m = 0; m < 4; ++m) { bf16_t* rowp = base + (size_t)(row0 + ai * HALF + m * 16) * ldc + col0;
#pragma unroll
                for (int bj = 0; bj < 2; ++bj) { f32x4 v0 = acc[ai][bj][m][0], v1 = acc[ai][bj][m][1];
                    if (gate) { v0 = sigmoid4(v0); v1 = sigmoid4(v1); } else { v0 = v0 * sc; v1 = v1 * sc; }
                    *(u32x4*)(rowp + bj * HALF) = pack8(v0, v1); } }
    }
};
struct EpiBf16Plain {
    static constexpr bool PERM = true, AFTER_DRAIN = false;
    bf16_t* O; int ldc;
    __device__ __forceinline__ void operator()(const f32x4 (&acc)[2][2][4][2], const Unit& u, int wr, int wc, int fr, int fq) const {
        const int row0 = u.pm * BM + wr * 64 + fr, col0 = u.pn * BM + wc * 32 + 8 * fq;
#pragma unroll
        for (int ai = 0; ai < 2; ++ai)
#pragma unroll
            for (int m = 0; m < 4; ++m) { bf16_t* rowp = O + (size_t)(row0 + ai * HALF + m * 16) * ldc + col0;
#pragma unroll
                for (int bj = 0; bj < 2; ++bj) *(u32x4*)(rowp + bj * HALF) = pack8(acc[ai][bj][m][0], acc[ai][bj][m][1]); }
    }
};
struct EpiGateA {
    static constexpr bool PERM = false, AFTER_DRAIN = false;
    const bf16_t* G; float* Y1;
    __device__ __forceinline__ void operator()(const f32x4 (&acc)[2][2][4][2], const Unit& u, int wr, int wc, int fr, int fq) const {
        const int row0 = u.pm * BM + wr * 64 + fr, col0 = u.pn * BM + wc * 32 + 4 * fq;
#pragma unroll
        for (int ai = 0; ai < 2; ++ai)
#pragma unroll
            for (int m = 0; m < 4; ++m) { const size_t row = (size_t)(row0 + ai * HALF + m * 16);
#pragma unroll
                for (int bj = 0; bj < 2; ++bj)
#pragma unroll
                    for (int n = 0; n < 2; ++n) { const int c = col0 + bj * HALF + n * 16; const u32x2 gw = *(const u32x2*)(G + row * 8192 + c);
                        const f32x4 g = (f32x4){bf_lo(gw.x), bf_hi(gw.x), bf_lo(gw.y), bf_hi(gw.y)}; *(f32x4*)(Y1 + row * 4096 + c) = g * acc[ai][bj][m][n]; }
                if (m & 1) asm volatile("" ::: "memory"); }
    }
};
struct EpiGateB {
    static constexpr bool PERM = true, AFTER_DRAIN = false;
    const bf16_t* G; const float* Y1; bf16_t* Y;
    __device__ __forceinline__ void operator()(const f32x4 (&acc)[2][2][4][2], const Unit& u, int wr, int wc, int fr, int fq) const {
        const int row0 = u.pm * BM + wr * 64 + fr, col0 = u.pn * BM + wc * 32 + 8 * fq;
#pragma unroll
        for (int ai = 0; ai < 2; ++ai)
#pragma unroll
            for (int m = 0; m < 4; ++m) { const size_t row = (size_t)(row0 + ai * HALF + m * 16);
#pragma unroll
                for (int bj = 0; bj < 2; ++bj) { const int c = col0 + bj * HALF; const u32x4 gw = *(const u32x4*)(G + row * 8192 + 4096 + c);
                    const f32x4 a0 = *(const f32x4*)(Y1 + row * 4096 + c), a1 = *(const f32x4*)(Y1 + row * 4096 + c + 4);
                    const f32x4 g0 = (f32x4){bf_lo(gw.x), bf_hi(gw.x), bf_lo(gw.y), bf_hi(gw.y)}, g1 = (f32x4){bf_lo(gw.z), bf_hi(gw.z), bf_lo(gw.w), bf_hi(gw.w)};
                    *(u32x4*)(Y + row * 4096 + c) = pack8(a0 + g0 * acc[ai][bj][m][0], a1 + g1 * acc[ai][bj][m][1]); }
                if (m & 1) asm volatile("" ::: "memory"); }
    }
};
struct EpiPle {
    static constexpr bool PERM = false, AFTER_DRAIN = false;
    const float* res; float* out; const bf16_t* PP; float a;
    __device__ __forceinline__ void operator()(const f32x4 (&acc)[2][2][4][2], const Unit& u, int wr, int wc, int fr, int fq) const {
        const int row0 = u.pm * BM + wr * 64 + fr, col0 = u.pn * BM + wc * 32 + 4 * fq;
#pragma unroll
        for (int ai = 0; ai < 2; ++ai)
#pragma unroll
            for (int m = 0; m < 4; ++m) { const size_t off = (size_t)(row0 + ai * HALF + m * 16) * 4096 + col0;
#pragma unroll
                for (int bj = 0; bj < 2; ++bj)
#pragma unroll
                    for (int n = 0; n < 2; ++n) { const size_t o = off + bj * HALF + n * 16; const u32x2 pw = *(const u32x2*)(PP + o); const f32x4 r = *(const f32x4*)(res + o);
                        const f32x4 p = (f32x4){bf_lo(pw.x), bf_hi(pw.x), bf_lo(pw.y), bf_hi(pw.y)}; *(f32x4*)(out + o) = r * a + sigmoid4(acc[ai][bj][m][n]) * p; }
                if (m & 1) asm volatile("" ::: "memory"); }
    }
};

template <class Epi, class Sched, bool ALIGN_EPI = false, bool SP2 = false>
__device__ __forceinline__ void gemm_phase(PG8_LAS unsigned char* lds, const Gemm g, const Sched& S, const Epi& E) {
    int tid_ = threadIdx.x; asm volatile("" : "+v"(tid_));
    const int tid = tid_, wid = __builtin_amdgcn_readfirstlane(tid >> 6), lane = tid & 63, wr = wid >> 2, wc = wid & 3, fr = lane & 15, fq = lane >> 4;
    const int K = g.K, nt = K / BK;
    unsigned voffA[2], voffB[2];
#pragma unroll
    for (int i = 0; i < 2; ++i) { int R, C; stage_rc(tid * 16 + i * 8192, R, C); const int Rb = Epi::PERM ? ((R & ~31) + perm32(R & 31)) : R;
        voffA[i] = (unsigned)(R * K + C) * 2u; voffB[i] = (unsigned)(Rb * K + C) * 2u; }
    const size_t kstep = (size_t)(BK * 2);
    const size_t hstep = (size_t)HALF * K * 2;
    const size_t tstep = 2 * hstep;
    const unsigned ldsw = (unsigned)wid * 1024u;
    const int aoff = lds_byte(wr * 64 + fr, fq * 8), boff = lds_byte(wc * 32 + fr, fq * 8);
#define PG8_SA(b, h) (((b) * 2 + (h)) * HTB)
#define PG8_SB(b, h) ((4 + (b) * 2 + (h)) * HTB)
#define PG8_STAGE(bufoff, gbase, voff) do { _Pragma("unroll") for (int _i = 0; _i < 2; ++_i) \
        __builtin_amdgcn_global_load_lds((const unsigned*)((const char*)(gbase) + (voff)[_i]), (PG8_LAS unsigned*)(lds + (bufoff) + ldsw + _i * 8192), 16, 0, 0); } while (0)
#define PG8_LDA(dst, b, h) do { _Pragma("unroll") for (int m = 0; m < 4; ++m) _Pragma("unroll") for (int k = 0; k < 2; ++k) dst[m][k] = *(const PG8_LAS bf16x8*)(lds + PG8_SA(b, h) + aoff + m * 2048 + k * 1024); } while (0)
#define PG8_LDB(dst, b, h) do { _Pragma("unroll") for (int n = 0; n < 2; ++n) _Pragma("unroll") for (int k = 0; k < 2; ++k) dst[n][k] = *(const PG8_LAS bf16x8*)(lds + PG8_SB(b, h) + boff + n * 2048 + k * 1024); } while (0)
#define PG8_MMA(ai, bj, At, Bt) do { __builtin_amdgcn_s_setprio(1); _Pragma("unroll") for (int m = 0; m < 4; ++m) _Pragma("unroll") for (int n = 0; n < 2; ++n) _Pragma("unroll") for (int k = 0; k < 2; ++k) \
        acc[ai][bj][m][n] = __builtin_amdgcn_mfma_f32_16x16x32_bf16(Bt[n][k], At[m][k], acc[ai][bj][m][n], 0, 0, 0); __builtin_amdgcn_s_setprio(0); } while (0)
#define PG8_WAIT_V(n) asm volatile("s_waitcnt vmcnt(" #n ")" ::: "memory")
#define PG8_WAIT_L(n) asm volatile("s_waitcnt lgkmcnt(" #n ")" ::: "memory")
#define PG8_BAR __builtin_amdgcn_s_barrier()
#define PG8_SCHED __builtin_amdgcn_sched_barrier(0)
    Unit cur, nxt; int ui = 0;
    if (!S.next(0, cur)) return;
    f32x4 acc[2][2][4][2];
#pragma unroll
    for (int a = 0; a < 2; ++a)
#pragma unroll
        for (int b = 0; b < 2; ++b)
#pragma unroll
            for (int m = 0; m < 4; ++m)
#pragma unroll
                for (int n = 0; n < 2; ++n) acc[a][b][m][n] = (f32x4){0.f, 0.f, 0.f, 0.f};
    bf16x8 At[4][2], B0[2][2], B1[2][2];
    const char* cA = (const char*)g.A + (size_t)cur.pm * tstep; const char* cB = (const char*)g.Bt + (size_t)cur.pn * tstep;
    S.a_ready(cur);
    if constexpr (SP2) {
        PG8_STAGE(PG8_SB(0, 0), cB, voffB); PG8_STAGE(PG8_SB(0, 1), cB + hstep, voffB); PG8_STAGE(PG8_SA(0, 0), cA, voffA); PG8_STAGE(PG8_SA(0, 1), cA + hstep, voffA);
        if (wr == 1) PG8_BAR;
        PG8_WAIT_V(2); PG8_BAR;
        PG8_STAGE(PG8_SB(1, 0), cB + kstep, voffB); PG8_STAGE(PG8_SA(1, 0), cA + kstep, voffA); PG8_STAGE(PG8_SB(1, 1), cB + hstep + kstep, voffB);
        PG8_WAIT_V(6); PG8_BAR;
    } else {
        PG8_STAGE(PG8_SB(0, 0), cB, voffB); PG8_STAGE(PG8_SA(0, 0), cA, voffA); PG8_STAGE(PG8_SB(0, 1), cB + hstep, voffB); PG8_STAGE(PG8_SA(0, 1), cA + hstep, voffA);
        if (wr == 1) PG8_BAR;
        PG8_WAIT_V(4); PG8_BAR;
        PG8_STAGE(PG8_SB(1, 0), cB + kstep, voffB); PG8_STAGE(PG8_SA(1, 0), cA + kstep, voffA); PG8_STAGE(PG8_SB(1, 1), cB + hstep + kstep, voffB);
        PG8_WAIT_V(6); PG8_BAR;
    }
    for (;;) {
        const bool has_next = S.next(ui + 1, nxt);
        const char* nA = has_next ? (const char*)g.A + (size_t)nxt.pm * tstep : cA; const char* nB = has_next ? (const char*)g.Bt + (size_t)nxt.pn * tstep : cB;
        for (int t = 0; t < nt; t += 2) {
            const bool last = (t == nt - 2);
            const char* a1 = cA + (size_t)(t + 1) * kstep;
            const char* a2 = last ? nA : cA + (size_t)(t + 2) * kstep; const char* b2 = last ? nB : cB + (size_t)(t + 2) * kstep;
            const char* a3 = a2 + kstep; const char* b3 = b2 + kstep;
            if (last && has_next) S.a_ready(nxt);
            if constexpr (SP2) {
            PG8_LDB(B0, 0, 0); PG8_LDB(B1, 0, 1); PG8_SCHED; PG8_LDA(At, 0, 0); PG8_STAGE(PG8_SA(1, 1), a1 + hstep, voffA);
            PG8_WAIT_V(8); PG8_WAIT_L(0); PG8_BAR; PG8_MMA(0, 0, At, B0); PG8_MMA(0, 1, At, B1); PG8_BAR; PG8_SCHED;
            PG8_LDA(At, 0, 1); PG8_STAGE(PG8_SB(0, 0), b2, voffB); PG8_STAGE(PG8_SB(0, 1), b2 + hstep, voffB); PG8_STAGE(PG8_SA(0, 0), a2, voffA);
            PG8_WAIT_V(8); PG8_WAIT_L(0); PG8_BAR; PG8_MMA(1, 0, At, B0); PG8_MMA(1, 1, At, B1); PG8_BAR; PG8_SCHED;
            PG8_LDB(B0, 1, 0); PG8_LDB(B1, 1, 1); PG8_SCHED; PG8_LDA(At, 1, 0); PG8_STAGE(PG8_SA(0, 1), a2 + hstep, voffA);
            PG8_WAIT_V(8); PG8_WAIT_L(0); PG8_BAR; PG8_MMA(0, 0, At, B0); PG8_MMA(0, 1, At, B1); PG8_BAR; PG8_SCHED;
            PG8_LDA(At, 1, 1); PG8_STAGE(PG8_SB(1, 0), b3, voffB); PG8_STAGE(PG8_SB(1, 1), b3 + hstep, voffB); PG8_STAGE(PG8_SA(1, 0), a3, voffA);
            PG8_WAIT_V(8); PG8_WAIT_L(0); PG8_BAR; PG8_MMA(1, 0, At, B0); PG8_MMA(1, 1, At, B1); PG8_BAR; PG8_SCHED;
            } else {
            PG8_LDB(B0, 0, 0); PG8_SCHED; PG8_LDA(At, 0, 0); PG8_STAGE(PG8_SA(1, 1), a1 + hstep, voffA);
            PG8_WAIT_L(8); PG8_BAR; PG8_WAIT_L(0); PG8_MMA(0, 0, At, B0); PG8_BAR; PG8_SCHED;
            PG8_LDB(B1, 0, 1); PG8_STAGE(PG8_SB(0, 0), b2, voffB);
            PG8_BAR; PG8_WAIT_L(0); PG8_MMA(0, 1, At, B1); PG8_BAR;
            PG8_LDA(At, 0, 1); PG8_STAGE(PG8_SA(0, 0), a2, voffA);
            PG8_BAR; PG8_WAIT_L(0); PG8_MMA(1, 0, At, B0); PG8_BAR; PG8_SCHED;
            PG8_STAGE(PG8_SB(0, 1), b2 + hstep, voffB);
            PG8_WAIT_V(6); PG8_BAR; PG8_MMA(1, 1, At, B1); PG8_BAR;
            PG8_LDB(B0, 1, 0); PG8_SCHED; PG8_LDA(At, 1, 0); PG8_STAGE(PG8_SA(0, 1), a2 + hstep, voffA);
            PG8_WAIT_L(8); PG8_BAR; PG8_WAIT_L(0); PG8_MMA(0, 0, At, B0); PG8_BAR; PG8_SCHED;
            PG8_LDB(B1, 1, 1); PG8_STAGE(PG8_SB(1, 0), b3, voffB);
            PG8_BAR; PG8_WAIT_L(0); PG8_MMA(0, 1, At, B1); PG8_BAR;
            PG8_LDA(At, 1, 1); PG8_STAGE(PG8_SA(1, 0), a3, voffA);
            PG8_BAR; PG8_WAIT_L(0); PG8_MMA(1, 0, At, B0); PG8_BAR; PG8_SCHED;
            PG8_STAGE(PG8_SB(1, 1), b3 + hstep, voffB);
            PG8_WAIT_V(6); PG8_BAR; PG8_MMA(1, 1, At, B1); PG8_BAR;
            }
        }
        if constexpr (ALIGN_EPI) { if (wr == 0) PG8_BAR; }
        if constexpr (!Epi::AFTER_DRAIN) { E(acc, cur, wr, wc, fr, fq); S.done(cur); }
        if (!has_next) break;
#pragma unroll
        for (int a = 0; a < 2; ++a)
#pragma unroll
            for (int b = 0; b < 2; ++b)
#pragma unroll
                for (int m = 0; m < 4; ++m)
#pragma unroll
                    for (int n = 0; n < 2; ++n) acc[a][b][m][n] = (f32x4){0.f, 0.f, 0.f, 0.f};
        cur = nxt; cA = nA; cB = nB; ++ui;
        if constexpr (ALIGN_EPI) { if (wr == 1) PG8_BAR; }
    }
    PG8_WAIT_V(0);
    if constexpr (!ALIGN_EPI) { if (wr == 0) PG8_BAR; }
    PG8_BAR;
    if constexpr (Epi::AFTER_DRAIN) { E.fused(acc, cur, wr, wc, fr, fq, lds, wid, lane); S.done(cur); }
#undef PG8_SA
#undef PG8_SB
#undef PG8_STAGE
#undef PG8_LDA
#undef PG8_LDB
#undef PG8_MMA
#undef PG8_WAIT_V
#undef PG8_WAIT_L
#undef PG8_BAR
#undef PG8_SCHED
}
}
namespace att {
using bf16 = __hip_bfloat16;
using bf16x8 = __attribute__((ext_vector_type(8))) short;
using s16x4  = __attribute__((ext_vector_type(4))) short;
using f32x16 = __attribute__((ext_vector_type(16))) float;
using u32x4  = __attribute__((ext_vector_type(4))) unsigned;
constexpr int NW = 8, QBLK = 32, KVBLK = 64;
constexpr size_t SHM_V = KVBLK * 128 * 2, SHM_K = KVBLK * 128 * 2, SHM_ATTN = 2 * SHM_V + 2 * SHM_K + NW * 64 * 4;
constexpr float THR2 = 11.5f;
#define KSWZ(row, colB) ((row) * 256 + ((colB) ^ (((row) & 7) << 4)))
#define SBAR() __builtin_amdgcn_sched_barrier(0)
__device__ __forceinline__ int crow(int r, int hi) { return (r & 3) + 8 * (r >> 2) + 4 * hi; }
__device__ __forceinline__ unsigned cvtpk(float lo, float hi) { unsigned r; asm volatile("v_cvt_pk_bf16_f32 %0, %1, %2" : "=v"(r) : "v"(lo), "v"(hi)); return r; }

template <int MODE>
__device__ __forceinline__ void partialSM(f32x16& p0, f32x16& p1, float& m_reg, float& mn, float& alpha, float di, float sl2) {
#pragma unroll
  for (int r = 0; r < 16; ++r) { const float a0 = fabsf(di - (float)((r & 3) + 8 * (r >> 2))), a1 = fabsf(di - (float)(32 + (r & 3) + 8 * (r >> 2)));
    if (MODE == 0) { p0[r] = fmaf(-sl2, a0, p0[r]); p1[r] = fmaf(-sl2, a1, p1[r]); }
    else { p0[r] = a0 <= 64.f ? fmaf(-sl2, a0, p0[r]) : -1e30f; p1[r] = a1 <= 64.f ? fmaf(-sl2, a1, p1[r]) : -1e30f; } }
  float pmax = p0[0];
#pragma unroll
  for (int r = 1; r < 16; ++r) pmax = fmaxf(pmax, p0[r]);
#pragma unroll
  for (int r = 0; r < 16; ++r) pmax = fmaxf(pmax, p1[r]);
  { auto rr = __builtin_amdgcn_permlane32_swap(__float_as_uint(pmax), __float_as_uint(pmax), false, false);
    pmax = fmaxf(__uint_as_float(rr[0]), __uint_as_float(rr[1])); }
  if (__builtin_expect(__all(pmax - m_reg <= THR2), 1)) { mn = m_reg; alpha = 1.f; }
  else { mn = fmaxf(m_reg, pmax); alpha = __builtin_amdgcn_exp2f(m_reg - mn); m_reg = mn; }
#pragma unroll
  for (int r = 0; r < 16; ++r) p0[r] = p0[r] - mn;
#pragma unroll
  for (int r = 0; r < 16; ++r) p1[r] = p1[r] - mn;
#pragma unroll
  for (int r = 0; r < 16; ++r) p0[r] = __builtin_amdgcn_exp2f(p0[r]);
}
__device__ __forceinline__ void finishSM(f32x16& p0, f32x16& p1, float alpha, float& l_reg, bf16x8& pa0, bf16x8& pa1, bf16x8& pa2, bf16x8& pa3) {
#pragma unroll
  for (int r = 0; r < 16; ++r) p1[r] = __builtin_amdgcn_exp2f(p1[r]);
  float ps = 0;
#pragma unroll
  for (int r = 0; r < 16; ++r) ps += p0[r];
#pragma unroll
  for (int r = 0; r < 16; ++r) ps += p1[r];
  { auto rr = __builtin_amdgcn_permlane32_swap(__float_as_uint(ps), __float_as_uint(ps), false, false);
    ps = __uint_as_float(rr[0]) + __uint_as_float(rr[1]); }
  l_reg = l_reg * alpha + ps;
#define PK4(P, BASE, OUT) do { unsigned a0 = cvtpk(P[BASE + 0], P[BASE + 1]), a1 = cvtpk(P[BASE + 2], P[BASE + 3]);   \
    unsigned b0 = cvtpk(P[BASE + 4], P[BASE + 5]), b1 = cvtpk(P[BASE + 6], P[BASE + 7]);                              \
    auto r0 = __builtin_amdgcn_permlane32_swap(a0, b0, false, false); auto r1 = __builtin_amdgcn_permlane32_swap(a1, b1, false, false); \
    u32x4 w = {r0[0], r1[0], r0[1], r1[1]}; OUT = *reinterpret_cast<bf16x8*>(&w); } while (0)
  PK4(p0, 0, pa0); PK4(p0, 8, pa1); PK4(p1, 0, pa2); PK4(p1, 8, pa3);
#undef PK4
}
__device__ __forceinline__ void qkt(f32x16& p0, f32x16& p1, const bf16* Ks, const bf16x8* qr, int r32, int hi) {
  p0 = f32x16{}; p1 = f32x16{};
#pragma unroll
  for (int d0 = 0; d0 < 8; ++d0) { int cb = (d0 * 16 + hi * 8) * 2;
    bf16x8 b0 = *reinterpret_cast<const bf16x8*>((const char*)Ks + KSWZ(r32, cb));
    bf16x8 b1 = *reinterpret_cast<const bf16x8*>((const char*)Ks + KSWZ(32 + r32, cb));
    p0 = __builtin_amdgcn_mfma_f32_32x32x16_bf16(b0, qr[d0], p0, 0, 0, 0);
    p1 = __builtin_amdgcn_mfma_f32_32x32x16_bf16(b1, qr[d0], p1, 0, 0, 0); }
}
__device__ __forceinline__ int v_st(int k, int c) { const int kk = (k & ~0xC) | ((k & 4) << 1) | ((k & 8) >> 1); return ((kk >> 3) * 4 + (c >> 5)) * 512 + ((kk & 7) * 32 + (c & 31)) * 2; }
__device__ __forceinline__ int v_rd_base(int lane) { return ((lane & 3) << 3) | (((lane >> 2) & 3) << 6) | (((lane >> 4) & 1) << 5) | (((lane >> 5) & 1) << 8); }
constexpr int v_rd_off(int d0, int ks, int half) { return d0 * 512 + ks * 4096 + half * 2048; }
template <int OFF> __device__ __forceinline__ s16x4 tr_read(int vb) {
  s16x4 r; asm volatile("ds_read_b64_tr_b16 %0, %1 offset:%2" : "=&v"(r) : "v"(vb), "i"(OFF) : "memory"); return r;
}
template <int D0> __device__ __forceinline__ void pv_one(f32x16& od, int vb, bf16x8 pa0, bf16x8 pa1, bf16x8 pa2, bf16x8 pa3) {
  const s16x4 l0 = tr_read<v_rd_off(D0, 0, 0)>(vb), h0 = tr_read<v_rd_off(D0, 0, 1)>(vb), l1 = tr_read<v_rd_off(D0, 1, 0)>(vb), h1 = tr_read<v_rd_off(D0, 1, 1)>(vb);
  const s16x4 l2 = tr_read<v_rd_off(D0, 2, 0)>(vb), h2 = tr_read<v_rd_off(D0, 2, 1)>(vb), l3 = tr_read<v_rd_off(D0, 3, 0)>(vb), h3 = tr_read<v_rd_off(D0, 3, 1)>(vb);
  asm volatile("s_waitcnt lgkmcnt(0)" ::: "memory"); SBAR();
#define PK(L, H) (bf16x8){L[0], L[1], L[2], L[3], H[0], H[1], H[2], H[3]}
  od = __builtin_amdgcn_mfma_f32_32x32x16_bf16(pa0, PK(l0, h0), od, 0, 0, 0);
  od = __builtin_amdgcn_mfma_f32_32x32x16_bf16(pa1, PK(l1, h1), od, 0, 0, 0);
  od = __builtin_amdgcn_mfma_f32_32x32x16_bf16(pa2, PK(l2, h2), od, 0, 0, 0);
  od = __builtin_amdgcn_mfma_f32_32x32x16_bf16(pa3, PK(l3, h3), od, 0, 0, 0);
#undef PK
}
__device__ __forceinline__ void pv_d0(f32x16* o, int vb, bf16x8 pa0, bf16x8 pa1, bf16x8 pa2, bf16x8 pa3) {
  pv_one<0>(o[0], vb, pa0, pa1, pa2, pa3); pv_one<1>(o[1], vb, pa0, pa1, pa2, pa3); pv_one<2>(o[2], vb, pa0, pa1, pa2, pa3); pv_one<3>(o[3], vb, pa0, pa1, pa2, pa3);
}

template <int MODE>
__device__ __forceinline__ void attn_core(const bf16* __restrict__ Qb, long ldq, const bf16* __restrict__ Kh, const bf16* __restrict__ Vh, long ldk, int NT, int t0, int tmax,
                                          float dq, float sl2, char* lds, f32x16 (&o)[4], float& m_reg, float& l_reg) {
  int tid_ = threadIdx.x; asm volatile("" : "+v"(tid_), "+v"(dq));
  const int tid = tid_, wid = tid >> 6, lane = tid & 63, r32 = lane & 31, hi = lane >> 5;
  bf16* V_lds = (bf16*)lds; bf16* K_lds = (bf16*)(lds + 2 * SHM_V);
  float* ws = (float*)(lds + 2 * SHM_V + 2 * SHM_K) + wid * 64; float* al_l = ws + 32;
  m_reg = -1e30f; l_reg = 0.f;
#pragma unroll
  for (int d = 0; d < 4; ++d) o[d] = f32x16{};
  bf16x8 qr[8];
  const bf16* Qw = Qb + (long)(wid * QBLK + r32) * ldq + hi * 8;
#pragma unroll
  for (int d0 = 0; d0 < 8; ++d0) qr[d0] = *reinterpret_cast<const bf16x8*>(Qw + d0 * 16);
  const int sr = tid >> 4, sc = (tid & 15) * 8, vst0 = v_st(sr, sc), vst1 = v_st(32 + sr, sc);
  const int vb0 = (int)(uintptr_t)V_lds + v_rd_base(lane);
  struct { bf16x8 vs0, vs1, ks0, ks1; } sr_[2];
#define TILEK0(jt) ((MODE == 1) ? 64 * min(max(t0 + (jt), 0), tmax - 1) : 64 * (t0 + (jt)))
#define TILEDI(jt) ((MODE == 1 && ((t0 + (jt)) < 0 || (t0 + (jt)) >= tmax)) ? 1e9f : (dq - 64.f * (float)(jt)))
#define SLOAD(i, jt) do { const long k0_ = TILEK0(jt); sr_[i].vs0 = *reinterpret_cast<const bf16x8*>(&Vh[(k0_ + sr) * ldk + sc]); sr_[i].vs1 = *reinterpret_cast<const bf16x8*>(&Vh[(k0_ + 32 + sr) * ldk + sc]); \
    sr_[i].ks0 = *reinterpret_cast<const bf16x8*>(&Kh[(k0_ + sr) * ldk + sc]); sr_[i].ks1 = *reinterpret_cast<const bf16x8*>(&Kh[(k0_ + 32 + sr) * ldk + sc]); } while (0)
#define SWRITE(b, i) do { *(bf16x8*)((char*)V_lds + (b) * SHM_V + vst0) = sr_[i].vs0;          \
    *(bf16x8*)((char*)V_lds + (b) * SHM_V + vst1) = sr_[i].vs1; int kc = sc * 2;               \
    *(bf16x8*)((char*)K_lds + (b) * SHM_K + KSWZ(sr, kc)) = sr_[i].ks0;                       \
    *(bf16x8*)((char*)K_lds + (b) * SHM_K + KSWZ(32 + sr, kc)) = sr_[i].ks1; } while (0)
#define SWAIT() asm volatile("s_waitcnt vmcnt(4)" ::: "memory")
#define RESC(a) do { if (__any((a) < 1.f)) { if (hi == 0) al_l[r32] = (a); asm volatile("s_waitcnt lgkmcnt(0)" ::: "memory"); \
    _Pragma("unroll") for (int d = 0; d < 4; ++d) _Pragma("unroll") for (int r = 0; r < 16; ++r) o[d][r] *= al_l[crow(r, hi)]; } } while (0)
  f32x16 pA0, pA1, pB0, pB1; float mnA, mnB, alA, alB; bf16x8 pa0, pa1, pa2, pa3;
  constexpr int SE = 0, SO = 1;
  SLOAD(SE, 0); asm volatile("s_waitcnt vmcnt(0)" ::: "memory"); SWRITE(0, SE); __syncthreads();
  qkt(pA0, pA1, K_lds, qr, r32, hi); partialSM<MODE>(pA0, pA1, m_reg, mnA, alA, TILEDI(0), sl2);
  SLOAD(SO, 1); if (2 < NT) SLOAD(SE, 2);
  SWAIT(); SWRITE(1, SO); __syncthreads();
  for (int j = 1; j + 1 < NT; j += 2) {
    SBAR(); qkt(pB0, pB1, (bf16*)((char*)K_lds + SHM_K), qr, r32, hi);
    finishSM(pA0, pA1, alA, l_reg, pa0, pa1, pa2, pa3); SBAR();
    SLOAD(SO, j + 2); SBAR();
    pv_d0(o, vb0, pa0, pa1, pa2, pa3); partialSM<MODE>(pB0, pB1, m_reg, mnB, alB, TILEDI(j), sl2);
    __syncthreads(); SWAIT(); SWRITE(0, SE);
    RESC(alB); __syncthreads();
    SBAR(); qkt(pA0, pA1, K_lds, qr, r32, hi);
    finishSM(pB0, pB1, alB, l_reg, pa0, pa1, pa2, pa3); SBAR();
    if (j + 3 < NT) SLOAD(SE, j + 3); SBAR();
    pv_d0(o, vb0 + (int)SHM_V, pa0, pa1, pa2, pa3); partialSM<MODE>(pA0, pA1, m_reg, mnA, alA, TILEDI(j + 1), sl2);
    __syncthreads(); SWAIT(); SWRITE(1, SO);
    RESC(alA); __syncthreads();
  }
  SBAR(); qkt(pB0, pB1, (bf16*)((char*)K_lds + SHM_K), qr, r32, hi);
  finishSM(pA0, pA1, alA, l_reg, pa0, pa1, pa2, pa3); SBAR();
  pv_d0(o, vb0, pa0, pa1, pa2, pa3); partialSM<MODE>(pB0, pB1, m_reg, mnB, alB, TILEDI(NT - 1), sl2);
  __syncthreads(); RESC(alB);
  finishSM(pB0, pB1, alB, l_reg, pa0, pa1, pa2, pa3); SBAR();
  pv_d0(o, vb0 + (int)SHM_V, pa0, pa1, pa2, pa3);
  asm volatile("s_waitcnt vmcnt(0)" ::: "memory");
#undef TILEK0
#undef TILEDI
#undef SLOAD
#undef SWRITE
#undef SWAIT
#undef RESC
}
}

#ifndef PG8_SP2
#define PG8_SP2 true
#endif
#ifndef PG8_ALIGN
#define PG8_ALIGN true
#endif
constexpr int NWAVES = 8;
constexpr int BATCH = 4, SEQ = 4096, DM = 4096, FF = 11008, M = BATCH * SEQ;
constexpr int NIN = 23552, NQKV = 15360, NGATE = 8192, PLE = 256;
constexpr float LN_EPS = 1e-5f, SUBLN_EPS = 1e-5f;
constexpr float ALPHA = 1.189207115002721f;
constexpr float LAMBDA_INIT = 0.2f;
constexpr float QSCALE = 0.08838834764831845f * 1.4426950408889634f;
constexpr float LOG2E = 1.4426950408889634f;

constexpr size_t MiB = 1u << 20;
constexpr size_t WS_CTL = 0, CTL_ZERO_BYTES = 1 * MiB;
constexpr size_t WS_W1IN = 1 * MiB, WS_W1OUT = WS_W1IN + 172 * MiB;
constexpr size_t WS_GATES = WS_W1IN;
constexpr size_t WS_WIN = WS_W1OUT + 86 * MiB;
constexpr size_t WS_WA = WS_WIN + 184 * MiB, WS_WB = WS_WA + 16 * MiB, WS_WOUT = WS_WB + 8 * MiB;
constexpr size_t WS_W2IN = WS_WOUT + 32 * MiB, WS_W2OUT = WS_W2IN + 172 * MiB;
constexpr size_t WS_WG = WS_W2OUT + 86 * MiB, WS_WP = WS_WG + 32 * MiB;
constexpr size_t WS_HB = WS_WP + 2 * MiB;
constexpr size_t WS_BIG = WS_HB + 128 * MiB;
constexpr size_t WS_Y1 = WS_BIG, WS_Y = WS_BIG + 256 * MiB;
constexpr size_t WS_OA = WS_BIG + 480 * MiB;
constexpr size_t WS_OB = WS_OA + 64 * MiB;
constexpr size_t WS_DILP = WS_OB + 32 * MiB;
constexpr size_t WS_LSE = WS_DILP + 96 * MiB;
constexpr size_t WS_SCR = WS_LSE + 2 * MiB;
constexpr size_t WS_PB = WS_SCR + 64 * MiB;
constexpr size_t WS_PP = WS_PB + 8 * MiB;
constexpr size_t WS_END = WS_PP + 128 * MiB;
static_assert(WS_GATES + (size_t)M * NGATE * 2 <= WS_WIN, "gates overlay fits in the FFN1 weight region");
static_assert((size_t)M * NQKV * 2 <= 480 * MiB && (size_t)M * FF * 2 <= 480 * MiB, "BIG region");
constexpr int CW_BAR = 4096;

constexpr int RING_OFF = 0, RING_BYTES = 131072;
constexpr int LDSCTL_OFF = RING_BYTES, MISC_OFF = LDSCTL_OFF + 320;
constexpr int LDS_BYTES = 147456;
constexpr int ATT_STASH_OFF = 69632;
static_assert(att::SHM_ATTN <= ATT_STASH_OFF && ATT_STASH_OFF + 8 * 4096 <= RING_BYTES, "attention LDS map");

#define GAS __attribute__((address_space(1)))
#define LAS __attribute__((address_space(3)))
typedef unsigned short bf16;
typedef unsigned v4u __attribute__((ext_vector_type(4)));
typedef float f32x4 __attribute__((ext_vector_type(4)));
typedef short bf16x8 __attribute__((ext_vector_type(8)));
typedef GAS unsigned gu32;
typedef GAS unsigned long long gu64;
#define RLX_AGENT __ATOMIC_RELAXED, __HIP_MEMORY_SCOPE_AGENT
#define LDS_WAIT() asm volatile("s_waitcnt lgkmcnt(0)" ::: "memory")
#define VM_WAIT() asm volatile("s_waitcnt vmcnt(0)" ::: "memory")
__device__ __forceinline__ unsigned long long rt() { return __builtin_amdgcn_s_memrealtime(); }
__device__ __forceinline__ unsigned f2bf(float f) { unsigned u = __builtin_bit_cast(unsigned, f); return (u + 0x7fffu + ((u >> 16) & 1u)) >> 16; }
__device__ __forceinline__ unsigned pk2(float lo, float hi) { return f2bf(lo) | (f2bf(hi) << 16); }

#define XB_TMO      128
#define XB_XCNT(j)  (256  + 64 * (j))
#define XB_XSUB(j)  (1280 + 64 * (j))
#define XB_XGEN(j)  (2304 + 64 * (j))
#define XB_TOP      3328
#define XB_TOPGEN   3392
#define XCD_BAR_WORDS 3456
#define XB_SPIN_CAP (1u << 18)

__device__ __forceinline__ unsigned xb_ld(unsigned* p)              { return __hip_atomic_load(p, __ATOMIC_RELAXED, __HIP_MEMORY_SCOPE_AGENT); }
__device__ __forceinline__ unsigned xb_add(unsigned* p, unsigned v) { return __hip_atomic_fetch_add(p, v, __ATOMIC_RELAXED, __HIP_MEMORY_SCOPE_AGENT); }
__device__ __forceinline__ unsigned xb_xcc_id() { return (unsigned)__builtin_amdgcn_s_getreg((3 << 11) | 20) & 0xFu; }
#define XB_SPIN(cond, bar) do { unsigned _sp = 0; while (cond) { __builtin_amdgcn_s_sleep(1); \
    if ((++_sp & 255u) == 0u) { if (xb_ld(&(bar)[XB_TMO])) break; if (_sp > XB_SPIN_CAP) { atomicAdd(&(bar)[XB_TMO], 1u); break; } } } } while (0)

struct XcdBarrier {
    unsigned* bar; unsigned x;
    volatile LAS unsigned* st;
};

__device__ __forceinline__ XcdBarrier xcd_barrier_post(unsigned* bar, volatile LAS unsigned* st) {
    XcdBarrier b; b.bar = bar; b.x = xb_xcc_id(); b.st = st;
    if (threadIdx.x == 0) (void)xb_add(&bar[XB_XCNT(b.x)], 1u);
    return b;
}
__device__ __forceinline__ void xcd_barrier_complete(unsigned* bar, unsigned x, unsigned& nloc, unsigned& nx) {
    const unsigned G = gridDim.x * gridDim.y * gridDim.z;
    unsigned sum, cnt, mine, sp = 0u;
    for (;;) {
        sum = 0u; cnt = 0u; mine = 0u;
#pragma unroll
        for (unsigned j = 0; j < 16; ++j) { const unsigned c = xb_ld(&bar[XB_XCNT(j)]); sum += c; cnt += (c > 0u) ? 1u : 0u; mine = (j == x) ? c : mine; }
        if (sum == G) break;
        __builtin_amdgcn_s_sleep(1);
        if ((++sp & 255u) == 0u) { if (xb_ld(&bar[XB_TMO])) break; if (sp > XB_SPIN_CAP) { atomicAdd(&bar[XB_TMO], 1u); break; } }
    }
    nloc = mine > 0u ? mine : 1u; nx = cnt > 0u ? cnt : 1u;
}

__device__ __forceinline__ void xcd_barrier(const XcdBarrier& b) {
    asm volatile("s_waitcnt vmcnt(0)" ::: "memory");
    __syncthreads();
    if (threadIdx.x == 0) {
        unsigned* bar = b.bar;
        __builtin_amdgcn_s_waitcnt(0);
        unsigned nloc = b.st[0], nx = b.st[1];
        if (nloc == 0u) { xcd_barrier_complete(bar, b.x, nloc, nx); b.st[0] = nloc; b.st[1] = nx; }
        const unsigned old = xb_add(&bar[XB_XSUB(b.x)], 1u);
        const unsigned gen = old / nloc;
        if (old + 1u == (gen + 1u) * nloc) {
            __builtin_amdgcn_fence(__ATOMIC_RELEASE, "agent");
            asm volatile("s_waitcnt vmcnt(0)" ::: "memory");
            const unsigned og = xb_add(&bar[XB_TOP], 1u);
            const unsigned tg = og / nx;
            if (og + 1u == (tg + 1u) * nx) xb_add(&bar[XB_TOPGEN], 1u);
            else XB_SPIN(xb_ld(&bar[XB_TOPGEN]) == tg, bar);
            __builtin_amdgcn_fence(__ATOMIC_ACQUIRE, "agent");
            xb_add(&bar[XB_XGEN(b.x)], 1u);
            asm volatile("s_waitcnt vmcnt(0)" ::: "memory");
        } else {
            XB_SPIN(xb_ld(&bar[XB_XGEN(b.x)]) == gen, bar);
            __builtin_amdgcn_fence(__ATOMIC_ACQUIRE, "agent");
            asm volatile("s_waitcnt vmcnt(0)" ::: "memory");
        }
    }
    __syncthreads();
}
struct Frame {
    LAS unsigned char* lds;
    volatile LAS unsigned* MISC;
    gu32* ctl;
    int tid, lane, wave;
    int vcu, G;
};
typedef float f32x8v __attribute__((ext_vector_type(8)));
__device__ __forceinline__ float wave_sum(float v) {
#pragma unroll
    for (int o = 1; o < 64; o <<= 1) v += __shfl_xor(v, o);
    return v;
}
__device__ __forceinline__ void p0_transpose_item(const float* W, int K, int N, bf16* WT, int dst_row0, LAS float* scr, int k0, int n0, int lane) {
#pragma unroll 8
    for (int i = 0; i < 32; ++i) { const int kk = 2 * i + (lane >> 5); scr[kk * 33 + (lane & 31)] = W[(size_t)(k0 + kk) * N + n0 + (lane & 31)]; }
    LDS_WAIT(); asm volatile("" ::: "memory");
    const int c = lane & 7;
#pragma unroll
    for (int j = 0; j < 4; ++j) { const int n = (lane >> 3) + 8 * j; const LAS float* s = scr + (8 * c) * 33 + n;
        v4u o; o.x = pk2(s[0 * 33], s[1 * 33]); o.y = pk2(s[2 * 33], s[3 * 33]); o.z = pk2(s[4 * 33], s[5 * 33]); o.w = pk2(s[6 * 33], s[7 * 33]);
        *(GAS v4u*)(WT + (size_t)(dst_row0 + n) * K + k0 + 8 * c) = o; }
    LDS_WAIT(); asm volatile("" ::: "memory");
}
__device__ __forceinline__ void cvt_rows(Frame& F, const float* src, bf16* dst, size_t n8) {
    const size_t gt = (size_t)(F.vcu * NWAVES + F.wave) * 64 + F.lane, NT = (size_t)F.G * NWAVES * 64;
    for (size_t i = gt; i < n8; i += NT) { const f32x8v x = *(const GAS f32x8v*)(src + i * 8);
        v4u o; o.x = pk2(x[0], x[1]); o.y = pk2(x[2], x[3]); o.z = pk2(x[4], x[5]); o.w = pk2(x[6], x[7]); *(GAS v4u*)(dst + i * 8) = o; }
}
struct Args { const float* in[25]; float* out; unsigned char* ws; };

typedef const __attribute__((address_space(4))) Args* KargP;
__device__ __forceinline__ void p0_prologue(Frame& F, KargP a) {
    LAS float* scr = (LAS float*)(F.lds + RING_OFF + F.wave * 16384);
    const int gw = F.vcu * NWAVES + F.wave, NGW = F.G * NWAVES;
    unsigned char* ws = a->ws;
#define TR_MAT(SRC, KK, NN, DST, SWI) do { const int nblk = (NN) / 32, nit = ((KK) / 64) * nblk; \
        for (int it = gw; it < nit; it += NGW) { const int kb = it / nblk, nb = it % nblk, n0 = 32 * nb; int dr = n0; \
            if (SWI) { const int c = n0 < FF ? n0 : n0 - FF; dr = (c >> 7) * 256 + (c & 127) + (n0 < FF ? 0 : 128); } \
            p0_transpose_item((SRC), (KK), (NN), (bf16*)(ws + (DST)), dr, scr, 64 * kb, n0, F.lane); } } while (0)
    TR_MAT(a->in[2], DM, 2 * FF, WS_W1IN, true);
    TR_MAT(a->in[3], FF, DM, WS_W1OUT, false);
    TR_MAT(a->in[6], DM, NIN, WS_WIN, false);
    TR_MAT(a->in[12], 2048, DM, WS_WA, false);
    TR_MAT(a->in[13], 1024, DM, WS_WB, false);
    TR_MAT(a->in[14], DM, DM, WS_WOUT, false);
    TR_MAT(a->in[17], DM, 2 * FF, WS_W2IN, true);
    TR_MAT(a->in[18], FF, DM, WS_W2OUT, false);
    TR_MAT(a->in[21], DM, DM, WS_WG, false);
    TR_MAT(a->in[22], PLE, DM, WS_WP, false);
#undef TR_MAT
    cvt_rows(F, a->in[0], (bf16*)(ws + WS_HB), (size_t)M * DM / 8);
    cvt_rows(F, a->in[1], (bf16*)(ws + WS_PB), (size_t)M * PLE / 8);
}
template <bool WB>
__device__ __forceinline__ void ln_phase(Frame& F, float* hf, const float* g, const float* b, bf16* hb) {
    const int gw = F.vcu * NWAVES + F.wave, NGW = F.G * NWAVES;
    for (int m = gw; m < M; m += NGW) {
        GAS f32x4* xr = (GAS f32x4*)(hf + (size_t)m * DM) + F.lane;
        f32x4 v[16]; float s = 0.f;
#pragma unroll
        for (int j = 0; j < 16; ++j) { v[j] = xr[64 * j]; s += (v[j].x + v[j].y) + (v[j].z + v[j].w); }
        const float mean = wave_sum(s) * (1.f / DM); float s2 = 0.f;
#pragma unroll
        for (int j = 0; j < 16; ++j) { v[j] = v[j] - mean; s2 += (v[j].x * v[j].x + v[j].y * v[j].y) + (v[j].z * v[j].z + v[j].w * v[j].w); }
        const float rstd = 1.f / sqrtf(wave_sum(s2) * (1.f / DM) + LN_EPS);
        GAS unsigned long long* o8 = (GAS unsigned long long*)(hb + (size_t)m * DM) + F.lane;
#pragma unroll
        for (int j = 0; j < 16; ++j) { const f32x4 gv = *((const GAS f32x4*)g + F.lane + 64 * j), bv = *((const GAS f32x4*)b + F.lane + 64 * j);
            const f32x4 y = v[j] * rstd * gv + bv; xr[64 * j] = y;
            if (WB) o8[64 * j] = (unsigned long long)pk2(y.x, y.y) | ((unsigned long long)pk2(y.z, y.w) << 32); }
    }
}
__device__ __forceinline__ void combine_phase(Frame& F, const bf16* dilp, const float* lse, bf16* ob) {
    const int gw = F.vcu * NWAVES + F.wave, NGW = F.G * NWAVES;
    for (int m = gw; m < M; m += NGW) {
        const int h = F.lane >> 3;
        const float l0 = lse[(size_t)m * 8 + h], l1 = lse[(size_t)M * 8 + (size_t)m * 8 + h], l2 = lse[(size_t)2 * M * 8 + (size_t)m * 8 + h];
        const float mx = fmaxf(l0, fmaxf(l1, l2));
        float w0 = __builtin_amdgcn_exp2f(l0 - mx), w1 = __builtin_amdgcn_exp2f(l1 - mx), w2 = __builtin_amdgcn_exp2f(l2 - mx);
        const float inv = 1.f / (w0 + w1 + w2); w0 *= inv; w1 *= inv; w2 *= inv;
        float acc[16];
#pragma unroll
        for (int i = 0; i < 16; ++i) acc[i] = 0.f;
#pragma unroll
        for (int g = 0; g < 3; ++g) { const float w = g == 0 ? w0 : (g == 1 ? w1 : w2);
            const GAS v4u* p = (const GAS v4u*)(dilp + (size_t)g * M * 1024 + (size_t)m * 1024 + F.lane * 16);
            const v4u a = p[0], c = p[1];
            const unsigned wd[8] = {a.x, a.y, a.z, a.w, c.x, c.y, c.z, c.w};
#pragma unroll
            for (int i = 0; i < 8; ++i) { acc[2 * i] += w * __uint_as_float(wd[i] << 16); acc[2 * i + 1] += w * __uint_as_float(wd[i] & 0xffff0000u); } }
        v4u o0, o1; o0.x = pk2(acc[0], acc[1]); o0.y = pk2(acc[2], acc[3]); o0.z = pk2(acc[4], acc[5]); o0.w = pk2(acc[6], acc[7]);
        o1.x = pk2(acc[8], acc[9]); o1.y = pk2(acc[10], acc[11]); o1.z = pk2(acc[12], acc[13]); o1.w = pk2(acc[14], acc[15]);
        GAS v4u* q = (GAS v4u*)(ob + (size_t)m * 1024 + F.lane * 16); q[0] = o0; q[1] = o1;
    }
}

__device__ __forceinline__ void attention_phase(Frame& F, KargP a, char* lds) {
    using att::f32x16; using att::crow;
    unsigned char* ws = a->ws;
    const att::bf16* QKV = (const att::bf16*)(ws + WS_BIG);
    float lam;
    { const int lane = F.lane; const float* q1 = a->in[7]; const float* k1 = a->in[8]; const float* q2 = a->in[9]; const float* k2 = a->in[10];
      const float s1 = wave_sum(q1[lane] * k1[lane] + q1[lane + 64] * k1[lane + 64]), s2 = wave_sum(q2[lane] * k2[lane] + q2[lane + 64] * k2[lane + 64]);
      lam = expf(s1) - expf(s2) + LAMBDA_INIT; }
    const float* subg = a->in[11];
    bf16* OA = (bf16*)(ws + WS_OA);
    float* SCR = (float*)(ws + WS_SCR) + (size_t)blockIdx.x * (2 * 64 * 512);
#ifndef ATT_A
#define ATT_A 1
#endif
#ifndef ATT_B
#define ATT_B 1
#endif
    if (ATT_A) for (int u = F.vcu; u < BATCH * 8 * 16; u += F.G) {
        const int b = u >> 7, h = (u >> 4) & 7, qb = u & 15;
        const size_t rowbase = (size_t)b * SEQ;
        const float sl2 = __builtin_amdgcn_exp2f(-(float)(h + 1)) * LOG2E;
        for (int sub = 0; sub < 4; ++sub) {
            const int e = sub >> 1, c = sub & 1;
            int tl_ = F.tid; asm volatile("" : "+v"(tl_));
            const int tid = tl_, wid = tid >> 6, lane = tid & 63, r32 = lane & 31, hi = lane >> 5;
            float* wsx = (float*)(lds + 4 * 16384) + wid * 64; float* stash = (float*)(lds + ATT_STASH_OFF) + wid * 1024;
            const float dq = (float)(qb * 256 + wid * 32 + r32 - 4 * hi);
            const att::bf16* Qb = QKV + (rowbase + qb * 256) * NQKV + h * 256 + c * 128;
            const att::bf16* Kh = QKV + rowbase * NQKV + 2048 + h * 256 + c * 128;
            const att::bf16* Vh = QKV + rowbase * NQKV + 4096 + h * 256 + e * 128;
            f32x16 o[4]; float m_reg, l_reg;
            att::attn_core<0>(Qb, (long)NQKV, Kh, Vh, (long)NQKV, SEQ / 64, 0, SEQ / 64, dq, sl2, lds, o, m_reg, l_reg);
            if (hi == 0) wsx[r32] = l_reg;
            asm volatile("s_waitcnt lgkmcnt(0)" ::: "memory");
            float rli[16];
#pragma unroll
            for (int r = 0; r < 16; ++r) rli[r] = __builtin_amdgcn_rcpf(wsx[crow(r, hi)]);
            GAS float* scr_l = (GAS float*)(SCR + tid); asm volatile("" : "+v"(scr_l));
            if (c == 0) {
#pragma unroll
                for (int d0 = 0; d0 < 4; ++d0)
#pragma unroll
                    for (int r = 0; r < 16; ++r) scr_l[(d0 * 16 + r) * 512] = o[d0][r] * rli[r];
            } else {
                float ssq[16];
#pragma unroll
                for (int r = 0; r < 16; ++r) ssq[r] = 0.f;
#pragma unroll
                for (int d0 = 0; d0 < 4; ++d0) {
#pragma unroll
                    for (int r = 0; r < 16; ++r) { const float d = scr_l[(d0 * 16 + r) * 512] - lam * (o[d0][r] * rli[r]); o[d0][r] = d; ssq[r] += d * d; }
                    asm volatile("" ::: "memory"); }
                if (e == 0) {
#pragma unroll
                    for (int d0 = 0; d0 < 4; ++d0)
#pragma unroll
                        for (int r = 0; r < 16; ++r) scr_l[32768 + (d0 * 16 + r) * 512] = o[d0][r];
#pragma unroll
                    for (int r = 0; r < 16; ++r) stash[r * 64 + lane] = ssq[r];
                } else {
#pragma unroll
                    for (int r = 0; r < 16; ++r) { float s = ssq[r] + stash[r * 64 + lane];
                        s += __shfl_xor(s, 1); s += __shfl_xor(s, 2); s += __shfl_xor(s, 4); s += __shfl_xor(s, 8); s += __shfl_xor(s, 16);
                        ssq[r] = (1.0f - LAMBDA_INIT) / sqrtf(s * (1.f / 256.f) + SUBLN_EPS); }
                    GAS bf16* orow = (GAS bf16*)(OA + (rowbase + qb * 256 + wid * 32) * 2048 + h * 256 + r32); asm volatile("" : "+v"(orow));
#pragma unroll
                    for (int d0 = 0; d0 < 4; ++d0) { const float g1 = subg[128 + d0 * 32 + r32], g0 = subg[d0 * 32 + r32];
#pragma unroll
                        for (int r = 0; r < 16; ++r) { const float d0v = scr_l[32768 + (d0 * 16 + r) * 512];
                            GAS bf16* p = orow + (size_t)crow(r, hi) * 2048 + d0 * 32;
                            p[128] = (bf16)f2bf(o[d0][r] * ssq[r] * g1); p[0] = (bf16)f2bf(d0v * ssq[r] * g0); }
                        asm volatile("" ::: "memory"); }
                }
            }
        }
    }
    bf16* DILP = (bf16*)(ws + WS_DILP); float* LSE = (float*)(ws + WS_LSE);
    if (ATT_B) for (int u = F.vcu; u < BATCH * 8 * 48; u += F.G) {
        const int b = u / 384, rem = u % 384, h = rem / 48, rem2 = rem % 48, g = rem2 >> 4, w = rem2 & 15;
        const int dil = g == 0 ? 1 : (g == 1 ? 4 : 16), nU = 16 / dil, cls = w / nU, uu = w % nU, L = SEQ / dil;
        const size_t rowbase = (size_t)b * SEQ + cls;
        const long ld = (long)dil * NQKV;
        const att::bf16* Qb = QKV + (rowbase + (size_t)uu * 256 * dil) * NQKV + 6144 + g * 1024 + h * 128;
        const att::bf16* Kh = QKV + rowbase * NQKV + 9216 + g * 1024 + h * 128;
        const att::bf16* Vh = QKV + rowbase * NQKV + 12288 + g * 1024 + h * 128;
        int tl_ = F.tid; asm volatile("" : "+v"(tl_));
        const int tid = tl_, wid = tid >> 6, lane = tid & 63, r32 = lane & 31, hi = lane >> 5;
        float* wsx = (float*)(lds + 4 * 16384) + wid * 64;
        const float dq = (float)(64 + wid * 32 + r32 - 4 * hi);
        const float sl2 = __builtin_amdgcn_exp2f(-(float)(3 * h + g + 1) * (1.f / 3.f)) * (float)dil * LOG2E;
        f32x16 o[4]; float m_reg, l_reg;
        att::attn_core<1>(Qb, ld, Kh, Vh, ld, 6, 4 * uu - 1, L / 64, dq, sl2, lds, o, m_reg, l_reg);
        if (hi == 0) wsx[r32] = l_reg;
        asm volatile("s_waitcnt lgkmcnt(0)" ::: "memory");
        float rli[16];
#pragma unroll
        for (int r = 0; r < 16; ++r) rli[r] = __builtin_amdgcn_rcpf(wsx[crow(r, hi)]);
        GAS bf16* obase = (GAS bf16*)(DILP + (size_t)g * M * 1024 + h * 128 + r32); asm volatile("" : "+v"(obase));
#pragma unroll
        for (int r = 0; r < 16; ++r) { const size_t tok = rowbase + (size_t)(uu * 256 + wid * 32 + crow(r, hi)) * dil;
#pragma unroll
            for (int d0 = 0; d0 < 4; ++d0) obase[tok * 1024 + d0 * 32] = (bf16)f2bf(o[d0][r] * rli[r]); }
        if (hi == 0) { const size_t tok = rowbase + (size_t)(uu * 256 + wid * 32 + r32) * dil; LSE[(size_t)g * M * 8 + tok * 8 + h] = m_reg + __builtin_amdgcn_logf(l_reg); }
    }
}

__global__ void __launch_bounds__(NWAVES * 64, 2) mega_fwd(Args args) {
    extern __shared__ __attribute__((aligned(16))) unsigned char lds[];
    Frame F;
    F.lds = (LAS unsigned char*)lds;
    F.MISC = (volatile LAS unsigned*)(F.lds + MISC_OFF);
    F.tid = threadIdx.x; F.lane = F.tid & 63; F.wave = __builtin_amdgcn_readfirstlane(F.tid >> 6);
    F.G = gridDim.x; { const int bx = blockIdx.x; F.vcu = (F.G % 8 == 0) ? (bx % 8) * (F.G / 8) + bx / 8 : bx; }
    KargP kp = (KargP)__builtin_amdgcn_kernarg_segment_ptr();
#define RELOAD() asm volatile("" : "+s"(kp))
    unsigned char* ws = kp->ws;
    F.ctl = (gu32*)(ws + WS_CTL);
    for (int u = F.tid; u < (LDS_BYTES - LDSCTL_OFF) / 4; u += NWAVES * 64) ((LAS unsigned*)(F.lds + LDSCTL_OFF))[u] = 0u;
    __syncthreads();
    XcdBarrier bar = xcd_barrier_post((unsigned*)(F.ctl + CW_BAR), F.MISC + 8);
#define GRID_BAR() do { xcd_barrier(bar); RELOAD(); ws = kp->ws; { int t_ = threadIdx.x; asm volatile("" : "+v"(t_)); F.tid = t_; F.lane = t_ & 63; } } while (0)
#define GEMM(EPI, A_, B_, N_, K_, E_) do { pg8::Gemm g_{(const pg8::bf16_t*)(A_), (const pg8::bf16_t*)(B_), M, (N_), (K_)}; pg8::StaticOrder S_; S_.init(M, (N_), F.G, (int)blockIdx.x); \
        pg8::gemm_phase<EPI, pg8::StaticOrder, PG8_ALIGN, PG8_SP2>(F.lds + RING_OFF, g_, S_, (E_)); } while (0)
#define hf (kp->out)
#define hb ((bf16*)(ws + WS_HB))
#define big ((bf16*)(ws + WS_BIG))

#ifndef PHM
#define PHM 0xFFFFF
#endif
#define PH(n) if ((PHM >> (n)) & 1)
    PH(0) p0_prologue(F, kp);
    GRID_BAR();
    PH(1) { pg8::EpiSwiglu E{(pg8::bf16_t*)big, FF}; GEMM(pg8::EpiSwiglu, hb, ws + WS_W1IN, 2 * FF, DM, E); }
    __syncthreads();
    PH(14) { pg8::EpiBf16Plain E{(pg8::bf16_t*)(ws + WS_PP), DM}; GEMM(pg8::EpiBf16Plain, ws + WS_PB, ws + WS_WP, DM, PLE, E); }
    GRID_BAR();
    PH(2) { pg8::EpiResid E{kp->in[0], hf, DM, ALPHA, 0.5f}; GEMM(pg8::EpiResid, big, ws + WS_W1OUT, DM, FF, E); }
    GRID_BAR();
    PH(3) ln_phase<true>(F, hf, kp->in[4], kp->in[5], hb);
    GRID_BAR();
    PH(4) { pg8::EpiInProj E{(pg8::bf16_t*)big, (pg8::bf16_t*)(ws + WS_GATES), QSCALE}; GEMM(pg8::EpiInProj, hb, ws + WS_WIN, NIN, DM, E); }
    GRID_BAR();
    PH(5) attention_phase(F, kp, (char*)lds);
    GRID_BAR();
    PH(6) combine_phase(F, (const bf16*)(ws + WS_DILP), (const float*)(ws + WS_LSE), (bf16*)(ws + WS_OB));
    GRID_BAR();
    PH(7) { pg8::EpiGateA E{(const pg8::bf16_t*)(ws + WS_GATES), (float*)(ws + WS_Y1)}; GEMM(pg8::EpiGateA, ws + WS_OA, ws + WS_WA, DM, 2048, E); }
    GRID_BAR();
    PH(8) { pg8::EpiGateB E{(const pg8::bf16_t*)(ws + WS_GATES), (const float*)(ws + WS_Y1), (pg8::bf16_t*)(ws + WS_Y)}; GEMM(pg8::EpiGateB, ws + WS_OB, ws + WS_WB, DM, 1024, E); }
    GRID_BAR();
    PH(9) { pg8::EpiResid E{hf, hf, DM, ALPHA, 1.0f}; GEMM(pg8::EpiResid, ws + WS_Y, ws + WS_WOUT, DM, DM, E); }
    GRID_BAR();
    PH(10) ln_phase<true>(F, hf, kp->in[15], kp->in[16], hb);
    GRID_BAR();
    PH(11) { pg8::EpiSwiglu E{(pg8::bf16_t*)big, FF}; GEMM(pg8::EpiSwiglu, hb, ws + WS_W2IN, 2 * FF, DM, E); }
    GRID_BAR();
    PH(12) { pg8::EpiResid E{hf, hf, DM, ALPHA, 0.5f}; GEMM(pg8::EpiResid, big, ws + WS_W2OUT, DM, FF, E); }
    GRID_BAR();
    PH(13) ln_phase<true>(F, hf, kp->in[19], kp->in[20], hb);
    GRID_BAR();
    PH(15) { pg8::EpiPle E{hf, hf, (const pg8::bf16_t*)(ws + WS_PP), ALPHA}; GEMM(pg8::EpiPle, hb, ws + WS_WG, DM, DM, E); }
    GRID_BAR();
    PH(16) ln_phase<false>(F, hf, kp->in[23], kp->in[24], hb);
#undef GEMM
#undef GRID_BAR
#undef hf
#undef hb
#undef big
}

extern "C" void kernel_launch(void* const* d_in, const int* in_sizes, int n_in, void* d_out, int out_size, void* d_ws, size_t ws_size, hipStream_t stream) {
    static int grid = 0;
    if (grid == 0) {
        if (n_in != 25 || in_sizes[0] != M * DM || out_size != M * DM || ws_size < WS_END) { fprintf(stderr, "kernel_launch: shape mismatch: n_in %d in0 %d out %d ws %zu (need %zu)\n", n_in, n_in > 0 ? in_sizes[0] : -1, out_size, ws_size, (size_t)WS_END); grid = -1; return; }
        int dev = 0, cus = 0;
        if (hipGetDevice(&dev) != hipSuccess || hipDeviceGetAttribute(&cus, hipDeviceAttributeMultiprocessorCount, dev) != hipSuccess) { grid = -1; return; }
        if (hipFuncSetAttribute((const void*)mega_fwd, hipFuncAttributeMaxDynamicSharedMemorySize, LDS_BYTES) != hipSuccess) { fprintf(stderr, "kernel_launch: hipFuncSetAttribute failed\n"); grid = -1; return; }
        int per_cu = 0;
        if (hipOccupancyMaxActiveBlocksPerMultiprocessor(&per_cu, (const void*)mega_fwd, NWAVES * 64, LDS_BYTES) != hipSuccess || per_cu < 1) fprintf(stderr, "kernel_launch: occupancy query reports %d\n", per_cu);
        (void)hipGetLastError();
        grid = cus;
    }
    if (grid < 0) return;
    if (hipMemsetAsync((char*)d_ws + WS_CTL, 0, CTL_ZERO_BYTES, stream) != hipSuccess) return;
    Args a{};
    for (int i = 0; i < 25; ++i) a.in[i] = (const float*)d_in[i];
    a.out = (float*)d_out; a.ws = (unsigned char*)d_ws;
    hipLaunchKernelGGL(mega_fwd, dim3(grid), dim3(NWAVES * 64), LDS_BYTES, stream, a);
    const hipError_t le = hipPeekAtLastError();
    if (le != hipSuccess) fprintf(stderr, "kernel_launch: launch failed: %s\n", hipGetErrorName(le));
}
```

```cpp
#include <hip/hip_runtime.h>
#include <hip/hip_bf16.h>
#include <cstdio>
#include <cstdint>
struct Args { const float* in[25]; float* out; unsigned char* ws; };
typedef const __attribute__((address_space(4))) Args* KargP;
#define KARG_IN(k) (((KargP)__builtin_amdgcn_kernarg_segment_ptr())->in[(k)])
template <int CTRL> __device__ __forceinline__ float xl_dpp(float v) { return __builtin_bit_cast(float, __builtin_amdgcn_update_dpp(0, __builtin_bit_cast(int, v), CTRL, 0xF, 0xF, true)); }
#define XL_STEP(OP, v, CTRL) v = OP(v, xl_dpp<CTRL>(v))
__device__ __forceinline__ void xl_swap16(float& a, float& b) { asm volatile("s_nop 1\n\tv_permlane16_swap_b32 %0, %1" : "+v"(a), "+v"(b)); }
__device__ __forceinline__ void xl_swap32(float& a, float& b) { asm volatile("s_nop 1\n\tv_permlane32_swap_b32 %0, %1" : "+v"(a), "+v"(b)); }
#define XL_SWAP16(OP, v) do { float a_ = v, b_ = v; xl_swap16(a_, b_); v = OP(a_, b_); } while (0)
#define XL_SWAP32(OP, v) do { float a_ = v, b_ = v; xl_swap32(a_, b_); v = OP(a_, b_); } while (0)
__device__ __forceinline__ float xl_add(float a, float b) { return a + b; }
#define XL_RED8(OP, v)  do { XL_STEP(OP, v, 0xB1); XL_STEP(OP, v, 0x4E); XL_STEP(OP, v, 0x141); } while (0)
#define XL_RED32(OP, v) do { XL_RED8(OP, v); XL_STEP(OP, v, 0x140); XL_SWAP16(OP, v); } while (0)
#define XL_RED64(OP, v) do { XL_RED32(OP, v); XL_SWAP32(OP, v); } while (0)
#define XL_RED_16_32(OP, v) do { XL_SWAP16(OP, v); XL_SWAP32(OP, v); } while (0)
__device__ __forceinline__ int lane_id_fresh() { int l; asm volatile("v_mbcnt_lo_u32_b32 %0, -1, 0\n\tv_mbcnt_hi_u32_b32 %0, -1, %0" : "=v"(l)); return l; }
__device__ __forceinline__ float rfl_f(float x) { return __builtin_bit_cast(float, __builtin_amdgcn_readfirstlane(__builtin_bit_cast(int, x))); }
namespace pg8 {
#define PG8_LAS __attribute__((address_space(3)))
typedef unsigned short bf16_t;
typedef short bf16x8 __attribute__((ext_vector_type(8)));
typedef float f32x4 __attribute__((ext_vector_type(4)));
typedef unsigned u32x4 __attribute__((ext_vector_type(4)));
constexpr int BM = 256, BK = 64, HALF = 128, HTB = HALF * BK * 2  , STAGE_BYTES = 8 * HTB, NXCD = 8, WGM = 8;

__host__ __device__ __forceinline__ int lds_byte(int r, int c) { const int st = (r >> 4) * 2 + (c >> 5), rr = r & 15, cc = c & 31, ob = rr * 64 + cc * 2; return st * 1024 + (ob ^ (((ob >> 9) & 1) << 5)); }
__host__ __device__ __forceinline__ void stage_rc(int b, int& R, int& C) { const int st = b / 1024, sb = b % 1024, swz = sb ^ (((sb >> 9) & 1) << 5); R = (st >> 1) * 16 + swz / 64; C = (st & 1) * 32 + (swz % 64) / 2; }
__host__ __device__ __forceinline__ int perm32(int rho) { const int n = rho >> 4, i = rho & 15; return 8 * (i >> 2) + 4 * n + (i & 3); }

struct Unit { int pm, pn; };
struct Gemm { const bf16_t* A; const bf16_t* Bt; int M, N, K, ld; };

struct StaticOrder {
    int nM, nN, nwg, G, c, wgm, imax;
    __host__ __device__ void init(int M, int N, int G_, int c_, int wgm_ = WGM) { nM = M / BM; nN = N / BM; nwg = nM * nN; G = G_; c = c_; wgm = wgm_; imax = 1 << 30; }
    __host__ __device__ bool next(int i, Unit& u) const {
        const long L = (long)i * G + c; if (L >= nwg || i >= imax) return false;
        int wgid = (int)L; { const int q = nwg / NXCD, r = nwg % NXCD, xcd = wgid % NXCD, off = wgid / NXCD; wgid = (xcd < r ? xcd * (q + 1) : r * (q + 1) + (xcd - r) * q) + off; }
        const int nig = wgm * nN, gid = wgid / nig, fm = gid * wgm, gsz = (nM - fm) < wgm ? (nM - fm) : wgm;
        u.pm = fm + ((wgid % nig) % gsz); u.pn = (wgid % nig) / gsz; return true;
    }
    __device__ __forceinline__ void a_ready(const Unit&) const {}
    __device__ __forceinline__ void done(const Unit&) const {}
};
struct OneUnit {
    Unit u;
    __host__ __device__ bool next(int i, Unit& o) const { if (i != 0) return false; o = u; return true; }
    __device__ __forceinline__ void a_ready(const Unit&) const {}
    __device__ __forceinline__ void done(const Unit&) const {}
};

__device__ __forceinline__ unsigned cvt_pk_bf16(float lo, float hi) { unsigned r; asm volatile("v_cvt_pk_bf16_f32 %0, %1, %2" : "=v"(r) : "v"(lo), "v"(hi)); return r; }
typedef unsigned u32x2 __attribute__((ext_vector_type(2)));
__device__ __forceinline__ float bf_lo(unsigned w) { return __uint_as_float(w << 16); }
__device__ __forceinline__ float bf_hi(unsigned w) { return __uint_as_float(w & 0xffff0000u); }
__device__ __forceinline__ float sigmoid_f(float x) { return __builtin_amdgcn_rcpf(1.0f + __builtin_amdgcn_exp2f(x * -1.4426950408889634f)); }
__device__ __forceinline__ f32x4 sigmoid4(f32x4 v) { return (f32x4){sigmoid_f(v[0]), sigmoid_f(v[1]), sigmoid_f(v[2]), sigmoid_f(v[3])}; }
__device__ __forceinline__ u32x4 pack8(f32x4 v0, f32x4 v1) { u32x4 w; w.x = cvt_pk_bf16(v0[0], v0[1]); w.y = cvt_pk_bf16(v0[2], v0[3]); w.z = cvt_pk_bf16(v1[0], v1[1]); w.w = cvt_pk_bf16(v1[2], v1[3]); return w; }

typedef float f32x2s __attribute__((ext_vector_type(2)));
constexpr int LDS_PTAB = 132096, LDS_STAB = 140288, LDS_GTAB = 144384  ;
__device__ __forceinline__ void ln_row_stats(PG8_LAS unsigned char* L, int rloc, float& mu, float& rs) { const f32x2s s = *(const PG8_LAS f32x2s*)(L + LDS_STAB + rloc * 8); mu = s.x; rs = s.y; }
__device__ __forceinline__ f32x4 fmaxf4(f32x4 v) { return (f32x4){fmaxf(v[0], 1e-30f), fmaxf(v[1], 1e-30f), fmaxf(v[2], 1e-30f), fmaxf(v[3], 1e-30f)}; }
__device__ __forceinline__ float hsum4(f32x4 v) { return (v[0] + v[1]) + (v[2] + v[3]); }
template <bool LNIN> struct EpiSwiglu {
    static constexpr bool PERM = true, AFTER_DRAIN = false; static constexpr int TSW = 0;
    bf16_t* O; int ldc; PG8_LAS unsigned char* L; const float* CS; const float* DS;
    __device__ __forceinline__ void operator()(const f32x4 (&acc)[2][2][4][2], const Unit& u, int wr, int wc, int fr, int fq) const {
        const int row0 = u.pm * BM + wr * 64 + fr, col0 = u.pn * HALF + wc * 32 + 8 * fq, bcol = u.pn * BM + wc * 32 + 8 * fq;
        f32x4 cg[2], cu[2], dg[2], du[2];
        if (LNIN) {
#pragma unroll
            for (int n = 0; n < 2; ++n) { cg[n] = *(const f32x4*)(CS + bcol + 4 * n); cu[n] = *(const f32x4*)(CS + bcol + HALF + 4 * n); dg[n] = *(const f32x4*)(DS + bcol + 4 * n); du[n] = *(const f32x4*)(DS + bcol + HALF + 4 * n); } }
#pragma unroll
        for (int ai = 0; ai < 2; ++ai)
#pragma unroll
            for (int m = 0; m < 4; ++m) { const size_t row = (size_t)(row0 + ai * HALF + m * 16); bf16_t* rowp = O + row * ldc + col0;
                f32x4 g0 = acc[ai][0][m][0], g1 = acc[ai][0][m][1], u0 = acc[ai][1][m][0], u1 = acc[ai][1][m][1];
                if (LNIN) { float mu, rs; ln_row_stats(L, ai * HALF + wr * 64 + m * 16 + fr, mu, rs);
                    g0 = (g0 - cg[0] * mu) * rs + dg[0]; g1 = (g1 - cg[1] * mu) * rs + dg[1]; u0 = (u0 - cu[0] * mu) * rs + du[0]; u1 = (u1 - cu[1] * mu) * rs + du[1]; }
                const f32x4 h0 = g0 * sigmoid4(g0) * u0, h1 = g1 * sigmoid4(g1) * u1;
                *(u32x4*)rowp = pack8(h0, h1); }
    }
};
struct EpiSwigluTail {
    static constexpr bool PERM = true, AFTER_DRAIN = false; static constexpr int TSW = 0;
    bf16_t* O; int ldc; PG8_LAS unsigned char* L; const float* CS; const float* DS; float* P; unsigned* FLAG; int role;
    __device__ __forceinline__ void operator()(const f32x4 (&acc)[2][2][4][2], const Unit& u, int wr, int wc, int fr, int fq) const {
        const int tid = (wr * 4 + wc) * 64 + fq * 16 + fr;
        f32x4* Pt = (f32x4*)P + tid;
        if (role) {
#pragma unroll
            for (int ai = 0; ai < 2; ++ai)
#pragma unroll
                for (int bj = 0; bj < 2; ++bj)
#pragma unroll
                    for (int m = 0; m < 4; ++m)
#pragma unroll
                        for (int n = 0; n < 2; ++n) Pt[(size_t)(((ai * 2 + bj) * 4 + m) * 2 + n) * 512] = acc[ai][bj][m][n];
            asm volatile("s_waitcnt vmcnt(0)" ::: "memory"); __builtin_amdgcn_s_barrier();
            if (tid == 0) { __builtin_amdgcn_fence(__ATOMIC_RELEASE, "agent"); asm volatile("s_waitcnt vmcnt(0)" ::: "memory");
                __hip_atomic_store(FLAG, 1u, __ATOMIC_RELAXED, __HIP_MEMORY_SCOPE_AGENT); }
            return; }
        if (tid == 0) { unsigned sp = 0; while (__hip_atomic_load(FLAG, __ATOMIC_RELAXED, __HIP_MEMORY_SCOPE_AGENT) == 0u && ++sp < (1u << 22)) __builtin_amdgcn_s_sleep(1);
            __builtin_amdgcn_fence(__ATOMIC_ACQUIRE, "agent"); asm volatile("s_waitcnt vmcnt(0)" ::: "memory"); }
        __builtin_amdgcn_s_barrier(); asm volatile("" ::: "memory");
        const int row0 = u.pm * BM + wr * 64 + fr, col0 = u.pn * HALF + wc * 32 + 8 * fq, bcol = u.pn * BM + wc * 32 + 8 * fq;
        f32x4 cg[2], cu[2], dg[2], du[2];
#pragma unroll
        for (int n = 0; n < 2; ++n) { cg[n] = *(const f32x4*)(CS + bcol + 4 * n); cu[n] = *(const f32x4*)(CS + bcol + HALF + 4 * n); dg[n] = *(const f32x4*)(DS + bcol + 4 * n); du[n] = *(const f32x4*)(DS + bcol + HALF + 4 * n); }
#pragma unroll
        for (int ai = 0; ai < 2; ++ai)
#pragma unroll
            for (int m = 0; m < 4; ++m) { const size_t row = (size_t)(row0 + ai * HALF + m * 16); bf16_t* rowp = O + row * ldc + col0;
#define PV_(bj, n) __builtin_nontemporal_load(Pt + (size_t)(((ai * 2 + (bj)) * 4 + m) * 2 + (n)) * 512)
                f32x4 g0 = acc[ai][0][m][0] + PV_(0, 0), g1 = acc[ai][0][m][1] + PV_(0, 1), u0 = acc[ai][1][m][0] + PV_(1, 0), u1 = acc[ai][1][m][1] + PV_(1, 1);
#undef PV_
                float mu, rs; ln_row_stats(L, ai * HALF + wr * 64 + m * 16 + fr, mu, rs);
                g0 = (g0 - cg[0] * mu) * rs + dg[0]; g1 = (g1 - cg[1] * mu) * rs + dg[1]; u0 = (u0 - cu[0] * mu) * rs + du[0]; u1 = (u1 - cu[1] * mu) * rs + du[1];
                const f32x4 h0 = g0 * sigmoid4(g0) * u0, h1 = g1 * sigmoid4(g1) * u1;
                *(u32x4*)rowp = pack8(h0, h1); }
    }
};
template <bool XIN, int GI, int BHALF> struct EpiResid {
    static constexpr bool PERM = true, AFTER_DRAIN = false; static constexpr int TSW = 0;
    const float* X; bf16_t* HB; PG8_LAS unsigned char* L; float* PART; int pm0;
    __device__ __forceinline__ void operator()(const f32x4 (&acc)[2][2][4][2], const Unit& u, int wr, int wc, int fr, int fq) const {
        constexpr float a = 1.189207115002721f, b = BHALF ? 0.5f : 1.0f;
        const int col0 = u.pn * BM + wc * 32 + 8 * fq;
        const size_t off0 = (size_t)(u.pm * BM + wr * 64 + fr) * 4096 + col0;
        u32x4 hw[2][4][2];
#define LOAD_HW(ai) do { _Pragma("unroll") for (int m = 0; m < 4; ++m) _Pragma("unroll") for (int bj = 0; bj < 2; ++bj) hw[ai][m][bj] = *(const u32x4*)(HB + off0 + (size_t)((ai) * HALF + m * 16) * 4096 + bj * HALF); } while (0)
        if (!XIN) { const float* gin = KARG_IN(GI); const float* bin = KARG_IN(GI + 1);
            LOAD_HW(0);
            const int t = (wr * 4 + wc) * 64 + fq * 16 + fr;
            if (t < 256) { *(PG8_LAS float*)(L + LDS_GTAB + t * 4) = gin[u.pn * BM + t] * a; *(PG8_LAS float*)(L + LDS_GTAB + 1024 + t * 4) = bin[u.pn * BM + t] * a; }
            asm volatile("s_waitcnt lgkmcnt(0)" ::: "memory"); __builtin_amdgcn_s_barrier(); asm volatile("" ::: "memory"); }
        const int gofs = LDS_GTAB + (wc * 32 + 8 * fq) * 4;
#pragma unroll
        for (int ai = 0; ai < 2; ++ai) {
            if (!XIN && ai == 0) { LOAD_HW(1); __builtin_amdgcn_sched_barrier(0); }
#pragma unroll
            for (int m = 0; m < 4; ++m) { const int rloc = ai * HALF + wr * 64 + m * 16 + fr; const size_t off = off0 + (size_t)(ai * HALF + m * 16) * 4096;
                float mu = 0.f, rs = 1.f; if (!XIN) ln_row_stats(L, rloc + (u.pm != pm0 ? 256 : 0), mu, rs);
                const float nmr = -mu * rs;
                f32x4 s1v = {0.f, 0.f, 0.f, 0.f}, s2v = {0.f, 0.f, 0.f, 0.f};
#pragma unroll
                for (int bj = 0; bj < 2; ++bj) { const int cc = bj * HALF; f32x4 o0, o1;
                    if (XIN) { const f32x4 r0 = *(const f32x4*)(X + off + cc), r1 = *(const f32x4*)(X + off + cc + 4); o0 = r0 * a + acc[ai][bj][m][0] * b; o1 = r1 * a + acc[ai][bj][m][1] * b; }
                    else { const u32x4 w = hw[ai][m][bj];
                        const f32x4 r0 = (f32x4){bf_lo(w.x), bf_hi(w.x), bf_lo(w.y), bf_hi(w.y)}, r1 = (f32x4){bf_lo(w.z), bf_hi(w.z), bf_lo(w.w), bf_hi(w.w)};
                        const volatile PG8_LAS f32x4* gp = (const volatile PG8_LAS f32x4*)(L + gofs + cc * 4);
                        const f32x4 ga0 = gp[0], ga1 = gp[1], ba0 = gp[64], ba1 = gp[65];
                        o0 = (r0 * rs + nmr) * ga0 + (acc[ai][bj][m][0] * b + ba0); o1 = (r1 * rs + nmr) * ga1 + (acc[ai][bj][m][1] * b + ba1); }
                    *(u32x4*)(HB + off + cc) = pack8(o0, o1);
                    s1v += o0 + o1; s2v += o0 * o0 + o1 * o1; }
                float s1 = hsum4(s1v), s2 = hsum4(s2v);
                XL_RED_16_32(xl_add, s1); XL_RED_16_32(xl_add, s2);
                if (fq == 0) *(PG8_LAS f32x2s*)(L + LDS_PTAB + (rloc * 4 + wc) * 8) = (f32x2s){s1, s2};
                if (m == 3) __builtin_amdgcn_sched_barrier(0); } }
#undef LOAD_HW
        asm volatile("s_waitcnt lgkmcnt(0)" ::: "memory"); __builtin_amdgcn_s_barrier(); asm volatile("" ::: "memory");
        const int tid = (wr * 4 + wc) * 64 + fq * 16 + fr;
        if (tid < 256) { const f32x4 p0 = *(const PG8_LAS f32x4*)(L + LDS_PTAB + tid * 32), p1 = *(const PG8_LAS f32x4*)(L + LDS_PTAB + tid * 32 + 16);
            *(f32x2s*)(PART + ((size_t)(u.pm * BM + tid) * 16 + u.pn) * 2) = (f32x2s){(p0[0] + p0[2]) + (p1[0] + p1[2]), (p0[1] + p0[3]) + (p1[1] + p1[3])}; }
    }
};
struct EpiInProj {
    static constexpr bool PERM = true, AFTER_DRAIN = false; static constexpr int TSW = 0;
    bf16_t* QKV; bf16_t* G; float qscale; float* NRM;
    PG8_LAS unsigned char* L; const float* CS; const float* DS;
    __device__ __forceinline__ void operator()(const f32x4 (&acc)[2][2][4][2], const Unit& u, int wr, int wc, int fr, int fq) const {
        const int row0 = u.pm * BM + wr * 64 + fr; const bool gate = u.pn >= 60; const int bcol = u.pn * BM + wc * 32 + 8 * fq;
        f32x4 cv[2][2], dv[2][2];
#pragma unroll
        for (int bj = 0; bj < 2; ++bj)
#pragma unroll
            for (int n = 0; n < 2; ++n) { cv[bj][n] = *(const f32x4*)(CS + bcol + bj * HALF + 4 * n); dv[bj][n] = *(const f32x4*)(DS + bcol + bj * HALF + 4 * n); }
        bf16_t* base = gate ? G : QKV; const int ldc = gate ? 8192 : 15360, colt = gate ? (u.pn - 60) * BM : u.pn * BM;
        const float sc = (u.pn < 8 || (u.pn >= 24 && u.pn < 36)) ? qscale : 1.0f;
        const int col0 = colt + wc * 32 + 8 * fq;
#pragma unroll
        for (int ai = 0; ai < 2; ++ai)
#pragma unroll
            for (int m = 0; m < 4; ++m) { bf16_t* rowp = base + (size_t)(row0 + ai * HALF + m * 16) * ldc + col0;
                float mu, rs; ln_row_stats(L, ai * HALF + wr * 64 + m * 16 + fr, mu, rs);
#pragma unroll
                for (int bj = 0; bj < 2; ++bj) { f32x4 v0 = (acc[ai][bj][m][0] - cv[bj][0] * mu) * rs + dv[bj][0], v1 = (acc[ai][bj][m][1] - cv[bj][1] * mu) * rs + dv[bj][1];
                    if (gate) { v0 = sigmoid4(v0); v1 = sigmoid4(v1); } else { v0 = v0 * sc; v1 = v1 * sc; }
                    *(u32x4*)(rowp + bj * HALF) = pack8(v0, v1);
                    if (u.pn < 16) { float s = (v0[0] * v0[0] + v0[1] * v0[1]) + (v0[2] * v0[2] + v0[3] * v0[3]) + (v1[0] * v1[0] + v1[1] * v1[1]) + (v1[2] * v1[2] + v1[3] * v1[3]);
                        XL_RED_16_32(xl_add, s);
                        if (fq == 0) NRM[(size_t)(row0 + ai * HALF + m * 16) * 128 + u.pn * 8 + bj * 4 + wc] = s; } } }
    }
};
struct EpiBf16Plain {
    static constexpr bool PERM = true, AFTER_DRAIN = false; static constexpr int TSW = 0;
    bf16_t* O; int ldc;
    __device__ __forceinline__ void operator()(const f32x4 (&acc)[2][2][4][2], const Unit& u, int wr, int wc, int fr, int fq) const {
        const int row0 = u.pm * BM + wr * 64 + fr, col0 = u.pn * BM + wc * 32 + 8 * fq;
#pragma unroll
        for (int ai = 0; ai < 2; ++ai)
#pragma unroll
            for (int m = 0; m < 4; ++m) { bf16_t* rowp = O + (size_t)(row0 + ai * HALF + m * 16) * ldc + col0;
#pragma unroll
                for (int bj = 0; bj < 2; ++bj) *(u32x4*)(rowp + bj * HALF) = pack8(acc[ai][bj][m][0], acc[ai][bj][m][1]); }
    }
};
struct EpiGateAB {
    static constexpr bool PERM = true, AFTER_DRAIN = false; static constexpr int TSW = 2048 / BK;
    const bf16_t* G; bf16_t* Y;
    __device__ __forceinline__ void mid(f32x4 (&acc)[2][2][4][2], const Unit& u, int wr, int wc, int fr, int fq) const {
        int row0 = u.pm * BM + wr * 64 + fr, col0 = u.pn * BM + wc * 32 + 8 * fq; asm volatile("" : "+v"(row0), "+v"(col0));
#pragma unroll
        for (int ai = 0; ai < 2; ++ai) {
            u32x4 aw[4][2], bw[4][2];
#pragma unroll
            for (int m = 0; m < 4; ++m)
#pragma unroll
                for (int bj = 0; bj < 2; ++bj) { const bf16_t* gp = G + (size_t)(row0 + ai * HALF + m * 16) * 8192 + col0 + bj * HALF; aw[m][bj] = *(const u32x4*)gp; bw[m][bj] = *(const u32x4*)(gp + 4096); }
#pragma unroll
            for (int m = 0; m < 4; ++m)
#pragma unroll
                for (int bj = 0; bj < 2; ++bj) { const u32x4 av = aw[m][bj], bv = bw[m][bj];
                    const f32x4 a0 = (f32x4){bf_lo(av.x), bf_hi(av.x), bf_lo(av.y), bf_hi(av.y)}, a1 = (f32x4){bf_lo(av.z), bf_hi(av.z), bf_lo(av.w), bf_hi(av.w)};
                    const f32x4 b0 = (f32x4){bf_lo(bv.x), bf_hi(bv.x), bf_lo(bv.y), bf_hi(bv.y)}, b1 = (f32x4){bf_lo(bv.z), bf_hi(bv.z), bf_lo(bv.w), bf_hi(bv.w)};
#pragma unroll
                    for (int i = 0; i < 4; ++i) { acc[ai][bj][m][0][i] *= a0[i] * __builtin_amdgcn_rcpf(fmaxf(b0[i], 1e-30f)); acc[ai][bj][m][1][i] *= a1[i] * __builtin_amdgcn_rcpf(fmaxf(b1[i], 1e-30f)); } }
            __builtin_amdgcn_sched_barrier(0); }
    }
    __device__ __forceinline__ void operator()(const f32x4 (&acc)[2][2][4][2], const Unit& u, int wr, int wc, int fr, int fq) const {
        const int row0 = u.pm * BM + wr * 64 + fr, col0 = u.pn * BM + wc * 32 + 8 * fq;
#pragma unroll
        for (int ai = 0; ai < 2; ++ai)
#pragma unroll
            for (int m = 0; m < 4; ++m) { const size_t row = (size_t)(row0 + ai * HALF + m * 16);
#pragma unroll
                for (int bj = 0; bj < 2; ++bj) { const int c = col0 + bj * HALF; const u32x4 bw = *(const u32x4*)(G + row * 8192 + 4096 + c);
                    const f32x4 b0 = (f32x4){bf_lo(bw.x), bf_hi(bw.x), bf_lo(bw.y), bf_hi(bw.y)}, b1 = (f32x4){bf_lo(bw.z), bf_hi(bw.z), bf_lo(bw.w), bf_hi(bw.w)};
                    *(u32x4*)(Y + row * 4096 + c) = pack8(fmaxf4(b0) * acc[ai][bj][m][0], fmaxf4(b1) * acc[ai][bj][m][1]); }
                if (m == 3) __builtin_amdgcn_sched_barrier(0); }
    }
};
struct EpiPle {
    static constexpr bool PERM = true, AFTER_DRAIN = false; static constexpr int TSW = 0;
    const bf16_t* HB; bf16_t* out; const bf16_t* PP; PG8_LAS unsigned char* L; const float* CS; const float* DS;
    __device__ __forceinline__ void operator()(const f32x4 (&acc)[2][2][4][2], const Unit& u, int wr, int wc, int fr, int fq) const {
        constexpr float a = 1.189207115002721f; const float* gin = KARG_IN(19); const float* bin = KARG_IN(20);
        const int col0 = u.pn * BM + wc * 32 + 8 * fq;
        { const int t = (wr * 4 + wc) * 64 + fq * 16 + fr;
          if (t < 256) { const int c = u.pn * BM + t; PG8_LAS float* T = (PG8_LAS float*)(L + LDS_PTAB) + t; T[0] = gin[c] * a; T[256] = bin[c] * a; T[512] = CS[c]; T[768] = DS[c]; }
          asm volatile("s_waitcnt lgkmcnt(0)" ::: "memory"); __builtin_amdgcn_s_barrier(); asm volatile("" ::: "memory"); }
        const int gofs = LDS_PTAB + (wc * 32 + 8 * fq) * 4;
#pragma unroll
        for (int ai = 0; ai < 2; ++ai)
#pragma unroll
            for (int m = 0; m < 4; ++m) { const int rloc = ai * HALF + wr * 64 + m * 16 + fr; const size_t off = (size_t)(u.pm * BM + rloc) * 4096 + col0;
                float mu, rs; ln_row_stats(L, rloc, mu, rs); const float nmr = -mu * rs;
#pragma unroll
                for (int bj = 0; bj < 2; ++bj) { const size_t o = off + bj * HALF;
                    const u32x4 hw = *(const u32x4*)(HB + o), pw = *(const u32x4*)(PP + o);
                    const volatile PG8_LAS f32x4* gp = (const volatile PG8_LAS f32x4*)(L + gofs + bj * HALF * 4);
                    f32x4 y[2];
#pragma unroll
                    for (int n = 0; n < 2; ++n) { const unsigned h0 = n ? hw.z : hw.x, h1 = n ? hw.w : hw.y, q0 = n ? pw.z : pw.x, q1 = n ? pw.w : pw.y;
                        const f32x4 gv = gp[n], bv = gp[64 + n], cv = gp[128 + n], dv = gp[192 + n];
                        const f32x4 z = acc[ai][bj][m][n] * rs + (cv * nmr + dv);
                        y[n] = ((f32x4){bf_lo(h0), bf_hi(h0), bf_lo(h1), bf_hi(h1)} * rs + nmr) * gv + (bv + sigmoid4(z) * (f32x4){bf_lo(q0), bf_hi(q0), bf_lo(q1), bf_hi(q1)}); }
                    *(u32x4*)(out + o) = pack8(y[0], y[1]); }
                if (m == 3) __builtin_amdgcn_sched_barrier(0); }
    }
};

template <class Epi, class Sched, bool ALIGN_EPI = false, bool SP2 = false>
__device__ __forceinline__ void gemm_phase(PG8_LAS unsigned char* lds, const Gemm g, const Sched& S, const Epi& E, int wave_id) {
    const int tid_ = wave_id * 64 + lane_id_fresh();
    const int tid = tid_, wid = __builtin_amdgcn_readfirstlane(tid >> 6), lane = tid & 63, wr = wid >> 2, wc = wid & 3, fr = lane & 15, fq = lane >> 4;
    const int K = g.K, nt = K / BK, ld = g.ld;
    unsigned voffA[2], voffB[2];
#pragma unroll
    for (int i = 0; i < 2; ++i) { int R, C; stage_rc(tid * 16 + i * 8192, R, C); const int Rb = Epi::PERM ? ((R & ~31) + perm32(R & 31)) : R;
        voffA[i] = (unsigned)(R * ld + C) * 2u; voffB[i] = (unsigned)(Rb * ld + C) * 2u; }
    const size_t kstep = (size_t)(BK * 2);
    const size_t hstep = (size_t)HALF * ld * 2;
    const size_t tstep = 2 * hstep;
    const unsigned ldsw = (unsigned)wid * 1024u;
    const int aoff = lds_byte(wr * 64 + fr, fq * 8), boff = lds_byte(wc * 32 + fr, fq * 8);
#define PG8_SA(b, h) (((b) * 2 + (h)) * HTB)
#define PG8_SB(b, h) ((4 + (b) * 2 + (h)) * HTB)
#define PG8_STAGE(bufoff, gbase, voff) do { _Pragma("unroll") for (int _i = 0; _i < 2; ++_i) \
        __builtin_amdgcn_global_load_lds((const unsigned*)((const char*)(gbase) + (voff)[_i]), (PG8_LAS unsigned*)(lds + (bufoff) + ldsw + _i * 8192), 16, 0, 0); } while (0)
#define PG8_LDA(dst, b, h) do { _Pragma("unroll") for (int m = 0; m < 4; ++m) _Pragma("unroll") for (int k = 0; k < 2; ++k) dst[m][k] = *(const PG8_LAS bf16x8*)(lds + PG8_SA(b, h) + aoff + m * 2048 + k * 1024); } while (0)
#define PG8_LDB(dst, b, h) do { _Pragma("unroll") for (int n = 0; n < 2; ++n) _Pragma("unroll") for (int k = 0; k < 2; ++k) dst[n][k] = *(const PG8_LAS bf16x8*)(lds + PG8_SB(b, h) + boff + n * 2048 + k * 1024); } while (0)
#define PG8_MMA(ai, bj, At, Bt) do { __builtin_amdgcn_s_setprio(1); _Pragma("unroll") for (int m = 0; m < 4; ++m) _Pragma("unroll") for (int n = 0; n < 2; ++n) _Pragma("unroll") for (int k = 0; k < 2; ++k) \
        acc[ai][bj][m][n] = __builtin_amdgcn_mfma_f32_16x16x32_bf16(Bt[n][k], At[m][k], acc[ai][bj][m][n], 0, 0, 0); __builtin_amdgcn_s_setprio(0); } while (0)
#define PG8_WAIT_V(n) asm volatile("s_waitcnt vmcnt(" #n ")" ::: "memory")
#define PG8_WAIT_L(n) asm volatile("s_waitcnt lgkmcnt(" #n ")" ::: "memory")
#define PG8_BAR __builtin_amdgcn_s_barrier()
#define PG8_SCHED __builtin_amdgcn_sched_barrier(0)
    Unit cur, nxt; int ui = 0;
    if (!S.next(0, cur)) return;
    f32x4 acc[2][2][4][2];
#pragma unroll
    for (int a = 0; a < 2; ++a)
#pragma unroll
        for (int b = 0; b < 2; ++b)
#pragma unroll
            for (int m = 0; m < 4; ++m)
#pragma unroll
                for (int n = 0; n < 2; ++n) acc[a][b][m][n] = (f32x4){0.f, 0.f, 0.f, 0.f};
    bf16x8 At[4][2], B0[2][2], B1[2][2];
    const char* cA = (const char*)g.A + (size_t)cur.pm * tstep; const char* cB = (const char*)g.Bt + (size_t)cur.pn * tstep;
    S.a_ready(cur);
    if constexpr (SP2) {
        PG8_STAGE(PG8_SB(0, 0), cB, voffB); PG8_STAGE(PG8_SB(0, 1), cB + hstep, voffB); PG8_STAGE(PG8_SA(0, 0), cA, voffA); PG8_STAGE(PG8_SA(0, 1), cA + hstep, voffA);
        if (wr == 1) PG8_BAR;
        PG8_WAIT_V(2); PG8_BAR;
        PG8_STAGE(PG8_SB(1, 0), cB + kstep, voffB); PG8_STAGE(PG8_SA(1, 0), cA + kstep, voffA); PG8_STAGE(PG8_SB(1, 1), cB + hstep + kstep, voffB);
        PG8_WAIT_V(6); PG8_BAR;
    } else {
        PG8_STAGE(PG8_SB(0, 0), cB, voffB); PG8_STAGE(PG8_SA(0, 0), cA, voffA); PG8_STAGE(PG8_SB(0, 1), cB + hstep, voffB); PG8_STAGE(PG8_SA(0, 1), cA + hstep, voffA);
        if (wr == 1) PG8_BAR;
        PG8_WAIT_V(4); PG8_BAR;
        PG8_STAGE(PG8_SB(1, 0), cB + kstep, voffB); PG8_STAGE(PG8_SA(1, 0), cA + kstep, voffA); PG8_STAGE(PG8_SB(1, 1), cB + hstep + kstep, voffB);
        PG8_WAIT_V(6); PG8_BAR;
    }
    for (;;) {
        const bool has_next = S.next(ui + 1, nxt);
        const char* nA = has_next ? (const char*)g.A + (size_t)nxt.pm * tstep : cA; const char* nB = has_next ? (const char*)g.Bt + (size_t)nxt.pn * tstep : cB;
        for (int t = 0; t < nt; t += 2) {
            if constexpr (Epi::TSW > 0) { if (t == Epi::TSW) E.mid(acc, cur, wr, wc, fr, fq); }
            const bool last = (t == nt - 2);
            const char* a1 = cA + (size_t)(t + 1) * kstep;
            const char* a2 = last ? nA : cA + (size_t)(t + 2) * kstep; const char* b2 = last ? nB : cB + (size_t)(t + 2) * kstep;
            const char* a3 = a2 + kstep; const char* b3 = b2 + kstep;
            if (last && has_next) S.a_ready(nxt);
            if constexpr (SP2) {
            PG8_LDB(B0, 0, 0); PG8_LDB(B1, 0, 1); PG8_SCHED; PG8_LDA(At, 0, 0); PG8_STAGE(PG8_SA(1, 1), a1 + hstep, voffA);
            PG8_WAIT_V(8); PG8_WAIT_L(0); PG8_BAR; PG8_MMA(0, 0, At, B0); PG8_MMA(0, 1, At, B1); PG8_BAR; PG8_SCHED;
            PG8_LDA(At, 0, 1); PG8_STAGE(PG8_SB(0, 0), b2, voffB); PG8_STAGE(PG8_SB(0, 1), b2 + hstep, voffB); PG8_STAGE(PG8_SA(0, 0), a2, voffA);
            PG8_WAIT_V(8); PG8_WAIT_L(0); PG8_BAR; PG8_MMA(1, 0, At, B0); PG8_MMA(1, 1, At, B1); PG8_BAR; PG8_SCHED;
            PG8_LDB(B0, 1, 0); PG8_LDB(B1, 1, 1); PG8_SCHED; PG8_LDA(At, 1, 0); PG8_STAGE(PG8_SA(0, 1), a2 + hstep, voffA);
            PG8_WAIT_V(8); PG8_WAIT_L(0); PG8_BAR; PG8_MMA(0, 0, At, B0); PG8_MMA(0, 1, At, B1); PG8_BAR; PG8_SCHED;
            PG8_LDA(At, 1, 1); PG8_STAGE(PG8_SB(1, 0), b3, voffB); PG8_STAGE(PG8_SB(1, 1), b3 + hstep, voffB); PG8_STAGE(PG8_SA(1, 0), a3, voffA);
            PG8_WAIT_V(8); PG8_WAIT_L(0); PG8_BAR; PG8_MMA(1, 0, At, B0); PG8_MMA(1, 1, At, B1); PG8_BAR; PG8_SCHED;
            } else {
            PG8_LDB(B0, 0, 0); PG8_SCHED; PG8_LDA(At, 0, 0); PG8_STAGE(PG8_SA(1, 1), a1 + hstep, voffA);
            PG8_WAIT_L(8); PG8_BAR; PG8_WAIT_L(0); PG8_MMA(0, 0, At, B0); PG8_BAR; PG8_SCHED;
            PG8_LDB(B1, 0, 1); PG8_STAGE(PG8_SB(0, 0), b2, voffB);
            PG8_BAR; PG8_WAIT_L(0); PG8_MMA(0, 1, At, B1); PG8_BAR;
            PG8_LDA(At, 0, 1); PG8_STAGE(PG8_SA(0, 0), a2, voffA);
            PG8_BAR; PG8_WAIT_L(0); PG8_MMA(1, 0, At, B0); PG8_BAR; PG8_SCHED;
            PG8_STAGE(PG8_SB(0, 1), b2 + hstep, voffB);
            PG8_WAIT_V(6); PG8_BAR; PG8_MMA(1, 1, At, B1); PG8_BAR;
            PG8_LDB(B0, 1, 0); PG8_SCHED; PG8_LDA(At, 1, 0); PG8_STAGE(PG8_SA(0, 1), a2 + hstep, voffA);
            PG8_WAIT_L(8); PG8_BAR; PG8_WAIT_L(0); PG8_MMA(0, 0, At, B0); PG8_BAR; PG8_SCHED;
            PG8_LDB(B1, 1, 1); PG8_STAGE(PG8_SB(1, 0), b3, voffB);
            PG8_BAR; PG8_WAIT_L(0); PG8_MMA(0, 1, At, B1); PG8_BAR;
            PG8_LDA(At, 1, 1); PG8_STAGE(PG8_SA(1, 0), a3, voffA);
            PG8_BAR; PG8_WAIT_L(0); PG8_MMA(1, 0, At, B0); PG8_BAR; PG8_SCHED;
            PG8_STAGE(PG8_SB(1, 1), b3 + hstep, voffB);
            PG8_WAIT_V(6); PG8_BAR; PG8_MMA(1, 1, At, B1); PG8_BAR;
            }
        }
        if constexpr (ALIGN_EPI) { if (wr == 0) PG8_BAR; }
        if constexpr (!Epi::AFTER_DRAIN) { E(acc, cur, wr, wc, fr, fq); S.done(cur); }
        if (!has_next) break;
#pragma unroll
        for (int a = 0; a < 2; ++a)
#pragma unroll
            for (int b = 0; b < 2; ++b)
#pragma unroll
                for (int m = 0; m < 4; ++m)
#pragma unroll
                    for (int n = 0; n < 2; ++n) acc[a][b][m][n] = (f32x4){0.f, 0.f, 0.f, 0.f};
        cur = nxt; cA = nA; cB = nB; ++ui;
        if constexpr (ALIGN_EPI) { if (wr == 1) PG8_BAR; }
    }
    PG8_WAIT_V(0);
    if constexpr (!ALIGN_EPI) { if (wr == 0) PG8_BAR; }
    PG8_BAR;
    if constexpr (Epi::AFTER_DRAIN) { E.fused(acc, cur, wr, wc, fr, fq, lds, wid, lane); S.done(cur); }
#undef PG8_SA
#undef PG8_SB
#undef PG8_STAGE
#undef PG8_LDA
#undef PG8_LDB
#undef PG8_MMA
#undef PG8_WAIT_V
#undef PG8_WAIT_L
#undef PG8_BAR
#undef PG8_SCHED
}
}
namespace att {
using bf16 = __hip_bfloat16;
using bf16x8 = __attribute__((ext_vector_type(8))) short;
using s16x4  = __attribute__((ext_vector_type(4))) short;
using f32x16 = __attribute__((ext_vector_type(16))) float;
using u32x4  = __attribute__((ext_vector_type(4))) unsigned;
constexpr int NW = 8, QBLK = 32, KVBLK = 64;
constexpr size_t SHM_V = KVBLK * 128 * 2, SHM_K = KVBLK * 128 * 2, SHM_ATTN = 2 * SHM_V + 2 * SHM_K + NW * 64 * 4;
constexpr float THR2 = 11.5f;
#define KSWZ(row, colB) ((row) * 256 + ((colB) ^ (((row) & 7) << 4)))
#define SBAR() __builtin_amdgcn_sched_barrier(0)
__device__ __forceinline__ int crow(int r, int hi) { return (r & 3) + 8 * (r >> 2) + 4 * hi; }
__device__ __forceinline__ unsigned cvtpk(float lo, float hi) { unsigned r; asm volatile("v_cvt_pk_bf16_f32 %0, %1, %2" : "=v"(r) : "v"(lo), "v"(hi)); return r; }

template <int MODE>
__device__ __forceinline__ void partialSM(f32x16& p0, f32x16& p1, float& m_reg, float& mn, float& alpha, float di, float sl2) {
#pragma unroll
  for (int r = 0; r < 16; ++r) { const float a0 = fabsf(di - (float)((r & 3) + 8 * (r >> 2))), a1 = fabsf(di - (float)(32 + (r & 3) + 8 * (r >> 2)));
    if (MODE == 0) { p0[r] = fmaf(-sl2, a0, p0[r]); p1[r] = fmaf(-sl2, a1, p1[r]); }
    else { p0[r] = a0 <= 64.f ? fmaf(-sl2, a0, p0[r]) : -1e30f; p1[r] = a1 <= 64.f ? fmaf(-sl2, a1, p1[r]) : -1e30f; } }
  float pmax = p0[0];
#pragma unroll
  for (int r = 1; r < 16; ++r) pmax = fmaxf(pmax, p0[r]);
#pragma unroll
  for (int r = 0; r < 16; ++r) pmax = fmaxf(pmax, p1[r]);
  { auto rr = __builtin_amdgcn_permlane32_swap(__float_as_uint(pmax), __float_as_uint(pmax), false, false);
    pmax = fmaxf(__uint_as_float(rr[0]), __uint_as_float(rr[1])); }
  if (__builtin_expect(__all(pmax - m_reg <= THR2), 1)) { mn = m_reg; alpha = 1.f; }
  else { mn = fmaxf(m_reg, pmax); alpha = __builtin_amdgcn_exp2f(m_reg - mn); m_reg = mn; }
#pragma unroll
  for (int r = 0; r < 16; ++r) p0[r] = p0[r] - mn;
#pragma unroll
  for (int r = 0; r < 16; ++r) p1[r] = p1[r] - mn;
#pragma unroll
  for (int r = 0; r < 16; ++r) p0[r] = __builtin_amdgcn_exp2f(p0[r]);
}
__device__ __forceinline__ void finishSM(f32x16& p0, f32x16& p1, float alpha, float& l_reg, bf16x8& pa0, bf16x8& pa1, bf16x8& pa2, bf16x8& pa3) {
#pragma unroll
  for (int r = 0; r < 16; ++r) p1[r] = __builtin_amdgcn_exp2f(p1[r]);
  float ps = 0;
#pragma unroll
  for (int r = 0; r < 16; ++r) ps += p0[r];
#pragma unroll
  for (int r = 0; r < 16; ++r) ps += p1[r];
  { auto rr = __builtin_amdgcn_permlane32_swap(__float_as_uint(ps), __float_as_uint(ps), false, false);
    ps = __uint_as_float(rr[0]) + __uint_as_float(rr[1]); }
  l_reg = l_reg * alpha + ps;
#define PK4(P, BASE, OUT) do { unsigned a0 = cvtpk(P[BASE + 0], P[BASE + 1]), a1 = cvtpk(P[BASE + 2], P[BASE + 3]);   \
    unsigned b0 = cvtpk(P[BASE + 4], P[BASE + 5]), b1 = cvtpk(P[BASE + 6], P[BASE + 7]);                              \
    auto r0 = __builtin_amdgcn_permlane32_swap(a0, b0, false, false); auto r1 = __builtin_amdgcn_permlane32_swap(a1, b1, false, false); \
    u32x4 w = {r0[0], r1[0], r0[1], r1[1]}; OUT = *reinterpret_cast<bf16x8*>(&w); } while (0)
  PK4(p0, 0, pa0); PK4(p0, 8, pa1); PK4(p1, 0, pa2); PK4(p1, 8, pa3);
#undef PK4
}
__device__ __forceinline__ void qkt(f32x16& p0, f32x16& p1, const bf16* Ks, const bf16x8* qr, int r32, int hi) {
  p0 = f32x16{}; p1 = f32x16{};
#pragma unroll
  for (int d0 = 0; d0 < 8; ++d0) { int cb = (d0 * 16 + hi * 8) * 2;
    bf16x8 b0 = *reinterpret_cast<const bf16x8*>((const char*)Ks + KSWZ(r32, cb));
    bf16x8 b1 = *reinterpret_cast<const bf16x8*>((const char*)Ks + KSWZ(32 + r32, cb));
    p0 = __builtin_amdgcn_mfma_f32_32x32x16_bf16(b0, qr[d0], p0, 0, 0, 0);
    p1 = __builtin_amdgcn_mfma_f32_32x32x16_bf16(b1, qr[d0], p1, 0, 0, 0); }
}
__device__ __forceinline__ int v_st(int k, int c) { const int kk = (k & ~0xC) | ((k & 4) << 1) | ((k & 8) >> 1); return ((kk >> 3) * 4 + (c >> 5)) * 512 + ((kk & 7) * 32 + (c & 31)) * 2; }
__device__ __forceinline__ int v_rd_base(int lane) { return ((lane & 3) << 3) | (((lane >> 2) & 3) << 6) | (((lane >> 4) & 1) << 5) | (((lane >> 5) & 1) << 8); }
constexpr int v_rd_off(int d0, int ks, int half) { return d0 * 512 + ks * 4096 + half * 2048; }
template <int OFF> __device__ __forceinline__ s16x4 tr_read(int vb) {
  s16x4 r; asm volatile("ds_read_b64_tr_b16 %0, %1 offset:%2" : "=&v"(r) : "v"(vb), "i"(OFF) : "memory"); return r;
}
template <int D0> __device__ __forceinline__ void pv_one(f32x16& od, int vb, bf16x8 pa0, bf16x8 pa1, bf16x8 pa2, bf16x8 pa3) {
  const s16x4 l0 = tr_read<v_rd_off(D0, 0, 0)>(vb), h0 = tr_read<v_rd_off(D0, 0, 1)>(vb), l1 = tr_read<v_rd_off(D0, 1, 0)>(vb), h1 = tr_read<v_rd_off(D0, 1, 1)>(vb);
  const s16x4 l2 = tr_read<v_rd_off(D0, 2, 0)>(vb), h2 = tr_read<v_rd_off(D0, 2, 1)>(vb), l3 = tr_read<v_rd_off(D0, 3, 0)>(vb), h3 = tr_read<v_rd_off(D0, 3, 1)>(vb);
  asm volatile("s_waitcnt lgkmcnt(0)" ::: "memory"); SBAR();
#define PK(L, H) (bf16x8){L[0], L[1], L[2], L[3], H[0], H[1], H[2], H[3]}
  od = __builtin_amdgcn_mfma_f32_32x32x16_bf16(pa0, PK(l0, h0), od, 0, 0, 0);
  od = __builtin_amdgcn_mfma_f32_32x32x16_bf16(pa1, PK(l1, h1), od, 0, 0, 0);
  od = __builtin_amdgcn_mfma_f32_32x32x16_bf16(pa2, PK(l2, h2), od, 0, 0, 0);
  od = __builtin_amdgcn_mfma_f32_32x32x16_bf16(pa3, PK(l3, h3), od, 0, 0, 0);
#undef PK
}
__device__ __forceinline__ void pv_d0(f32x16* o, int vb, bf16x8 pa0, bf16x8 pa1, bf16x8 pa2, bf16x8 pa3) {
  pv_one<0>(o[0], vb, pa0, pa1, pa2, pa3); pv_one<1>(o[1], vb, pa0, pa1, pa2, pa3); pv_one<2>(o[2], vb, pa0, pa1, pa2, pa3); pv_one<3>(o[3], vb, pa0, pa1, pa2, pa3);
}

template <int MODE>
__device__ __forceinline__ void attn_core(const bf16* __restrict__ Qb, long ldq, const bf16* __restrict__ Kh, const bf16* __restrict__ Vh, long ldk, int NT, int t0, int tmax,
                                          float dq, float sl2, int wave_id, char* lds, f32x16 (&o)[4], float& m_reg, float& l_reg) {
  const int tid_ = wave_id * 64 + lane_id_fresh(); asm volatile("" : "+v"(dq));
  const int tid = tid_, wid = tid >> 6, lane = tid & 63, r32 = lane & 31, hi = lane >> 5;
  bf16* V_lds = (bf16*)lds; bf16* K_lds = (bf16*)(lds + 2 * SHM_V);
  float* ws = (float*)(lds + 2 * SHM_V + 2 * SHM_K) + wid * 64; float* al_l = ws + 32;
  m_reg = -1e30f; l_reg = 0.f;
#pragma unroll
  for (int d = 0; d < 4; ++d) o[d] = f32x16{};
  bf16x8 qr[8];
  const bf16* Qw = Qb + (long)(wid * QBLK + r32) * ldq + hi * 8;
#pragma unroll
  for (int d0 = 0; d0 < 8; ++d0) qr[d0] = *reinterpret_cast<const bf16x8*>(Qw + d0 * 16);
  const int sr = tid >> 4, sc = (tid & 15) * 8, vst0 = v_st(sr, sc), vst1 = v_st(32 + sr, sc);
  const unsigned loff = (unsigned)sr * (unsigned)ldk * 2u + (unsigned)sc * 2u;
  const int vb0 = (int)(uintptr_t)V_lds + v_rd_base(lane);
  struct { bf16x8 vs0, vs1, ks0, ks1; } sr_[2];
#define TILEK0(jt) ((MODE == 1) ? 64 * min(max(t0 + (jt), 0), tmax - 1) : 64 * (t0 + (jt)))
#define TILEDI(jt) ((MODE == 1 && ((t0 + (jt)) < 0 || (t0 + (jt)) >= tmax)) ? 1e9f : (dq - 64.f * (float)(jt)))
#define SLOAD(i, jt) do { const size_t t_ = (size_t)(TILEK0(jt)) * (size_t)ldk * 2; const char* vt_ = (const char*)Vh + t_; const char* kt_ = (const char*)Kh + t_;     \
    sr_[i].vs0 = *reinterpret_cast<const bf16x8*>(vt_ + loff); sr_[i].vs1 = *reinterpret_cast<const bf16x8*>(vt_ + (size_t)ldk * 64 + loff); \
    sr_[i].ks0 = *reinterpret_cast<const bf16x8*>(kt_ + loff); sr_[i].ks1 = *reinterpret_cast<const bf16x8*>(kt_ + (size_t)ldk * 64 + loff); } while (0)
#define SWRITE(b, i) do { *(bf16x8*)((char*)V_lds + (b) * SHM_V + vst0) = sr_[i].vs0;          \
    *(bf16x8*)((char*)V_lds + (b) * SHM_V + vst1) = sr_[i].vs1; int kc = sc * 2;               \
    *(bf16x8*)((char*)K_lds + (b) * SHM_K + KSWZ(sr, kc)) = sr_[i].ks0;                       \
    *(bf16x8*)((char*)K_lds + (b) * SHM_K + KSWZ(32 + sr, kc)) = sr_[i].ks1; } while (0)
#define SWAIT() asm volatile("s_waitcnt vmcnt(4)" ::: "memory")
#define RESC(a) do { if (__any((a) < 1.f)) { if (hi == 0) al_l[r32] = (a); asm volatile("s_waitcnt lgkmcnt(0)" ::: "memory"); \
    _Pragma("unroll") for (int d = 0; d < 4; ++d) _Pragma("unroll") for (int r = 0; r < 16; ++r) o[d][r] *= al_l[crow(r, hi)]; } } while (0)
  f32x16 pA0, pA1, pB0, pB1; float mnA, mnB, alA = 1.f, alB = 1.f; bf16x8 pa0, pa1, pa2, pa3;
  constexpr int SE = 0, SO = 1;
  const int wv2 = wave_id >> 1;
#define NEED(jt) (MODE != 1 || ((jt) >= wv2 && (jt) <= wv2 + 2))
  SLOAD(SE, 0); asm volatile("s_waitcnt vmcnt(0)" ::: "memory"); SWRITE(0, SE); __syncthreads();
  if (NEED(0)) { qkt(pA0, pA1, K_lds, qr, r32, hi); partialSM<MODE>(pA0, pA1, m_reg, mnA, alA, TILEDI(0), sl2); }
  SLOAD(SO, 1); if (2 < NT) SLOAD(SE, 2);
  SWAIT(); SWRITE(1, SO); __syncthreads();
  for (int j = 1; j + 1 < NT; j += 2) {
    SBAR(); if (NEED(j)) qkt(pB0, pB1, (bf16*)((char*)K_lds + SHM_K), qr, r32, hi);
    if (NEED(j - 1)) finishSM(pA0, pA1, alA, l_reg, pa0, pa1, pa2, pa3); SBAR();
    SLOAD(SO, j + 2); SBAR();
    if (NEED(j - 1)) pv_d0(o, vb0, pa0, pa1, pa2, pa3); if (NEED(j)) partialSM<MODE>(pB0, pB1, m_reg, mnB, alB, TILEDI(j), sl2);
    __syncthreads(); SWAIT(); SWRITE(0, SE);
    if (NEED(j)) RESC(alB); __syncthreads();
    SBAR(); if (NEED(j + 1)) qkt(pA0, pA1, K_lds, qr, r32, hi);
    if (NEED(j)) finishSM(pB0, pB1, alB, l_reg, pa0, pa1, pa2, pa3); SBAR();
    if (j + 3 < NT) SLOAD(SE, j + 3); SBAR();
    if (NEED(j)) pv_d0(o, vb0 + (int)SHM_V, pa0, pa1, pa2, pa3); if (NEED(j + 1)) partialSM<MODE>(pA0, pA1, m_reg, mnA, alA, TILEDI(j + 1), sl2);
    __syncthreads(); SWAIT(); SWRITE(1, SO);
    if (NEED(j + 1)) RESC(alA); __syncthreads();
  }
  SBAR(); if (NEED(NT - 1)) qkt(pB0, pB1, (bf16*)((char*)K_lds + SHM_K), qr, r32, hi);
  if (NEED(NT - 2)) finishSM(pA0, pA1, alA, l_reg, pa0, pa1, pa2, pa3); SBAR();
  if (NEED(NT - 2)) pv_d0(o, vb0, pa0, pa1, pa2, pa3); if (NEED(NT - 1)) partialSM<MODE>(pB0, pB1, m_reg, mnB, alB, TILEDI(NT - 1), sl2);
  __syncthreads(); if (NEED(NT - 1)) RESC(alB);
  if (NEED(NT - 1)) { finishSM(pB0, pB1, alB, l_reg, pa0, pa1, pa2, pa3); SBAR();
  pv_d0(o, vb0 + (int)SHM_V, pa0, pa1, pa2, pa3); }
  asm volatile("s_waitcnt vmcnt(0)" ::: "memory");
#undef NEED
#undef TILEK0
#undef TILEDI
#undef SLOAD
#undef SWRITE
#undef SWAIT
#undef RESC
}

constexpr int K2_ROWB = 272, K2_BYTES = 64 * K2_ROWB  , V2_BYTES = 2 * 16384, BUF2_BYTES = K2_BYTES + V2_BYTES, WS2_OFF = 2 * BUF2_BYTES  ;
__device__ __forceinline__ void qkt2(f32x16& p0, f32x16& p1, const char* kb, const bf16x8* qr) {
  p0 = f32x16{}; p1 = f32x16{};
#pragma unroll
  for (int d0 = 0; d0 < 8; ++d0) {
    const bf16x8 b0 = *reinterpret_cast<const bf16x8*>(kb + d0 * 32), b1 = *reinterpret_cast<const bf16x8*>(kb + 32 * K2_ROWB + d0 * 32);
    p0 = __builtin_amdgcn_mfma_f32_32x32x16_bf16(b0, qr[d0], p0, 0, 0, 0);
    p1 = __builtin_amdgcn_mfma_f32_32x32x16_bf16(b1, qr[d0], p1, 0, 0, 0); }
}
__device__ __forceinline__ void attn_core_dv256(const bf16* __restrict__ Qb, const bf16* __restrict__ Kh, const bf16* __restrict__ Vh, unsigned ld, int NT, int t0,
                                                float dq, float sl2, int wave_id, int wlo, int whi, char* lds, f32x16 (&o)[8], float& m_reg, float& l_reg) {
  const int lane = lane_id_fresh(); asm volatile("" : "+v"(dq));
  const int r32 = lane & 31, hi = lane >> 5;
  float* al_l = (float*)(lds + WS2_OFF) + wave_id * 64 + 32;
  m_reg = -1e30f; l_reg = 0.f;
#pragma unroll
  for (int d = 0; d < 8; ++d) o[d] = f32x16{};
  bf16x8 qr[8];
  { const bf16* Qw = Qb + (size_t)(wave_id * QBLK + r32) * ld + hi * 8;
#pragma unroll
    for (int d0 = 0; d0 < 8; ++d0) qr[d0] = *reinterpret_cast<const bf16x8*>(Qw + d0 * 16); }
  unsigned kof[3];
#pragma unroll
  for (int i = 0; i < 3; ++i) { const int L = (wave_id + 8 * i) * 64 + lane, row = L / 17, slot = L - row * 17; kof[i] = (unsigned)row * ld * 2u + (unsigned)(slot > 15 ? 15 : slot) * 16u; }
  unsigned vof;
  { const int sub = 2 * wave_id + (lane >> 5), kk = (sub >> 2) * 8 + ((lane & 31) >> 2), k = (kk & ~0xC) | ((kk & 4) << 1) | ((kk & 8) >> 1), cc = (sub & 3) * 32 + (lane & 3) * 8;
    vof = (unsigned)k * ld * 2u + (unsigned)cc * 2u; }
  typedef __attribute__((address_space(3))) unsigned lds_u32;
#define DMA2(jt, b) do { const size_t tb_ = (size_t)(t0 + (jt)) * 64 * (size_t)ld * 2; const char* kt_ = (const char*)Kh + tb_; const char* vt_ = (const char*)Vh + tb_; \
    lds_u32* kl_ = (lds_u32*)(lds + (b) * BUF2_BYTES); lds_u32* vl_ = (lds_u32*)(lds + (b) * BUF2_BYTES + K2_BYTES); \
    __builtin_amdgcn_global_load_lds((const unsigned*)(kt_ + kof[0]), kl_ + wave_id * 256, 16, 0, 0); \
    __builtin_amdgcn_global_load_lds((const unsigned*)(kt_ + kof[1]), kl_ + (wave_id + 8) * 256, 16, 0, 0); \
    if (wave_id == 0) __builtin_amdgcn_global_load_lds((const unsigned*)(kt_ + kof[2]), kl_ + 16 * 256, 16, 0, 0); \
    __builtin_amdgcn_global_load_lds((const unsigned*)(vt_ + vof), vl_ + wave_id * 256, 16, 0, 0); \
    __builtin_amdgcn_global_load_lds((const unsigned*)(vt_ + (size_t)ld * 64 + vof), vl_ + (wave_id + 8) * 256, 16, 0, 0); \
    __builtin_amdgcn_global_load_lds((const unsigned*)(vt_ + 256 + vof), vl_ + 4096 + wave_id * 256, 16, 0, 0); \
    __builtin_amdgcn_global_load_lds((const unsigned*)(vt_ + (size_t)ld * 64 + 256 + vof), vl_ + 4096 + (wave_id + 8) * 256, 16, 0, 0); } while (0)
  const int kbase = r32 * K2_ROWB + hi * 16, vb0 = (int)(uintptr_t)lds + K2_BYTES + v_rd_base(lane);
  __syncthreads();
  DMA2(0, 0);
#define PASS_TILE(j) do { asm volatile("s_waitcnt vmcnt(0)" ::: "memory"); __syncthreads(); if ((j) + 1 < NT) DMA2((j) + 1, ((j) & 1) ^ 1); } while (0)
#pragma unroll 1
  for (int j = 0; j < wlo; ++j) PASS_TILE(j);
#pragma unroll 1
  for (int j = wlo; j <= whi; ++j) {
    const int b = j & 1;
    asm volatile("s_waitcnt vmcnt(0)" ::: "memory"); __syncthreads();
    if (j + 1 < NT) DMA2(j + 1, b ^ 1);
    f32x16 p0, p1; float mn, alpha; bf16x8 pa0, pa1, pa2, pa3;
    qkt2(p0, p1, lds + b * BUF2_BYTES + kbase, qr);
    partialSM<0>(p0, p1, m_reg, mn, alpha, dq - 64.f * (float)j, sl2);
    if (__any(alpha < 1.f)) { if (hi == 0) al_l[r32] = alpha; asm volatile("s_waitcnt lgkmcnt(0)" ::: "memory");
#pragma unroll
      for (int d = 0; d < 8; ++d)
#pragma unroll
        for (int r = 0; r < 16; ++r) o[d][r] *= al_l[crow(r, hi)]; }
    finishSM(p0, p1, alpha, l_reg, pa0, pa1, pa2, pa3); SBAR();
    const int vb = vb0 + b * BUF2_BYTES;
    pv_d0(o, vb, pa0, pa1, pa2, pa3);
    pv_d0(o + 4, vb + 16384, pa0, pa1, pa2, pa3);
  }
#pragma unroll 1
  for (int j = whi + 1; j < NT; ++j) PASS_TILE(j);
  asm volatile("s_waitcnt vmcnt(0)" ::: "memory");
#undef PASS_TILE
#undef DMA2
}
}

#ifndef PG8_SP2
#define PG8_SP2 true
#endif
#ifndef PG8_ALIGN
#define PG8_ALIGN true
#endif
constexpr int NWAVES = 8;
constexpr int BATCH = 4, SEQ = 4096, DM = 4096, FF = 11008, M = BATCH * SEQ;
constexpr int NIN = 23552, NQKV = 15360, NGATE = 8192, PLE = 256;
constexpr float LN_EPS = 1e-5f, SUBLN_EPS = 1e-5f;
constexpr float ALPHA = 1.189207115002721f;
constexpr float LAMBDA_INIT = 0.2f;
constexpr float QSCALE = 0.08838834764831845f * 1.4426950408889634f;
constexpr float LOG2E = 1.4426950408889634f;

constexpr size_t MiB = 1u << 20;
constexpr size_t WS_CTL = 0, CTL_ZERO_BYTES = 1 * MiB;
constexpr size_t WS_W1IN = 1 * MiB, WS_W1OUT = WS_W1IN + 172 * MiB;
constexpr size_t WS_GATES = WS_W1IN;
constexpr size_t WS_WIN = WS_W1OUT + 86 * MiB;
constexpr size_t WS_WA = WS_WIN + 184 * MiB, WS_WB = WS_WA + 16 * MiB, WS_WOUT = WS_WB + 8 * MiB;
constexpr size_t WS_W2IN = WS_WOUT + 32 * MiB, WS_W2OUT = WS_W2IN + 172 * MiB;
constexpr size_t WS_WG = WS_W2OUT + 86 * MiB, WS_WP = WS_WG + 32 * MiB;
constexpr size_t WS_HB = WS_WP + 2 * MiB;
constexpr size_t WS_BIG = WS_HB + 128 * MiB;
constexpr size_t WS_Y1 = WS_BIG, WS_Y = WS_BIG + 256 * MiB;
constexpr size_t WS_OA = WS_BIG + 480 * MiB;
constexpr size_t WS_OB = WS_OA + 64 * MiB;
constexpr size_t WS_DILP = WS_OB + 32 * MiB;
constexpr size_t WS_LSE = WS_DILP + 96 * MiB;
constexpr size_t WS_SCR = WS_LSE + 2 * MiB;
constexpr size_t WS_PB = WS_SCR + 64 * MiB;
constexpr size_t WS_PP = WS_PB + 8 * MiB;
constexpr size_t WS_NRM = WS_PP + 128 * MiB;
constexpr size_t WS_CP = WS_NRM + 8 * MiB, WS_DP = WS_CP + 13 * MiB;
constexpr size_t WS_PART = WS_DP + 13 * MiB;
constexpr size_t WS_END = WS_PART + 6 * MiB;
static_assert(WS_GATES + (size_t)M * NGATE * 2 <= WS_WIN, "gates overlay fits in the FFN1 weight region");
static_assert((size_t)M * NQKV * 2 <= 480 * MiB && (size_t)M * FF * 2 <= 480 * MiB, "BIG region");
#ifndef FFOUT_WGM
#define FFOUT_WGM 4
#endif
constexpr int CW_QA = 8192, CW_QB = 8256;
constexpr int NCV = NIN + 2 * FF + DM, CV1 = 0, CV2 = NIN, CV3 = NIN + 2 * FF;
constexpr int CW_CV = 16384;
static_assert((size_t)(CW_CV + 2 * NCV) * 4 <= CTL_ZERO_BYTES && (size_t)64 * NCV * 4 <= 13 * MiB, "CTL / partial-sum maps");
constexpr int CW_SPLIT = 8704;
constexpr int CW_BAR = 4096;

constexpr int RING_OFF = 0, RING_BYTES = 131072;
constexpr int LDSCTL_OFF = RING_BYTES, MISC_OFF = LDSCTL_OFF + 320;
constexpr int LDS_BYTES = 147456;
constexpr int ATT_RED_OFF = 69632 + 8 * 4096;
constexpr float PRUNE_T = 38.0f;
constexpr int ATT_STASH_OFF = 69632;
static_assert(att::SHM_ATTN <= ATT_STASH_OFF && ATT_RED_OFF + 256 <= RING_BYTES && att::WS2_OFF + 2048 <= ATT_RED_OFF, "attention LDS map");

#define GAS __attribute__((address_space(1)))
#define LAS __attribute__((address_space(3)))
typedef unsigned short bf16;
typedef unsigned v4u __attribute__((ext_vector_type(4)));
typedef float f32x4 __attribute__((ext_vector_type(4)));
typedef short bf16x8 __attribute__((ext_vector_type(8)));
typedef GAS unsigned gu32;
typedef GAS unsigned long long gu64;
#define RLX_AGENT __ATOMIC_RELAXED, __HIP_MEMORY_SCOPE_AGENT
#define LDS_WAIT() asm volatile("s_waitcnt lgkmcnt(0)" ::: "memory")
#define VM_WAIT() asm volatile("s_waitcnt vmcnt(0)" ::: "memory")
__device__ __forceinline__ unsigned long long rt() { return __builtin_amdgcn_s_memrealtime(); }
__device__ __forceinline__ unsigned f2bf(float f) { unsigned u = __builtin_bit_cast(unsigned, f); return (u + 0x7fffu + ((u >> 16) & 1u)) >> 16; }
__device__ __forceinline__ unsigned pk2(float lo, float hi) { return f2bf(lo) | (f2bf(hi) << 16); }

#define XB_TMO      128
#define XB_XCNT(j)  (256  + 64 * (j))
#define XB_XSUB(j)  (1280 + 64 * (j))
#define XB_XGEN(j)  (2304 + 64 * (j))
#define XB_TOP      3328
#define XB_TOPGEN   3392
#define XCD_BAR_WORDS 3456
#define XB_SPIN_CAP (1u << 18)

__device__ __forceinline__ unsigned xb_ld(unsigned* p)              { return __hip_atomic_load(p, __ATOMIC_RELAXED, __HIP_MEMORY_SCOPE_AGENT); }
__device__ __forceinline__ unsigned xb_add(unsigned* p, unsigned v) { return __hip_atomic_fetch_add(p, v, __ATOMIC_RELAXED, __HIP_MEMORY_SCOPE_AGENT); }
__device__ __forceinline__ unsigned xb_xcc_id() { return (unsigned)__builtin_amdgcn_s_getreg((3 << 11) | 20) & 0xFu; }
#define XB_SPIN(cond, bar) do { unsigned _sp = 0; while (cond) { __builtin_amdgcn_s_sleep(1); \
    if ((++_sp & 255u) == 0u) { if (xb_ld(&(bar)[XB_TMO])) break; if (_sp > XB_SPIN_CAP) { atomicAdd(&(bar)[XB_TMO], 1u); break; } } } } while (0)

struct XcdBarrier {
    unsigned* bar; unsigned x;
    volatile LAS unsigned* st;
};

__device__ __forceinline__ XcdBarrier xcd_barrier_post(unsigned* bar, volatile LAS unsigned* st, bool thread0) {
    XcdBarrier b; b.bar = bar; b.x = xb_xcc_id(); b.st = st;
    if (thread0) (void)xb_add(&bar[XB_XCNT(b.x)], 1u);
    return b;
}
__device__ __forceinline__ void xcd_barrier_complete(unsigned* bar, unsigned x, unsigned& nloc, unsigned& nx) {
    const unsigned G = gridDim.x * gridDim.y * gridDim.z;
    unsigned sum, cnt, mine, sp = 0u;
    for (;;) {
        sum = 0u; cnt = 0u; mine = 0u;
#pragma unroll
        for (unsigned j = 0; j < 16; ++j) { const unsigned c = xb_ld(&bar[XB_XCNT(j)]); sum += c; cnt += (c > 0u) ? 1u : 0u; mine = (j == x) ? c : mine; }
        if (sum == G) break;
        __builtin_amdgcn_s_sleep(1);
        if ((++sp & 255u) == 0u) { if (xb_ld(&bar[XB_TMO])) break; if (sp > XB_SPIN_CAP) { atomicAdd(&bar[XB_TMO], 1u); break; } }
    }
    nloc = mine > 0u ? mine : 1u; nx = cnt > 0u ? cnt : 1u;
}

__device__ __forceinline__ void xcd_barrier(const XcdBarrier& b, bool thread0) {
    asm volatile("s_waitcnt vmcnt(0)" ::: "memory");
    __syncthreads();
    if (thread0) {
        unsigned* bar = b.bar;
        __builtin_amdgcn_s_waitcnt(0);
        unsigned nloc = b.st[0], nx = b.st[1];
        if (nloc == 0u) { xcd_barrier_complete(bar, b.x, nloc, nx); b.st[0] = nloc; b.st[1] = nx; }
        const unsigned old = xb_add(&bar[XB_XSUB(b.x)], 1u);
        const unsigned gen = old / nloc;
        if (old + 1u == (gen + 1u) * nloc) {
            __builtin_amdgcn_fence(__ATOMIC_RELEASE, "agent");
            asm volatile("s_waitcnt vmcnt(0)" ::: "memory");
            const unsigned og = xb_add(&bar[XB_TOP], 1u);
            const unsigned tg = og / nx;
            if (og + 1u == (tg + 1u) * nx) xb_add(&bar[XB_TOPGEN], 1u);
            else XB_SPIN(xb_ld(&bar[XB_TOPGEN]) == tg, bar);
            __builtin_amdgcn_fence(__ATOMIC_ACQUIRE, "agent");
            xb_add(&bar[XB_XGEN(b.x)], 1u);
            asm volatile("s_waitcnt vmcnt(0)" ::: "memory");
        } else {
            XB_SPIN(xb_ld(&bar[XB_XGEN(b.x)]) == gen, bar);
            __builtin_amdgcn_fence(__ATOMIC_ACQUIRE, "agent");
            asm volatile("s_waitcnt vmcnt(0)" ::: "memory");
        }
    }
    __syncthreads();
}
struct Frame {
    LAS unsigned char* lds;
    volatile LAS unsigned* MISC;
    gu32* ctl;
    int tid, lane, wave;
    int vcu, G;
};
typedef float f32x8v __attribute__((ext_vector_type(8)));
__device__ __forceinline__ float wave_sum(float v) { XL_RED64(xl_add, v); return v; }
template <bool FOLD>
__device__ __forceinline__ void p0_transpose_item(const float* W, int K, int N, bf16* WT, int dpitch, int dst_row0, LAS float* scr, int k0, int n0, int lane, const float* g, const float* bb, float* cp, float* dp) {
#pragma unroll 8
    for (int i = 0; i < 32; ++i) { const int kk = 2 * i + (lane >> 5); scr[kk * 33 + (lane & 31)] = W[(size_t)(k0 + kk) * N + n0 + (lane & 31)]; }
    LDS_WAIT(); asm volatile("" ::: "memory");
    const int c = lane & 7;
    float gv[8], bv[8];
    if (FOLD) { const f32x4 g0 = *(const GAS f32x4*)(g + k0 + 8 * c), g1 = *(const GAS f32x4*)(g + k0 + 8 * c + 4), b0 = *(const GAS f32x4*)(bb + k0 + 8 * c), b1 = *(const GAS f32x4*)(bb + k0 + 8 * c + 4);
#pragma unroll
        for (int i = 0; i < 4; ++i) { gv[i] = g0[i]; gv[4 + i] = g1[i]; bv[i] = b0[i]; bv[4 + i] = b1[i]; } }
#pragma unroll
    for (int j = 0; j < 4; ++j) { const int n = (lane >> 3) + 8 * j; const LAS float* s = scr + (8 * c) * 33 + n;
        float w[8];
#pragma unroll
        for (int i = 0; i < 8; ++i) w[i] = s[i * 33];
        float ds = 0.f;
        if (FOLD) {
#pragma unroll
            for (int i = 0; i < 8; ++i) { ds += w[i] * bv[i]; w[i] *= gv[i]; } }
        v4u o; o.x = pk2(w[0], w[1]); o.y = pk2(w[2], w[3]); o.z = pk2(w[4], w[5]); o.w = pk2(w[6], w[7]);
        *(GAS v4u*)(WT + (size_t)(dst_row0 + n) * dpitch + k0 + 8 * c) = o;
        if (FOLD) { float cs = ((__uint_as_float(o.x << 16) + __uint_as_float(o.x & 0xffff0000u)) + (__uint_as_float(o.y << 16) + __uint_as_float(o.y & 0xffff0000u)))
                             + ((__uint_as_float(o.z << 16) + __uint_as_float(o.z & 0xffff0000u)) + (__uint_as_float(o.w << 16) + __uint_as_float(o.w & 0xffff0000u)));
            XL_RED8(xl_add, cs); XL_RED8(xl_add, ds);
            if (c == 0) { cp[dst_row0 + n] = cs; dp[dst_row0 + n] = ds; } } }
    LDS_WAIT(); asm volatile("" ::: "memory");
}
__device__ __forceinline__ void cvt_rows(Frame& F, const float* src, bf16* dst, size_t n8) {
    const size_t gt = (size_t)(F.vcu * NWAVES + F.wave) * 64 + F.lane, NT = (size_t)F.G * NWAVES * 64;
    for (size_t i = gt; i < n8; i += NT) { const f32x8v x = *(const GAS f32x8v*)(src + i * 8);
        v4u o; o.x = pk2(x[0], x[1]); o.y = pk2(x[2], x[3]); o.z = pk2(x[4], x[5]); o.w = pk2(x[6], x[7]); *(GAS v4u*)(dst + i * 8) = o; }
}

__device__ __forceinline__ void p0_prologue(Frame& F, KargP a) {
    LAS float* scr = (LAS float*)(F.lds + RING_OFF + F.wave * 16384);
    const int gw = F.vcu * NWAVES + F.wave, NGW = F.G * NWAVES;
    unsigned char* ws = a->ws;
#define TR_MAT(SRC, KK, NN, DST, SWI, FOLD, GV, BV, CVO) TR_MATP(SRC, KK, NN, DST, KK, SWI, FOLD, GV, BV, CVO)
#define TR_MATP(SRC, KK, NN, DST, DPITCH, SWI, FOLD, GV, BV, CVO) do { const int nblk = (NN) / 32, nit = ((KK) / 64) * nblk; \
        for (int it = gw; it < nit; it += NGW) { const int kb = it / nblk, nb = it % nblk, n0 = 32 * nb; int dr = n0; \
            if (SWI) { const int c = n0 < FF ? n0 : n0 - FF; dr = (c >> 7) * 256 + (c & 127) + (n0 < FF ? 0 : 128); } \
            p0_transpose_item<FOLD>((SRC), (KK), (NN), (bf16*)(ws + (DST)), (DPITCH), dr, scr, 64 * kb, n0, F.lane, (GV), (BV), (float*)(ws + WS_CP) + (size_t)kb * NCV + (CVO), (float*)(ws + WS_DP) + (size_t)kb * NCV + (CVO)); } } while (0)
    TR_MAT(a->in[2], DM, 2 * FF, WS_W1IN, true, false, nullptr, nullptr, 0);
    TR_MAT(a->in[3], FF, DM, WS_W1OUT, false, false, nullptr, nullptr, 0);
    TR_MAT(a->in[6], DM, NIN, WS_WIN, false, true, a->in[4], a->in[5], CV1);
    TR_MATP(a->in[12], 2048, DM, WS_WA, 3072, false, false, nullptr, nullptr, 0);
    TR_MATP(a->in[13], 1024, DM, WS_WA + 2048 * 2, 3072, false, false, nullptr, nullptr, 0);
    TR_MAT(a->in[14], DM, DM, WS_WOUT, false, false, nullptr, nullptr, 0);
    TR_MAT(a->in[17], DM, 2 * FF, WS_W2IN, true, true, a->in[15], a->in[16], CV2);
    TR_MAT(a->in[18], FF, DM, WS_W2OUT, false, false, nullptr, nullptr, 0);
    TR_MAT(a->in[21], DM, DM, WS_WG, false, true, a->in[19], a->in[20], CV3);
    TR_MAT(a->in[22], PLE, DM, WS_WP, false, false, nullptr, nullptr, 0);
#undef TR_MAT
#undef TR_MATP
    cvt_rows(F, a->in[0], (bf16*)(ws + WS_HB), (size_t)M * DM / 8);
    cvt_rows(F, a->in[1], (bf16*)(ws + WS_PB), (size_t)M * PLE / 8);
}
__device__ __forceinline__ void colsum_reduce(Frame& F, unsigned char* ws) {
    const int gt = (F.vcu * NWAVES + F.wave) * 64 + F.lane, NT = F.G * NWAVES * 64;
    const float* cp = (const float*)(ws + WS_CP); const float* dp = (const float*)(ws + WS_DP); float* cv = (float*)(ws + WS_CTL) + CW_CV;
    for (int n = gt; n < NCV; n += NT) { float c = 0.f, d = 0.f;
#pragma unroll 8
        for (int kb = 0; kb < 64; ++kb) { c += cp[(size_t)kb * NCV + n]; d += dp[(size_t)kb * NCV + n]; }
        cv[n] = c; cv[NCV + n] = d; }
}
__device__ __forceinline__ int ln_table(Frame& F, const float* part, int N, int wgm = 8) {
    pg8::StaticOrder S0; S0.init(M, N, F.G, (int)blockIdx.x, wgm); pg8::Unit u0, u2; S0.next(0, u0); u2 = u0; if (wgm != 8) S0.next(2, u2);
#pragma unroll
    for (int t = 0; t < 2; ++t) { const int pm = t ? u2.pm : u0.pm;
        if (F.tid < 256) { const GAS f32x4* p = (const GAS f32x4*)(part + (size_t)(pm * 256 + F.tid) * 32); float s1 = 0.f, s2 = 0.f;
#pragma unroll
            for (int i = 0; i < 8; ++i) { const f32x4 v = p[i]; s1 += v[0] + v[2]; s2 += v[1] + v[3]; }
            const float mu = s1 * (1.f / DM), var = fmaxf(s2 * (1.f / DM) - mu * mu, 0.f);
            *(LAS pg8::f32x2s*)(F.lds + pg8::LDS_STAB + (t * 256 + F.tid) * 8) = (pg8::f32x2s){mu, 1.f / sqrtf(var + LN_EPS)}; } }
    __syncthreads();
    return u0.pm;
}
template <bool WB>
__device__ __forceinline__ void ln_phase(Frame& F, float* hf, const float* g, const float* b, bf16* hb) {
    const int gw = F.vcu * NWAVES + F.wave, NGW = F.G * NWAVES;
    for (int m = gw; m < M; m += NGW) {
        GAS f32x4* xr = (GAS f32x4*)(hf + (size_t)m * DM) + F.lane;
        f32x4 v[16]; float s = 0.f;
#pragma unroll
        for (int j = 0; j < 16; ++j) { v[j] = xr[64 * j]; s += (v[j].x + v[j].y) + (v[j].z + v[j].w); }
        const float mean = wave_sum(s) * (1.f / DM); float s2 = 0.f;
#pragma unroll
        for (int j = 0; j < 16; ++j) { v[j] = v[j] - mean; s2 += (v[j].x * v[j].x + v[j].y * v[j].y) + (v[j].z * v[j].z + v[j].w * v[j].w); }
        const float rstd = 1.f / sqrtf(wave_sum(s2) * (1.f / DM) + LN_EPS);
        GAS unsigned long long* o8 = (GAS unsigned long long*)(hb + (size_t)m * DM) + F.lane;
#pragma unroll
        for (int j = 0; j < 16; ++j) { const f32x4 gv = *((const GAS f32x4*)g + F.lane + 64 * j), bv = *((const GAS f32x4*)b + F.lane + 64 * j);
            const f32x4 y = v[j] * rstd * gv + bv; xr[64 * j] = y;
            if (WB) o8[64 * j] = (unsigned long long)pk2(y.x, y.y) | ((unsigned long long)pk2(y.z, y.w) << 32); }
    }
}
__device__ __forceinline__ void ln4_phase(Frame& F, const bf16* src, float* out, const float* g, const float* b) {
    const int gw = F.vcu * NWAVES + F.wave, NGW = F.G * NWAVES;
    for (int m = gw; m < M; m += 2 * NGW) {
        v4u w[2][8]; float s[2] = {0.f, 0.f}, s2[2] = {0.f, 0.f};
#pragma unroll
        for (int t = 0; t < 2; ++t) { const GAS v4u* xr = (const GAS v4u*)(src + (size_t)(m + t * NGW) * DM) + F.lane;
#pragma unroll
            for (int j = 0; j < 8; ++j) w[t][j] = xr[64 * j]; }
        float mean[2], rstd[2];
#pragma unroll
        for (int t = 0; t < 2; ++t) {
#pragma unroll
            for (int j = 0; j < 8; ++j) { const unsigned u[4] = {w[t][j].x, w[t][j].y, w[t][j].z, w[t][j].w};
#pragma unroll
                for (int i = 0; i < 4; ++i) s[t] += __uint_as_float(u[i] << 16) + __uint_as_float(u[i] & 0xffff0000u); }
            mean[t] = wave_sum(s[t]) * (1.f / DM);
#pragma unroll
            for (int j = 0; j < 8; ++j) { const unsigned u[4] = {w[t][j].x, w[t][j].y, w[t][j].z, w[t][j].w};
#pragma unroll
                for (int i = 0; i < 4; ++i) { const float d0 = __uint_as_float(u[i] << 16) - mean[t], d1 = __uint_as_float(u[i] & 0xffff0000u) - mean[t]; s2[t] += d0 * d0 + d1 * d1; } }
            rstd[t] = 1.f / sqrtf(wave_sum(s2[t]) * (1.f / DM) + LN_EPS); }
#pragma unroll
        for (int j = 0; j < 8; ++j) { const GAS f32x4* gp = (const GAS f32x4*)g + 2 * (F.lane + 64 * j); const GAS f32x4* bp = (const GAS f32x4*)b + 2 * (F.lane + 64 * j);
            const f32x4 g0 = gp[0], g1 = gp[1], b0 = bp[0], b1 = bp[1];
#pragma unroll
            for (int t = 0; t < 2; ++t) { const v4u u = w[t][j]; GAS f32x4* o = (GAS f32x4*)(out + (size_t)(m + t * NGW) * DM) + 2 * (F.lane + 64 * j);
                const f32x4 x0 = {__uint_as_float(u.x << 16), __uint_as_float(u.x & 0xffff0000u), __uint_as_float(u.y << 16), __uint_as_float(u.y & 0xffff0000u)};
                const f32x4 x1 = {__uint_as_float(u.z << 16), __uint_as_float(u.z & 0xffff0000u), __uint_as_float(u.w << 16), __uint_as_float(u.w & 0xffff0000u)};
                o[0] = (x0 - mean[t]) * rstd[t] * g0 + b0; o[1] = (x1 - mean[t]) * rstd[t] * g1 + b1; } }
    }
}
__device__ __forceinline__ void combine_phase(Frame& F, const bf16* dilp, const float* lse, bf16* ob) {
    const int gw = F.vcu * NWAVES + F.wave, NGW = F.G * NWAVES;
    for (int m = gw; m < M; m += NGW) {
        const int h = F.lane >> 3;
        const float l0 = lse[(size_t)m * 8 + h], l1 = lse[(size_t)M * 8 + (size_t)m * 8 + h], l2 = lse[(size_t)2 * M * 8 + (size_t)m * 8 + h];
        const float mx = fmaxf(l0, fmaxf(l1, l2));
        float w0 = __builtin_amdgcn_exp2f(l0 - mx), w1 = __builtin_amdgcn_exp2f(l1 - mx), w2 = __builtin_amdgcn_exp2f(l2 - mx);
        const float inv = 1.f / (w0 + w1 + w2); w0 *= inv; w1 *= inv; w2 *= inv;
        float acc[16];
#pragma unroll
        for (int i = 0; i < 16; ++i) acc[i] = 0.f;
#pragma unroll
        for (int g = 0; g < 3; ++g) { const float w = g == 0 ? w0 : (g == 1 ? w1 : w2);
            const GAS v4u* p = (const GAS v4u*)(dilp + (size_t)g * M * 1024 + (size_t)m * 1024 + F.lane * 16);
            const v4u a = p[0], c = p[1];
            const unsigned wd[8] = {a.x, a.y, a.z, a.w, c.x, c.y, c.z, c.w};
#pragma unroll
            for (int i = 0; i < 8; ++i) { acc[2 * i] += w * __uint_as_float(wd[i] << 16); acc[2 * i + 1] += w * __uint_as_float(wd[i] & 0xffff0000u); } }
        v4u o0, o1; o0.x = pk2(acc[0], acc[1]); o0.y = pk2(acc[2], acc[3]); o0.z = pk2(acc[4], acc[5]); o0.w = pk2(acc[6], acc[7]);
        o1.x = pk2(acc[8], acc[9]); o1.y = pk2(acc[10], acc[11]); o1.z = pk2(acc[12], acc[13]); o1.w = pk2(acc[14], acc[15]);
        GAS v4u* q = (GAS v4u*)(ob + (size_t)m * 3072 + 2048 + F.lane * 16); q[0] = o0; q[1] = o1;
    }
}

__device__ __forceinline__ void attention_phase(Frame& F, KargP a, char* lds) {
    using att::f32x16; using att::crow;
    unsigned char* ws = a->ws;
    const att::bf16* QKV = (const att::bf16*)(ws + WS_BIG);
    float lam;
    { const int lane = F.lane; const float* q1 = a->in[7]; const float* k1 = a->in[8]; const float* q2 = a->in[9]; const float* k2 = a->in[10];
      const float s1 = wave_sum(q1[lane] * k1[lane] + q1[lane + 64] * k1[lane + 64]), s2 = wave_sum(q2[lane] * k2[lane] + q2[lane + 64] * k2[lane + 64]);
      lam = expf(s1) - expf(s2) + LAMBDA_INIT; ((float*)(lds + ATT_RED_OFF))[44] = lam; }
    const float* subg = a->in[11];
    bf16* OA = (bf16*)(ws + WS_OA);
    float* SCR = (float*)(ws + WS_SCR) + (size_t)blockIdx.x * (2 * 64 * 512);
#ifndef ATT_A
#define ATT_A 1
#endif
#ifndef ATT_B
#define ATT_B 1
#endif
    if (ATT_A) for (;;) {
        __syncthreads();
        if (F.wave == 0 && lane_id_fresh() == 0) ((int*)(lds + ATT_RED_OFF))[40] = (int)__hip_atomic_fetch_add((unsigned*)(F.ctl + CW_QA), 1u, __ATOMIC_RELAXED, __HIP_MEMORY_SCOPE_AGENT);
        __syncthreads();
        const int u = __builtin_amdgcn_readfirstlane(((const int*)(lds + ATT_RED_OFF))[40]);
        if (u >= BATCH * 8 * 16) break;
        const int h = 7 - (u >> 6), b = (u >> 4) & 3, qb = u & 15;
        const size_t rowbase = (size_t)b * SEQ;
        const float sl2 = rfl_f(__builtin_amdgcn_exp2f(-(float)(h + 1)) * LOG2E);
        { const float* NRM = (const float*)(ws + WS_NRM); const int tq = F.wave * 64 + lane_id_fresh();
          float km0 = 0.f, km1 = 0.f, qm0 = 0.f, qm1 = 0.f;
          const GAS f32x4* nk = (const GAS f32x4*)(NRM + rowbase * 128 + (8 + h) * 8);
          for (int j = tq; j < SEQ; j += NWAVES * 64) { const f32x4 a = nk[(size_t)j * 32], c4 = nk[(size_t)j * 32 + 1];
              km0 = fmaxf(km0, (a.x + a.y) + (a.z + a.w)); km1 = fmaxf(km1, (c4.x + c4.y) + (c4.z + c4.w)); }
          float dg = 0.f;
          { const GAS v4u* qp = (const GAS v4u*)(QKV + (rowbase + qb * 256 + (tq & 255)) * NQKV + h * 256 + (tq >> 8) * 128);
            const GAS v4u* kp2 = (const GAS v4u*)(QKV + (rowbase + qb * 256 + (tq & 255)) * NQKV + 2048 + h * 256 + (tq >> 8) * 128);
#pragma unroll 4
            for (int i = 0; i < 16; ++i) { const v4u a = qp[i], c4 = kp2[i];
                dg += __uint_as_float(a.x << 16) * __uint_as_float(c4.x << 16) + __uint_as_float(a.x & 0xffff0000u) * __uint_as_float(c4.x & 0xffff0000u);
                dg += __uint_as_float(a.y << 16) * __uint_as_float(c4.y << 16) + __uint_as_float(a.y & 0xffff0000u) * __uint_as_float(c4.y & 0xffff0000u);
                dg += __uint_as_float(a.z << 16) * __uint_as_float(c4.z << 16) + __uint_as_float(a.z & 0xffff0000u) * __uint_as_float(c4.z & 0xffff0000u);
                dg += __uint_as_float(a.w << 16) * __uint_as_float(c4.w << 16) + __uint_as_float(a.w & 0xffff0000u) * __uint_as_float(c4.w & 0xffff0000u); } }
          if (tq < 256) { const GAS f32x4* nq = (const GAS f32x4*)(NRM + (rowbase + qb * 256 + tq) * 128 + h * 8); const f32x4 a = nq[0], c4 = nq[1];
              qm0 = (a.x + a.y) + (a.z + a.w); qm1 = (c4.x + c4.y) + (c4.z + c4.w); }
          XL_RED64(fminf, dg); XL_RED64(fmaxf, km0); XL_RED64(fmaxf, km1); XL_RED64(fmaxf, qm0); XL_RED64(fmaxf, qm1);
          float* red = (float*)(lds + ATT_RED_OFF);
          __syncthreads();
          if ((tq & 63) == 0) { red[48 + F.wave] = dg; red[F.wave * 4 + 0] = km0; red[F.wave * 4 + 1] = km1; red[F.wave * 4 + 2] = qm0; red[F.wave * 4 + 3] = qm1; }
          __syncthreads();
#pragma unroll
          for (int w = 0; w < NWAVES; ++w) { km0 = fmaxf(km0, red[w * 4 + 0]); km1 = fmaxf(km1, red[w * 4 + 1]); qm0 = fmaxf(qm0, red[w * 4 + 2]); qm1 = fmaxf(qm1, red[w * 4 + 3]); }
#pragma unroll
          for (int c = 0; c < 2; ++c) { const float S = rfl_f(sqrtf((c ? qm1 : qm0) * (c ? km1 : km0))) * 1.01f;
              const float mlb = fmaxf(rfl_f(fminf(fminf(red[48 + 4 * c], red[49 + 4 * c]), fminf(red[50 + 4 * c], red[51 + 4 * c]))) - 0.01f, -S);
              const float dmin = (S - mlb + PRUNE_T) / sl2; const int D = dmin > 8192.f ? 8192 : (int)dmin + 1, q0 = qb * 256;
              int lo = (q0 - 63 - D + 64 * 256) / 64 - 256 + 1; if (lo < 0) lo = 0;
              int hi_t = (q0 + 255 + D + 63) / 64 - 1; if (hi_t > SEQ / 64 - 1) hi_t = SEQ / 64 - 1;
              const int nt = hi_t - lo + 1;
              if (tq == 0) { ((int*)red)[32 + c] = lo; ((int*)red)[34 + c] = nt; ((int*)red)[36 + c] = D; } }
          __syncthreads(); }
        for (int c = 0; c < 2; ++c) {
            const int t0 = __builtin_amdgcn_readfirstlane(((const int*)(lds + ATT_RED_OFF))[32 + c]), NTc = __builtin_amdgcn_readfirstlane(((const int*)(lds + ATT_RED_OFF))[34 + c]);
            const att::bf16* Qb = QKV + (rowbase + qb * 256) * NQKV + h * 256 + c * 128;
            const att::bf16* Kh = QKV + rowbase * NQKV + 2048 + h * 256 + c * 128;
            const att::bf16* Vh = QKV + rowbase * NQKV + 4096 + h * 256;
            f32x16 o[8]; float m_reg, l_reg;
            { const int l0 = lane_id_fresh(); const float dq = (float)(qb * 256 + F.wave * 32 + (l0 & 31) - 4 * (l0 >> 5) - 64 * t0);
              const int Dc = __builtin_amdgcn_readfirstlane(((const int*)(lds + ATT_RED_OFF))[36 + c]), W0 = qb * 256 + F.wave * 32;
              int wlo = (W0 - 63 - Dc + 64 * 256) / 64 - 256 + 1 - t0, whi = (W0 + 31 + Dc + 63) / 64 - 1 - t0; if (wlo < 0) wlo = 0; if (whi > NTc - 1) whi = NTc - 1;
              att::attn_core_dv256(Qb, Kh, Vh, (unsigned)NQKV, NTc, t0, dq, sl2, F.wave, wlo, whi, lds, o, m_reg, l_reg); }
            const int wid = F.wave, lane = lane_id_fresh(), tid = wid * 64 + lane, r32 = lane & 31, hi = lane >> 5;
            float* wsx = (float*)(lds + att::WS2_OFF) + wid * 64;
            if (hi == 0) wsx[r32] = l_reg;
            asm volatile("s_waitcnt lgkmcnt(0)" ::: "memory");
            float rli[16];
#pragma unroll
            for (int r = 0; r < 16; ++r) rli[r] = __builtin_amdgcn_rcpf(wsx[crow(r, hi)]);
            GAS f32x4* scr4 = (GAS f32x4*)(SCR + (size_t)tid * 128); asm volatile("" : "+v"(scr4));
            if (c == 0) {
#pragma unroll
                for (int d0 = 0; d0 < 8; ++d0)
#pragma unroll
                    for (int q = 0; q < 4; ++q) scr4[d0 * 4 + q] = (f32x4){o[d0][4 * q] * rli[4 * q], o[d0][4 * q + 1] * rli[4 * q + 1], o[d0][4 * q + 2] * rli[4 * q + 2], o[d0][4 * q + 3] * rli[4 * q + 3]};
            } else {
                float ssq[16]; const float lam_l = ((const float*)(lds + ATT_RED_OFF))[44];
#pragma unroll
                for (int r = 0; r < 16; ++r) ssq[r] = 0.f;
#pragma unroll
                for (int d0 = 0; d0 < 8; ++d0) {
#pragma unroll
                    for (int q = 0; q < 4; ++q) { f32x4 d = scr4[d0 * 4 + q];
#pragma unroll
                        for (int i = 0; i < 4; ++i) { d[i] = d[i] - lam_l * (o[d0][4 * q + i] * rli[4 * q + i]); ssq[4 * q + i] += d[i] * d[i]; }
                        scr4[d0 * 4 + q] = d; }
                    asm volatile("" ::: "memory"); }
#pragma unroll
                for (int r = 0; r < 16; ++r) { float s = ssq[r]; XL_RED32(xl_add, s); ssq[r] = (1.0f - LAMBDA_INIT) / sqrtf(s * (1.f / 256.f) + SUBLN_EPS); }
                GAS bf16* orow = (GAS bf16*)(OA + (rowbase + qb * 256 + wid * 32) * 3072 + h * 256 + r32); asm volatile("" : "+v"(orow));
#pragma unroll
                for (int d0 = 0; d0 < 8; ++d0) { const float g = subg[d0 * 32 + r32];
#pragma unroll
                    for (int q = 0; q < 4; ++q) { const f32x4 d = scr4[d0 * 4 + q];
#pragma unroll
                        for (int i = 0; i < 4; ++i) orow[(size_t)crow(4 * q + i, hi) * 3072 + d0 * 32] = (bf16)f2bf(d[i] * ssq[4 * q + i] * g); }
                    asm volatile("" ::: "memory"); }
            }
        }
    }
    bf16* DILP = (bf16*)(ws + WS_DILP); float* LSE = (float*)(ws + WS_LSE);
    if (ATT_B) for (;;) {
        __syncthreads();
        if (F.wave == 0 && lane_id_fresh() == 0) ((int*)(lds + 16384))[0] = (int)__hip_atomic_fetch_add((unsigned*)(F.ctl + CW_QB), 1u, __ATOMIC_RELAXED, __HIP_MEMORY_SCOPE_AGENT);
        __syncthreads();
        const int u = __builtin_amdgcn_readfirstlane(((const int*)(lds + 16384))[0]    );
        if (u >= BATCH * 8 * 48) break;
        const int b = u / 384, rem = u % 384, h = rem / 48, rem2 = rem % 48, g = rem2 >> 4, w = rem2 & 15;
        const int dil = g == 0 ? 1 : (g == 1 ? 4 : 16), nU = 16 / dil, cls = w / nU, uu = w % nU, L = SEQ / dil;
        const size_t rowbase = (size_t)b * SEQ + cls;
        const long ld = (long)dil * NQKV;
        const att::bf16* Qb = QKV + (rowbase + (size_t)uu * 256 * dil) * NQKV + 6144 + g * 1024 + h * 128;
        const att::bf16* Kh = QKV + rowbase * NQKV + 9216 + g * 1024 + h * 128;
        const att::bf16* Vh = QKV + rowbase * NQKV + 12288 + g * 1024 + h * 128;
        const float sl2 = rfl_f(__builtin_amdgcn_exp2f(-(float)(3 * h + g + 1) * (1.f / 3.f)) * (float)dil * LOG2E);
        f32x16 o[4]; float m_reg, l_reg;
        { const int l0 = lane_id_fresh(); const float dq = (float)(64 + F.wave * 32 + (l0 & 31) - 4 * (l0 >> 5));
          att::attn_core<1>(Qb, ld, Kh, Vh, ld, 6, 4 * uu - 1, L / 64, dq, sl2, F.wave, lds, o, m_reg, l_reg); }
        const int wid = F.wave, lane = lane_id_fresh(), r32 = lane & 31, hi = lane >> 5;
        float* wsx = (float*)(lds + 4 * 16384) + wid * 64;
        if (hi == 0) wsx[r32] = l_reg;
        asm volatile("s_waitcnt lgkmcnt(0)" ::: "memory");
        float rli[16];
#pragma unroll
        for (int r = 0; r < 16; ++r) rli[r] = __builtin_amdgcn_rcpf(wsx[crow(r, hi)]);
        GAS bf16* obase = (GAS bf16*)(DILP + (size_t)g * M * 1024 + h * 128 + r32); asm volatile("" : "+v"(obase));
#pragma unroll
        for (int r = 0; r < 16; ++r) { const size_t tok = rowbase + (size_t)(uu * 256 + wid * 32 + crow(r, hi)) * dil;
#pragma unroll
            for (int d0 = 0; d0 < 4; ++d0) obase[tok * 1024 + d0 * 32] = (bf16)f2bf(o[d0][r] * rli[r]); }
        if (hi == 0) { const size_t tok = rowbase + (size_t)(uu * 256 + wid * 32 + r32) * dil; LSE[(size_t)g * M * 8 + tok * 8 + h] = m_reg + __builtin_amdgcn_logf(l_reg); }
    }
}

static_assert(PG8_ALIGN, "the residual epilogue's workgroup barrier needs both half-workgroups in their epilogues together (ALIGN_EPI)");
__global__ void __launch_bounds__(NWAVES * 64, 2) mega_fwd(Args args) {
    extern __shared__ __attribute__((aligned(16))) unsigned char lds[];
    Frame F;
    F.lds = (LAS unsigned char*)lds;
    F.MISC = (volatile LAS unsigned*)(F.lds + MISC_OFF);
    F.wave = __builtin_amdgcn_readfirstlane((int)threadIdx.x >> 6); F.lane = lane_id_fresh(); F.tid = F.wave * 64 + F.lane;
    F.G = gridDim.x; { const int bx = blockIdx.x; F.vcu = (F.G % 8 == 0) ? (bx % 8) * (F.G / 8) + bx / 8 : bx; }
    KargP kp = (KargP)__builtin_amdgcn_kernarg_segment_ptr();
#define RELOAD() asm volatile("" : "+s"(kp))
    unsigned char* ws = kp->ws;
    F.ctl = (gu32*)(ws + WS_CTL);
    for (int u = F.tid; u < (LDS_BYTES - LDSCTL_OFF) / 4; u += NWAVES * 64) ((LAS unsigned*)(F.lds + LDSCTL_OFF))[u] = 0u;
    __syncthreads();
    XcdBarrier bar = xcd_barrier_post((unsigned*)(F.ctl + CW_BAR), F.MISC + 8, F.tid == 0);
#define GRID_BAR() do { xcd_barrier(bar, F.wave == 0 && lane_id_fresh() == 0); RELOAD(); ws = kp->ws; F.lane = lane_id_fresh(); F.tid = F.wave * 64 + F.lane; } while (0)
#define GEMM(EPI, A_, B_, N_, K_, E_) GEMMW(EPI, A_, B_, N_, K_, E_, 8)
#define GEMMW(EPI, A_, B_, N_, K_, E_, WGM_) do { pg8::Gemm g_{(const pg8::bf16_t*)(A_), (const pg8::bf16_t*)(B_), M, (N_), (K_), (K_)}; pg8::StaticOrder S_; S_.init(M, (N_), F.G, (int)blockIdx.x, (WGM_)); \
        pg8::gemm_phase<decltype(E_), pg8::StaticOrder, PG8_ALIGN, PG8_SP2>(F.lds + RING_OFF, g_, S_, (E_), F.wave); } while (0)
#define hf (kp->out)
#define hb ((bf16*)(ws + WS_HB))
#define big ((bf16*)(ws + WS_BIG))
#define PARTB(i) ((float*)(ws + WS_PART) + (size_t)(i) * M * 32)
#define CSV(o) ((const float*)(ws + WS_CTL) + CW_CV + (o))
#define DSV(o) ((const float*)(ws + WS_CTL) + CW_CV + NCV + (o))

    p0_prologue(F, kp);
    GRID_BAR();
    { pg8::EpiSwiglu<false> E; E.O = (pg8::bf16_t*)big; E.ldc = FF; E.L = F.lds; E.CS = E.DS = (const float*)ws; GEMM(pg8::EpiSwiglu<false>, hb, ws + WS_W1IN, 2 * FF, DM, E); }
    __syncthreads();
    { constexpr int NU1 = (M / 256) * (2 * FF / 256); const int rem = NU1 % F.G;
      const int gpp = rem ? F.G - rem : F.G, cpp = rem ? (int)blockIdx.x - rem : (int)blockIdx.x;
      if (cpp >= 0) { pg8::EpiBf16Plain E{(pg8::bf16_t*)(ws + WS_PP), DM}; pg8::Gemm g_{(const pg8::bf16_t*)(ws + WS_PB), (const pg8::bf16_t*)(ws + WS_WP), M, DM, PLE, PLE}; pg8::StaticOrder S_; S_.init(M, DM, gpp, cpp);
          pg8::gemm_phase<pg8::EpiBf16Plain, pg8::StaticOrder, PG8_ALIGN, PG8_SP2>(F.lds + RING_OFF, g_, S_, E, F.wave); } }
    GRID_BAR();
    colsum_reduce(F, ws);
    { pg8::EpiResid<true, 0, 1> E; E.X = kp->in[0]; E.HB = (pg8::bf16_t*)hb; E.L = F.lds; E.PART = PARTB(0); E.pm0 = 0; GEMMW((pg8::EpiResid<true, 0, 1>), big, ws + WS_W1OUT, DM, FF, E, FFOUT_WGM); }
    GRID_BAR();
    { ln_table(F, PARTB(0), NIN); pg8::EpiInProj E; E.QKV = (pg8::bf16_t*)big; E.G = (pg8::bf16_t*)(ws + WS_GATES); E.qscale = QSCALE; E.NRM = (float*)(ws + WS_NRM); E.L = F.lds; E.CS = CSV(CV1); E.DS = DSV(CV1); GEMM(pg8::EpiInProj, hb, ws + WS_WIN, NIN, DM, E); }
    GRID_BAR();
    attention_phase(F, kp, (char*)lds);
    GRID_BAR();
    combine_phase(F, (const bf16*)(ws + WS_DILP), (const float*)(ws + WS_LSE), (bf16*)(ws + WS_OA));
    GRID_BAR();
    { pg8::EpiGateAB E{(const pg8::bf16_t*)(ws + WS_GATES), (pg8::bf16_t*)(ws + WS_Y)}; GEMM(pg8::EpiGateAB, ws + WS_OA, ws + WS_WA, DM, 3072, E); }
    GRID_BAR();
    { pg8::EpiResid<false, 4, 0> E; E.pm0 = ln_table(F, PARTB(0), DM); E.X = nullptr; E.HB = (pg8::bf16_t*)hb; E.L = F.lds; E.PART = PARTB(1); GEMM((pg8::EpiResid<false, 4, 0>), ws + WS_Y, ws + WS_WOUT, DM, DM, E); }
    GRID_BAR();
    { ln_table(F, PARTB(1), 2 * FF); pg8::EpiSwiglu<true> E; E.O = (pg8::bf16_t*)big; E.ldc = FF; E.L = F.lds; E.CS = CSV(CV2); E.DS = DSV(CV2);
      constexpr int NU2 = (M / 256) * (2 * FF / 256); static_assert(NU2 % 256 == 128, "the split tail is written for 128 left-over units on 256 workgroups");
      { pg8::Gemm g_{(const pg8::bf16_t*)hb, (const pg8::bf16_t*)(ws + WS_W2IN), M, 2 * FF, DM, DM}; pg8::StaticOrder S_; S_.init(M, 2 * FF, F.G, (int)blockIdx.x); S_.imax = NU2 / 256;
        pg8::gemm_phase<pg8::EpiSwiglu<true>, pg8::StaticOrder, PG8_ALIGN, PG8_SP2>(F.lds + RING_OFF, g_, S_, E, F.wave); }
      const int v = (int)blockIdx.x & 127, role = (int)blockIdx.x >> 7;
      pg8::StaticOrder S0; S0.init(M, 2 * FF, F.G, v); pg8::OneUnit T; S0.next(NU2 / 256, T.u);
      pg8::EpiSwigluTail E2; E2.O = (pg8::bf16_t*)big; E2.ldc = FF; E2.L = F.lds; E2.CS = CSV(CV2); E2.DS = DSV(CV2); E2.P = (float*)(ws + WS_SCR) + (size_t)v * 65536; E2.FLAG = (unsigned*)(ws + WS_CTL) + CW_SPLIT + v; E2.role = role;
      pg8::Gemm g2{(const pg8::bf16_t*)hb + role * (DM / 2), (const pg8::bf16_t*)(ws + WS_W2IN) + role * (DM / 2), M, 2 * FF, DM / 2, DM};
      pg8::gemm_phase<pg8::EpiSwigluTail, pg8::OneUnit, PG8_ALIGN, PG8_SP2>(F.lds + RING_OFF, g2, T, E2, F.wave); }
    GRID_BAR();
    { pg8::EpiResid<false, 15, 1> E; E.pm0 = ln_table(F, PARTB(1), DM, FFOUT_WGM); E.X = nullptr; E.HB = (pg8::bf16_t*)hb; E.L = F.lds; E.PART = PARTB(2); GEMMW((pg8::EpiResid<false, 15, 1>), big, ws + WS_W2OUT, DM, FF, E, FFOUT_WGM); }
    GRID_BAR();
    { ln_table(F, PARTB(2), DM); pg8::EpiPle E; E.HB = (const pg8::bf16_t*)hb; E.out = (pg8::bf16_t*)big; E.PP = (const pg8::bf16_t*)(ws + WS_PP); E.L = F.lds; E.CS = CSV(CV3); E.DS = DSV(CV3); GEMM(pg8::EpiPle, hb, ws + WS_WG, DM, DM, E); }
    GRID_BAR();
    ln4_phase(F, big, hf, kp->in[23], kp->in[24]);
#undef GEMM
#undef GEMMW
#undef GRID_BAR
#undef hf
#undef hb
#undef big
#undef PARTB
#undef CSV
#undef DSV
}

extern "C" void kernel_launch(void* const* d_in, const int* in_sizes, int n_in, void* d_out, int out_size, void* d_ws, size_t ws_size, hipStream_t stream) {
    static int grid = 0;
    if (grid == 0) {
        if (n_in != 25 || in_sizes[0] != M * DM || out_size != M * DM || ws_size < WS_END) { fprintf(stderr, "kernel_launch: shape mismatch: n_in %d in0 %d out %d ws %zu (need %zu)\n", n_in, n_in > 0 ? in_sizes[0] : -1, out_size, ws_size, (size_t)WS_END); grid = -1; return; }
        int dev = 0, cus = 0;
        if (hipGetDevice(&dev) != hipSuccess || hipDeviceGetAttribute(&cus, hipDeviceAttributeMultiprocessorCount, dev) != hipSuccess) { grid = -1; return; }
        if (hipFuncSetAttribute((const void*)mega_fwd, hipFuncAttributeMaxDynamicSharedMemorySize, LDS_BYTES) != hipSuccess) { fprintf(stderr, "kernel_launch: hipFuncSetAttribute failed\n"); grid = -1; return; }
        int per_cu = 0;
        if (hipOccupancyMaxActiveBlocksPerMultiprocessor(&per_cu, (const void*)mega_fwd, NWAVES * 64, LDS_BYTES) != hipSuccess || per_cu < 1) fprintf(stderr, "kernel_launch: occupancy query reports %d\n", per_cu);
        (void)hipGetLastError();
        if (cus != 256) { fprintf(stderr, "kernel_launch: built for 256 CUs (every workgroup owns one 256-row panel per GEMM phase); this device has %d; nothing launched\n", cus); grid = -1; return; }
        grid = cus;
    }
    if (grid < 0) return;
    if (hipMemsetAsync((char*)d_ws + WS_CTL, 0, CTL_ZERO_BYTES, stream) != hipSuccess) return;
    Args a{};
    for (int i = 0; i < 25; ++i) a.in[i] = (const float*)d_in[i];
    a.out = (float*)d_out; a.ws = (unsigned char*)d_ws;
    hipLaunchKernelGGL(mega_fwd, dim3(grid), dim3(NWAVES * 64), LDS_BYTES, stream, a);
    const hipError_t le = hipPeekAtLastError();
    if (le != hipSuccess) fprintf(stderr, "kernel_launch: launch failed: %s\n", hipGetErrorName(le));
}
```

```cpp
#include <hip/hip_runtime.h>
#include <hip/hip_bf16.h>
#include <cstdio>
#include <cstdint>
struct Args { const float* in[25]; float* out; unsigned char* ws; };
typedef const __attribute__((address_space(4))) Args* KargP;
#define KARG_IN(k) (((KargP)__builtin_amdgcn_kernarg_segment_ptr())->in[(k)])
template <int CTRL> __device__ __forceinline__ float xl_dpp(float v) { return __builtin_bit_cast(float, __builtin_amdgcn_update_dpp(0, __builtin_bit_cast(int, v), CTRL, 0xF, 0xF, true)); }
#define XL_STEP(OP, v, CTRL) v = OP(v, xl_dpp<CTRL>(v))
__device__ __forceinline__ void xl_swap16(float& a, float& b) { asm volatile("s_nop 1\n\tv_permlane16_swap_b32 %0, %1" : "+v"(a), "+v"(b)); }
__device__ __forceinline__ void xl_swap32(float& a, float& b) { asm volatile("s_nop 1\n\tv_permlane32_swap_b32 %0, %1" : "+v"(a), "+v"(b)); }
#define XL_SWAP16(OP, v) do { float a_ = v, b_ = v; xl_swap16(a_, b_); v = OP(a_, b_); } while (0)
#define XL_SWAP32(OP, v) do { float a_ = v, b_ = v; xl_swap32(a_, b_); v = OP(a_, b_); } while (0)
__device__ __forceinline__ float xl_add(float a, float b) { return a + b; }
#define XL_RED8(OP, v)  do { XL_STEP(OP, v, 0xB1); XL_STEP(OP, v, 0x4E); XL_STEP(OP, v, 0x141); } while (0)
#define XL_RED32(OP, v) do { XL_RED8(OP, v); XL_STEP(OP, v, 0x140); XL_SWAP16(OP, v); } while (0)
#define XL_RED64(OP, v) do { XL_RED32(OP, v); XL_SWAP32(OP, v); } while (0)
#define XL_RED_16_32(OP, v) do { XL_SWAP16(OP, v); XL_SWAP32(OP, v); } while (0)
__device__ __forceinline__ int lane_id_fresh() { int l; asm volatile("v_mbcnt_lo_u32_b32 %0, -1, 0\n\tv_mbcnt_hi_u32_b32 %0, -1, %0" : "=v"(l)); return l; }
__device__ __forceinline__ float rfl_f(float x) { return __builtin_bit_cast(float, __builtin_amdgcn_readfirstlane(__builtin_bit_cast(int, x))); }
namespace pg8 {
#define PG8_LAS __attribute__((address_space(3)))
typedef unsigned short bf16_t;
typedef short bf16x8 __attribute__((ext_vector_type(8)));
typedef float f32x4 __attribute__((ext_vector_type(4)));
typedef unsigned u32x4 __attribute__((ext_vector_type(4)));
constexpr int BM = 256, BK = 64, HALF = 128, HTB = HALF * BK * 2  , STAGE_BYTES = 8 * HTB, NXCD = 8, WGM = 8;

__host__ __device__ __forceinline__ int lds_byte(int r, int c) { const int st = (r >> 4) * 2 + (c >> 5), rr = r & 15, cc = c & 31, ob = rr * 64 + cc * 2; return st * 1024 + (ob ^ (((ob >> 9) & 1) << 5)); }
__host__ __device__ __forceinline__ void stage_rc(int b, int& R, int& C) { const int st = b / 1024, sb = b % 1024, swz = sb ^ (((sb >> 9) & 1) << 5); R = (st >> 1) * 16 + swz / 64; C = (st & 1) * 32 + (swz % 64) / 2; }
__host__ __device__ __forceinline__ int perm32(int rho) { const int n = rho >> 4, i = rho & 15; return 8 * (i >> 2) + 4 * n + (i & 3); }

struct Unit { int pm, pn; };
struct Gemm { const bf16_t* A; const bf16_t* Bt; int M, N, K, ld; };

struct StaticOrder {
    int nM, nN, nwg, G, c, wgm, imax;
    __host__ __device__ void init(int M, int N, int G_, int c_, int wgm_ = WGM) { nM = M / BM; nN = N / BM; nwg = nM * nN; G = G_; c = c_; wgm = wgm_; imax = 1 << 30; }
    __host__ __device__ bool next(int i, Unit& u) const {
        const long L = (long)i * G + c; if (L >= nwg || i >= imax) return false;
        int wgid = (int)L; { const int q = nwg / NXCD, r = nwg % NXCD, xcd = wgid % NXCD, off = wgid / NXCD; wgid = (xcd < r ? xcd * (q + 1) : r * (q + 1) + (xcd - r) * q) + off; }
        const int nig = wgm * nN, gid = wgid / nig, fm = gid * wgm, gsz = (nM - fm) < wgm ? (nM - fm) : wgm;
        u.pm = fm + ((wgid % nig) % gsz); u.pn = (wgid % nig) / gsz; return true;
    }
    __device__ __forceinline__ void a_ready(const Unit&) const {}
    __device__ __forceinline__ void done(const Unit&) const {}
};
struct OneUnit {
    Unit u;
    __host__ __device__ bool next(int i, Unit& o) const { if (i != 0) return false; o = u; return true; }
    __device__ __forceinline__ void a_ready(const Unit&) const {}
    __device__ __forceinline__ void done(const Unit&) const {}
};

__device__ __forceinline__ unsigned cvt_pk_bf16(float lo, float hi) { unsigned r; asm volatile("v_cvt_pk_bf16_f32 %0, %1, %2" : "=v"(r) : "v"(lo), "v"(hi)); return r; }
typedef unsigned u32x2 __attribute__((ext_vector_type(2)));
__device__ __forceinline__ float bf_lo(unsigned w) { return __uint_as_float(w << 16); }
__device__ __forceinline__ float bf_hi(unsigned w) { return __uint_as_float(w & 0xffff0000u); }
__device__ __forceinline__ float sigmoid_f(float x) { return __builtin_amdgcn_rcpf(1.0f + __builtin_amdgcn_exp2f(x * -1.4426950408889634f)); }
__device__ __forceinline__ f32x4 sigmoid4(f32x4 v) { return (f32x4){sigmoid_f(v[0]), sigmoid_f(v[1]), sigmoid_f(v[2]), sigmoid_f(v[3])}; }
__device__ __forceinline__ u32x4 pack8(f32x4 v0, f32x4 v1) { u32x4 w; w.x = cvt_pk_bf16(v0[0], v0[1]); w.y = cvt_pk_bf16(v0[2], v0[3]); w.z = cvt_pk_bf16(v1[0], v1[1]); w.w = cvt_pk_bf16(v1[2], v1[3]); return w; }

typedef float f32x2s __attribute__((ext_vector_type(2)));
constexpr int LDS_PTAB = 132096, LDS_STAB = 140288, LDS_GTAB = 144384  ;
__device__ __forceinline__ void ln_row_stats(PG8_LAS unsigned char* L, int rloc, float& mu, float& rs) { const f32x2s s = *(const PG8_LAS f32x2s*)(L + LDS_STAB + rloc * 8); mu = s.x; rs = s.y; }
__device__ __forceinline__ f32x4 fmaxf4(f32x4 v) { return (f32x4){fmaxf(v[0], 1e-30f), fmaxf(v[1], 1e-30f), fmaxf(v[2], 1e-30f), fmaxf(v[3], 1e-30f)}; }
__device__ __forceinline__ float hsum4(f32x4 v) { return (v[0] + v[1]) + (v[2] + v[3]); }
template <bool LNIN> struct EpiSwiglu {
    static constexpr bool PERM = true, AFTER_DRAIN = false; static constexpr int TSW = 0;
    bf16_t* O; int ldc; PG8_LAS unsigned char* L; const float* CS; const float* DS;
    __device__ __forceinline__ void operator()(const f32x4 (&acc)[2][2][4][2], const Unit& u, int wr, int wc, int fr, int fq) const {
        const int row0 = u.pm * BM + wr * 64 + fr, col0 = u.pn * HALF + wc * 32 + 8 * fq, bcol = u.pn * BM + wc * 32 + 8 * fq;
        f32x4 cg[2], cu[2], dg[2], du[2];
        if (LNIN) {
#pragma unroll
            for (int n = 0; n < 2; ++n) { cg[n] = *(const f32x4*)(CS + bcol + 4 * n); cu[n] = *(const f32x4*)(CS + bcol + HALF + 4 * n); dg[n] = *(const f32x4*)(DS + bcol + 4 * n); du[n] = *(const f32x4*)(DS + bcol + HALF + 4 * n); } }
#pragma unroll
        for (int ai = 0; ai < 2; ++ai)
#pragma unroll
            for (int m = 0; m < 4; ++m) { const size_t row = (size_t)(row0 + ai * HALF + m * 16); bf16_t* rowp = O + row * ldc + col0;
                f32x4 g0 = acc[ai][0][m][0], g1 = acc[ai][0][m][1], u0 = acc[ai][1][m][0], u1 = acc[ai][1][m][1];
                if (LNIN) { float mu, rs; ln_row_stats(L, ai * HALF + wr * 64 + m * 16 + fr, mu, rs);
                    g0 = (g0 - cg[0] * mu) * rs + dg[0]; g1 = (g1 - cg[1] * mu) * rs + dg[1]; u0 = (u0 - cu[0] * mu) * rs + du[0]; u1 = (u1 - cu[1] * mu) * rs + du[1]; }
                const f32x4 h0 = g0 * sigmoid4(g0) * u0, h1 = g1 * sigmoid4(g1) * u1;
                *(u32x4*)rowp = pack8(h0, h1); }
    }
};
struct EpiSwigluTail {
    static constexpr bool PERM = true, AFTER_DRAIN = false; static constexpr int TSW = 0;
    bf16_t* O; int ldc; PG8_LAS unsigned char* L; const float* CS; const float* DS; float* P; unsigned* FLAG; int role;
    __device__ __forceinline__ void operator()(const f32x4 (&acc)[2][2][4][2], const Unit& u, int wr, int wc, int fr, int fq) const {
        const int tid = (wr * 4 + wc) * 64 + fq * 16 + fr;
        f32x4* Pt = (f32x4*)P + tid;
        if (role) {
#pragma unroll
            for (int ai = 0; ai < 2; ++ai)
#pragma unroll
                for (int bj = 0; bj < 2; ++bj)
#pragma unroll
                    for (int m = 0; m < 4; ++m)
#pragma unroll
                        for (int n = 0; n < 2; ++n) Pt[(size_t)(((ai * 2 + bj) * 4 + m) * 2 + n) * 512] = acc[ai][bj][m][n];
            asm volatile("s_waitcnt vmcnt(0)" ::: "memory"); __builtin_amdgcn_s_barrier();
            if (tid == 0) { __builtin_amdgcn_fence(__ATOMIC_RELEASE, "agent"); asm volatile("s_waitcnt vmcnt(0)" ::: "memory");
                __hip_atomic_store(FLAG, 1u, __ATOMIC_RELAXED, __HIP_MEMORY_SCOPE_AGENT); }
            return; }
        if (tid == 0) { unsigned sp = 0; while (__hip_atomic_load(FLAG, __ATOMIC_RELAXED, __HIP_MEMORY_SCOPE_AGENT) == 0u && ++sp < (1u << 22)) __builtin_amdgcn_s_sleep(1);
            __builtin_amdgcn_fence(__ATOMIC_ACQUIRE, "agent"); asm volatile("s_waitcnt vmcnt(0)" ::: "memory"); }
        __builtin_amdgcn_s_barrier(); asm volatile("" ::: "memory");
        const int row0 = u.pm * BM + wr * 64 + fr, col0 = u.pn * HALF + wc * 32 + 8 * fq, bcol = u.pn * BM + wc * 32 + 8 * fq;
        f32x4 cg[2], cu[2], dg[2], du[2];
#pragma unroll
        for (int n = 0; n < 2; ++n) { cg[n] = *(const f32x4*)(CS + bcol + 4 * n); cu[n] = *(const f32x4*)(CS + bcol + HALF + 4 * n); dg[n] = *(const f32x4*)(DS + bcol + 4 * n); du[n] = *(const f32x4*)(DS + bcol + HALF + 4 * n); }
#pragma unroll
        for (int ai = 0; ai < 2; ++ai)
#pragma unroll
            for (int m = 0; m < 4; ++m) { const size_t row = (size_t)(row0 + ai * HALF + m * 16); bf16_t* rowp = O + row * ldc + col0;
#define PV_(bj, n) __builtin_nontemporal_load(Pt + (size_t)(((ai * 2 + (bj)) * 4 + m) * 2 + (n)) * 512)
                f32x4 g0 = acc[ai][0][m][0] + PV_(0, 0), g1 = acc[ai][0][m][1] + PV_(0, 1), u0 = acc[ai][1][m][0] + PV_(1, 0), u1 = acc[ai][1][m][1] + PV_(1, 1);
#undef PV_
                float mu, rs; ln_row_stats(L, ai * HALF + wr * 64 + m * 16 + fr, mu, rs);
                g0 = (g0 - cg[0] * mu) * rs + dg[0]; g1 = (g1 - cg[1] * mu) * rs + dg[1]; u0 = (u0 - cu[0] * mu) * rs + du[0]; u1 = (u1 - cu[1] * mu) * rs + du[1];
                const f32x4 h0 = g0 * sigmoid4(g0) * u0, h1 = g1 * sigmoid4(g1) * u1;
                *(u32x4*)rowp = pack8(h0, h1); }
    }
};
template <bool XIN, int GI, int BHALF> struct EpiResid {
    static constexpr bool PERM = true, AFTER_DRAIN = false; static constexpr int TSW = 0;
    const float* X; bf16_t* HB; PG8_LAS unsigned char* L; float* PART; int pm0;
    __device__ __forceinline__ void operator()(const f32x4 (&acc)[2][2][4][2], const Unit& u, int wr, int wc, int fr, int fq) const {
        constexpr float a = 1.189207115002721f, b = BHALF ? 0.5f : 1.0f;
        const int col0 = u.pn * BM + wc * 32 + 8 * fq;
        const size_t off0 = (size_t)(u.pm * BM + wr * 64 + fr) * 4096 + col0;
        u32x4 hw[2][4][2];
#define LOAD_HW(ai) do { _Pragma("unroll") for (int m = 0; m < 4; ++m) _Pragma("unroll") for (int bj = 0; bj < 2; ++bj) hw[ai][m][bj] = *(const u32x4*)(HB + off0 + (size_t)((ai) * HALF + m * 16) * 4096 + bj * HALF); } while (0)
        if (!XIN) { const float* gin = KARG_IN(GI); const float* bin = KARG_IN(GI + 1);
            LOAD_HW(0);
            const int t = (wr * 4 + wc) * 64 + fq * 16 + fr;
            if (t < 256) { *(PG8_LAS float*)(L + LDS_GTAB + t * 4) = gin[u.pn * BM + t] * a; *(PG8_LAS float*)(L + LDS_GTAB + 1024 + t * 4) = bin[u.pn * BM + t] * a; }
            asm volatile("s_waitcnt lgkmcnt(0)" ::: "memory"); __builtin_amdgcn_s_barrier(); asm volatile("" ::: "memory"); }
        const int gofs = LDS_GTAB + (wc * 32 + 8 * fq) * 4;
#pragma unroll
        for (int ai = 0; ai < 2; ++ai) {
            if (!XIN && ai == 0) { LOAD_HW(1); __builtin_amdgcn_sched_barrier(0); }
#pragma unroll
            for (int m = 0; m < 4; ++m) { const int rloc = ai * HALF + wr * 64 + m * 16 + fr; const size_t off = off0 + (size_t)(ai * HALF + m * 16) * 4096;
                float mu = 0.f, rs = 1.f; if (!XIN) ln_row_stats(L, rloc + (u.pm != pm0 ? 256 : 0), mu, rs);
                const float nmr = -mu * rs;
                f32x4 s1v = {0.f, 0.f, 0.f, 0.f}, s2v = {0.f, 0.f, 0.f, 0.f};
#pragma unroll
                for (int bj = 0; bj < 2; ++bj) { const int cc = bj * HALF; f32x4 o0, o1;
                    if (XIN) { const f32x4 r0 = *(const f32x4*)(X + off + cc), r1 = *(const f32x4*)(X + off + cc + 4); o0 = r0 * a + acc[ai][bj][m][0] * b; o1 = r1 * a + acc[ai][bj][m][1] * b; }
                    else { const u32x4 w = hw[ai][m][bj];
                        const f32x4 r0 = (f32x4){bf_lo(w.x), bf_hi(w.x), bf_lo(w.y), bf_hi(w.y)}, r1 = (f32x4){bf_lo(w.z), bf_hi(w.z), bf_lo(w.w), bf_hi(w.w)};
                        const volatile PG8_LAS f32x4* gp = (const volatile PG8_LAS f32x4*)(L + gofs + cc * 4);
                        const f32x4 ga0 = gp[0], ga1 = gp[1], ba0 = gp[64], ba1 = gp[65];
                        o0 = (r0 * rs + nmr) * ga0 + (acc[ai][bj][m][0] * b + ba0); o1 = (r1 * rs + nmr) * ga1 + (acc[ai][bj][m][1] * b + ba1); }
                    *(u32x4*)(HB + off + cc) = pack8(o0, o1);
                    s1v += o0 + o1; s2v += o0 * o0 + o1 * o1; }
                float s1 = hsum4(s1v), s2 = hsum4(s2v);
                XL_RED_16_32(xl_add, s1); XL_RED_16_32(xl_add, s2);
                if (fq == 0) *(PG8_LAS f32x2s*)(L + LDS_PTAB + (rloc * 4 + wc) * 8) = (f32x2s){s1, s2};
                if (m == 3) __builtin_amdgcn_sched_barrier(0); } }
#undef LOAD_HW
        asm volatile("s_waitcnt lgkmcnt(0)" ::: "memory"); __builtin_amdgcn_s_barrier(); asm volatile("" ::: "memory");
        const int tid = (wr * 4 + wc) * 64 + fq * 16 + fr;
        if (tid < 256) { const f32x4 p0 = *(const PG8_LAS f32x4*)(L + LDS_PTAB + tid * 32), p1 = *(const PG8_LAS f32x4*)(L + LDS_PTAB + tid * 32 + 16);
            *(f32x2s*)(PART + ((size_t)(u.pm * BM + tid) * 16 + u.pn) * 2) = (f32x2s){(p0[0] + p0[2]) + (p1[0] + p1[2]), (p0[1] + p0[3]) + (p1[1] + p1[3])}; }
    }
};
struct EpiInProj {
    static constexpr bool PERM = true, AFTER_DRAIN = false; static constexpr int TSW = 0;
    bf16_t* QKV; bf16_t* G; float qscale; float* NRM;
    PG8_LAS unsigned char* L; const float* CS; const float* DS;
    __device__ __forceinline__ void operator()(const f32x4 (&acc)[2][2][4][2], const Unit& u, int wr, int wc, int fr, int fq) const {
        const int row0 = u.pm * BM + wr * 64 + fr; const bool gate = u.pn >= 60; const int bcol = u.pn * BM + wc * 32 + 8 * fq;
        f32x4 cv[2][2], dv[2][2];
#pragma unroll
        for (int bj = 0; bj < 2; ++bj)
#pragma unroll
            for (int n = 0; n < 2; ++n) { cv[bj][n] = *(const f32x4*)(CS + bcol + bj * HALF + 4 * n); dv[bj][n] = *(const f32x4*)(DS + bcol + bj * HALF + 4 * n); }
        bf16_t* base = gate ? G : QKV; const int ldc = gate ? 8192 : 15360, colt = gate ? (u.pn - 60) * BM : u.pn * BM;
        const float sc = (u.pn < 8 || (u.pn >= 24 && u.pn < 36)) ? qscale : 1.0f;
        const int col0 = colt + wc * 32 + 8 * fq;
#pragma unroll
        for (int ai = 0; ai < 2; ++ai)
#pragma unroll
            for (int m = 0; m < 4; ++m) { bf16_t* rowp = base + (size_t)(row0 + ai * HALF + m * 16) * ldc + col0;
                float mu, rs; ln_row_stats(L, ai * HALF + wr * 64 + m * 16 + fr, mu, rs);
#pragma unroll
                for (int bj = 0; bj < 2; ++bj) { f32x4 v0 = (acc[ai][bj][m][0] - cv[bj][0] * mu) * rs + dv[bj][0], v1 = (acc[ai][bj][m][1] - cv[bj][1] * mu) * rs + dv[bj][1];
                    if (gate) { v0 = sigmoid4(v0); v1 = sigmoid4(v1); } else { v0 = v0 * sc; v1 = v1 * sc; }
                    *(u32x4*)(rowp + bj * HALF) = pack8(v0, v1);
                    if (u.pn < 16) { float s = (v0[0] * v0[0] + v0[1] * v0[1]) + (v0[2] * v0[2] + v0[3] * v0[3]) + (v1[0] * v1[0] + v1[1] * v1[1]) + (v1[2] * v1[2] + v1[3] * v1[3]);
                        XL_RED_16_32(xl_add, s);
                        if (fq == 0) NRM[(size_t)(row0 + ai * HALF + m * 16) * 128 + u.pn * 8 + bj * 4 + wc] = s; } } }
    }
};
struct EpiBf16Plain {
    static constexpr bool PERM = true, AFTER_DRAIN = false; static constexpr int TSW = 0;
    bf16_t* O; int ldc;
    __device__ __forceinline__ void operator()(const f32x4 (&acc)[2][2][4][2], const Unit& u, int wr, int wc, int fr, int fq) const {
        const int row0 = u.pm * BM + wr * 64 + fr, col0 = u.pn * BM + wc * 32 + 8 * fq;
#pragma unroll
        for (int ai = 0; ai < 2; ++ai)
#pragma unroll
            for (int m = 0; m < 4; ++m) { bf16_t* rowp = O + (size_t)(row0 + ai * HALF + m * 16) * ldc + col0;
#pragma unroll
                for (int bj = 0; bj < 2; ++bj) *(u32x4*)(rowp + bj * HALF) = pack8(acc[ai][bj][m][0], acc[ai][bj][m][1]); }
    }
};
struct EpiGateAB {
    static constexpr bool PERM = true, AFTER_DRAIN = false; static constexpr int TSW = 2048 / BK;
    const bf16_t* G; bf16_t* Y;
    __device__ __forceinline__ void mid(f32x4 (&acc)[2][2][4][2], const Unit& u, int wr, int wc, int fr, int fq) const {
        int row0 = u.pm * BM + wr * 64 + fr, col0 = u.pn * BM + wc * 32 + 8 * fq; asm volatile("" : "+v"(row0), "+v"(col0));
#pragma unroll
        for (int ai = 0; ai < 2; ++ai) {
            u32x4 aw[4][2], bw[4][2];
#pragma unroll
            for (int m = 0; m < 4; ++m)
#pragma unroll
                for (int bj = 0; bj < 2; ++bj) { const bf16_t* gp = G + (size_t)(row0 + ai * HALF + m * 16) * 8192 + col0 + bj * HALF; aw[m][bj] = *(const u32x4*)gp; bw[m][bj] = *(const u32x4*)(gp + 4096); }
#pragma unroll
            for (int m = 0; m < 4; ++m)
#pragma unroll
                for (int bj = 0; bj < 2; ++bj) { const u32x4 av = aw[m][bj], bv = bw[m][bj];
                    const f32x4 a0 = (f32x4){bf_lo(av.x), bf_hi(av.x), bf_lo(av.y), bf_hi(av.y)}, a1 = (f32x4){bf_lo(av.z), bf_hi(av.z), bf_lo(av.w), bf_hi(av.w)};
                    const f32x4 b0 = (f32x4){bf_lo(bv.x), bf_hi(bv.x), bf_lo(bv.y), bf_hi(bv.y)}, b1 = (f32x4){bf_lo(bv.z), bf_hi(bv.z), bf_lo(bv.w), bf_hi(bv.w)};
#pragma unroll
                    for (int i = 0; i < 4; ++i) { acc[ai][bj][m][0][i] *= a0[i] * __builtin_amdgcn_rcpf(fmaxf(b0[i], 1e-30f)); acc[ai][bj][m][1][i] *= a1[i] * __builtin_amdgcn_rcpf(fmaxf(b1[i], 1e-30f)); } }
            __builtin_amdgcn_sched_barrier(0); }
    }
    __device__ __forceinline__ void operator()(const f32x4 (&acc)[2][2][4][2], const Unit& u, int wr, int wc, int fr, int fq) const {
        const int row0 = u.pm * BM + wr * 64 + fr, col0 = u.pn * BM + wc * 32 + 8 * fq;
#pragma unroll
        for (int ai = 0; ai < 2; ++ai)
#pragma unroll
            for (int m = 0; m < 4; ++m) { const size_t row = (size_t)(row0 + ai * HALF + m * 16);
#pragma unroll
                for (int bj = 0; bj < 2; ++bj) { const int c = col0 + bj * HALF; const u32x4 bw = *(const u32x4*)(G + row * 8192 + 4096 + c);
                    const f32x4 b0 = (f32x4){bf_lo(bw.x), bf_hi(bw.x), bf_lo(bw.y), bf_hi(bw.y)}, b1 = (f32x4){bf_lo(bw.z), bf_hi(bw.z), bf_lo(bw.w), bf_hi(bw.w)};
                    *(u32x4*)(Y + row * 4096 + c) = pack8(fmaxf4(b0) * acc[ai][bj][m][0], fmaxf4(b1) * acc[ai][bj][m][1]); }
                if (m == 3) __builtin_amdgcn_sched_barrier(0); }
    }
};
struct EpiPle {
    static constexpr bool PERM = true, AFTER_DRAIN = false; static constexpr int TSW = 0;
    const bf16_t* HB; bf16_t* out; const bf16_t* PP; PG8_LAS unsigned char* L; const float* CS; const float* DS;
    __device__ __forceinline__ void operator()(const f32x4 (&acc)[2][2][4][2], const Unit& u, int wr, int wc, int fr, int fq) const {
        constexpr float a = 1.189207115002721f; const float* gin = KARG_IN(19); const float* bin = KARG_IN(20);
        const int col0 = u.pn * BM + wc * 32 + 8 * fq;
        { const int t = (wr * 4 + wc) * 64 + fq * 16 + fr;
          if (t < 256) { const int c = u.pn * BM + t; PG8_LAS float* T = (PG8_LAS float*)(L + LDS_PTAB) + t; T[0] = gin[c] * a; T[256] = bin[c] * a; T[512] = CS[c]; T[768] = DS[c]; }
          asm volatile("s_waitcnt lgkmcnt(0)" ::: "memory"); __builtin_amdgcn_s_barrier(); asm volatile("" ::: "memory"); }
        const int gofs = LDS_PTAB + (wc * 32 + 8 * fq) * 4;
#pragma unroll
        for (int ai = 0; ai < 2; ++ai)
#pragma unroll
            for (int m = 0; m < 4; ++m) { const int rloc = ai * HALF + wr * 64 + m * 16 + fr; const size_t off = (size_t)(u.pm * BM + rloc) * 4096 + col0;
                float mu, rs; ln_row_stats(L, rloc, mu, rs); const float nmr = -mu * rs;
#pragma unroll
                for (int bj = 0; bj < 2; ++bj) { const size_t o = off + bj * HALF;
                    const u32x4 hw = *(const u32x4*)(HB + o), pw = *(const u32x4*)(PP + o);
                    const volatile PG8_LAS f32x4* gp = (const volatile PG8_LAS f32x4*)(L + gofs + bj * HALF * 4);
                    f32x4 y[2];
#pragma unroll
                    for (int n = 0; n < 2; ++n) { const unsigned h0 = n ? hw.z : hw.x, h1 = n ? hw.w : hw.y, q0 = n ? pw.z : pw.x, q1 = n ? pw.w : pw.y;
                        const f32x4 gv = gp[n], bv = gp[64 + n], cv = gp[128 + n], dv = gp[192 + n];
                        const f32x4 z = acc[ai][bj][m][n] * rs + (cv * nmr + dv);
                        y[n] = ((f32x4){bf_lo(h0), bf_hi(h0), bf_lo(h1), bf_hi(h1)} * rs + nmr) * gv + (bv + sigmoid4(z) * (f32x4){bf_lo(q0), bf_hi(q0), bf_lo(q1), bf_hi(q1)}); }
                    *(u32x4*)(out + o) = pack8(y[0], y[1]); }
                if (m == 3) __builtin_amdgcn_sched_barrier(0); }
    }
};

template <class Epi, class Sched, bool ALIGN_EPI = false, bool SP2 = false>
__device__ __forceinline__ void gemm_phase(PG8_LAS unsigned char* lds, const Gemm g, const Sched& S, const Epi& E, int wave_id) {
    const int tid_ = wave_id * 64 + lane_id_fresh();
    const int tid = tid_, wid = __builtin_amdgcn_readfirstlane(tid >> 6), lane = tid & 63, wr = wid >> 2, wc = wid & 3, fr = lane & 15, fq = lane >> 4;
    const int K = g.K, nt = K / BK, ld = g.ld;
    unsigned voffA[2], voffB[2];
#pragma unroll
    for (int i = 0; i < 2; ++i) { int R, C; stage_rc(tid * 16 + i * 8192, R, C); const int Rb = Epi::PERM ? ((R & ~31) + perm32(R & 31)) : R;
        voffA[i] = (unsigned)(R * ld + C) * 2u; voffB[i] = (unsigned)(Rb * ld + C) * 2u; }
    const size_t kstep = (size_t)(BK * 2);
    const size_t hstep = (size_t)HALF * ld * 2;
    const size_t tstep = 2 * hstep;
    const unsigned ldsw = (unsigned)wid * 1024u;
    const int aoff = lds_byte(wr * 64 + fr, fq * 8), boff = lds_byte(wc * 32 + fr, fq * 8);
#define PG8_SA(b, h) (((b) * 2 + (h)) * HTB)
#define PG8_SB(b, h) ((4 + (b) * 2 + (h)) * HTB)
#define PG8_STAGE(bufoff, gbase, voff) do { _Pragma("unroll") for (int _i = 0; _i < 2; ++_i) \
        __builtin_amdgcn_global_load_lds((const unsigned*)((const char*)(gbase) + (voff)[_i]), (PG8_LAS unsigned*)(lds + (bufoff) + ldsw + _i * 8192), 16, 0, 0); } while (0)
#define PG8_LDA(dst, b, h) do { _Pragma("unroll") for (int m = 0; m < 4; ++m) _Pragma("unroll") for (int k = 0; k < 2; ++k) dst[m][k] = *(const PG8_LAS bf16x8*)(lds + PG8_SA(b, h) + aoff + m * 2048 + k * 1024); } while (0)
#define PG8_LDB(dst, b, h) do { _Pragma("unroll") for (int n = 0; n < 2; ++n) _Pragma("unroll") for (int k = 0; k < 2; ++k) dst[n][k] = *(const PG8_LAS bf16x8*)(lds + PG8_SB(b, h) + boff + n * 2048 + k * 1024); } while (0)
#define PG8_MMA(ai, bj, At, Bt) do { __builtin_amdgcn_s_setprio(1); _Pragma("unroll") for (int m = 0; m < 4; ++m) _Pragma("unroll") for (int n = 0; n < 2; ++n) _Pragma("unroll") for (int k = 0; k < 2; ++k) \
        acc[ai][bj][m][n] = __builtin_amdgcn_mfma_f32_16x16x32_bf16(Bt[n][k], At[m][k], acc[ai][bj][m][n], 0, 0, 0); __builtin_amdgcn_s_setprio(0); } while (0)
#define PG8_WAIT_V(n) asm volatile("s_waitcnt vmcnt(" #n ")" ::: "memory")
#define PG8_WAIT_L(n) asm volatile("s_waitcnt lgkmcnt(" #n ")" ::: "memory")
#define PG8_BAR __builtin_amdgcn_s_barrier()
#define PG8_SCHED __builtin_amdgcn_sched_barrier(0)
    Unit cur, nxt; int ui = 0;
    if (!S.next(0, cur)) return;
    f32x4 acc[2][2][4][2];
#pragma unroll
    for (int a = 0; a < 2; ++a)
#pragma unroll
        for (int b = 0; b < 2; ++b)
#pragma unroll
            for (int m = 0; m < 4; ++m)
#pragma unroll
                for (int n = 0; n < 2; ++n) acc[a][b][m][n] = (f32x4){0.f, 0.f, 0.f, 0.f};
    bf16x8 At[4][2], B0[2][2], B1[2][2];
    const char* cA = (const char*)g.A + (size_t)cur.pm * tstep; const char* cB = (const char*)g.Bt + (size_t)cur.pn * tstep;
    S.a_ready(cur);
    if constexpr (SP2) {
        PG8_STAGE(PG8_SB(0, 0), cB, voffB); PG8_STAGE(PG8_SB(0, 1), cB + hstep, voffB); PG8_STAGE(PG8_SA(0, 0), cA, voffA); PG8_STAGE(PG8_SA(0, 1), cA + hstep, voffA);
        if (wr == 1) PG8_BAR;
        PG8_WAIT_V(2); PG8_BAR;
        PG8_STAGE(PG8_SB(1, 0), cB + kstep, voffB); PG8_STAGE(PG8_SA(1, 0), cA + kstep, voffA); PG8_STAGE(PG8_SB(1, 1), cB + hstep + kstep, voffB);
        PG8_WAIT_V(6); PG8_BAR;
    } else {
        PG8_STAGE(PG8_SB(0, 0), cB, voffB); PG8_STAGE(PG8_SA(0, 0), cA, voffA); PG8_STAGE(PG8_SB(0, 1), cB + hstep, voffB); PG8_STAGE(PG8_SA(0, 1), cA + hstep, voffA);
        if (wr == 1) PG8_BAR;
        PG8_WAIT_V(4); PG8_BAR;
        PG8_STAGE(PG8_SB(1, 0), cB + kstep, voffB); PG8_STAGE(PG8_SA(1, 0), cA + kstep, voffA); PG8_STAGE(PG8_SB(1, 1), cB + hstep + kstep, voffB);
        PG8_WAIT_V(6); PG8_BAR;
    }
    for (;;) {
        const bool has_next = S.next(ui + 1, nxt);
        const char* nA = has_next ? (const char*)g.A + (size_t)nxt.pm * tstep : cA; const char* nB = has_next ? (const char*)g.Bt + (size_t)nxt.pn * tstep : cB;
        for (int t = 0; t < nt; t += 2) {
            if constexpr (Epi::TSW > 0) { if (t == Epi::TSW) E.mid(acc, cur, wr, wc, fr, fq); }
            const bool last = (t == nt - 2);
            const char* a1 = cA + (size_t)(t + 1) * kstep;
            const char* a2 = last ? nA : cA + (size_t)(t + 2) * kstep; const char* b2 = last ? nB : cB + (size_t)(t + 2) * kstep;
            const char* a3 = a2 + kstep; const char* b3 = b2 + kstep;
            if (last && has_next) S.a_ready(nxt);
            if constexpr (SP2) {
            PG8_LDB(B0, 0, 0); PG8_LDB(B1, 0, 1); PG8_SCHED; PG8_LDA(At, 0, 0); PG8_STAGE(PG8_SA(1, 1), a1 + hstep, voffA);
            PG8_WAIT_V(8); PG8_WAIT_L(0); PG8_BAR; PG8_MMA(0, 0, At, B0); PG8_MMA(0, 1, At, B1); PG8_BAR; PG8_SCHED;
            PG8_LDA(At, 0, 1); PG8_STAGE(PG8_SB(0, 0), b2, voffB); PG8_STAGE(PG8_SB(0, 1), b2 + hstep, voffB); PG8_STAGE(PG8_SA(0, 0), a2, voffA);
            PG8_WAIT_V(8); PG8_WAIT_L(0); PG8_BAR; PG8_MMA(1, 0, At, B0); PG8_MMA(1, 1, At, B1); PG8_BAR; PG8_SCHED;
            PG8_LDB(B0, 1, 0); PG8_LDB(B1, 1, 1); PG8_SCHED; PG8_LDA(At, 1, 0); PG8_STAGE(PG8_SA(0, 1), a2 + hstep, voffA);
            PG8_WAIT_V(8); PG8_WAIT_L(0); PG8_BAR; PG8_MMA(0, 0, At, B0); PG8_MMA(0, 1, At, B1); PG8_BAR; PG8_SCHED;
            PG8_LDA(At, 1, 1); PG8_STAGE(PG8_SB(1, 0), b3, voffB); PG8_STAGE(PG8_SB(1, 1), b3 + hstep, voffB); PG8_STAGE(PG8_SA(1, 0), a3, voffA);
            PG8_WAIT_V(8); PG8_WAIT_L(0); PG8_BAR; PG8_MMA(1, 0, At, B0); PG8_MMA(1, 1, At, B1); PG8_BAR; PG8_SCHED;
            } else {
            PG8_LDB(B0, 0, 0); PG8_SCHED; PG8_LDA(At, 0, 0); PG8_STAGE(PG8_SA(1, 1), a1 + hstep, voffA);
            PG8_WAIT_L(8); PG8_BAR; PG8_WAIT_L(0); PG8_MMA(0, 0, At, B0); PG8_BAR; PG8_SCHED;
            PG8_LDB(B1, 0, 1); PG8_STAGE(PG8_SB(0, 0), b2, voffB);
            PG8_BAR; PG8_WAIT_L(0); PG8_MMA(0, 1, At, B1); PG8_BAR;
            PG8_LDA(At, 0, 1); PG8_STAGE(PG8_SA(0, 0), a2, voffA);
            PG8_BAR; PG8_WAIT_L(0); PG8_MMA(1, 0, At, B0); PG8_BAR; PG8_SCHED;
            PG8_STAGE(PG8_SB(0, 1), b2 + hstep, voffB);
            PG8_WAIT_V(6); PG8_BAR; PG8_MMA(1, 1, At, B1); PG8_BAR;
            PG8_LDB(B0, 1, 0); PG8_SCHED; PG8_LDA(At, 1, 0); PG8_STAGE(PG8_SA(0, 1), a2 + hstep, voffA);
            PG8_WAIT_L(8); PG8_BAR; PG8_WAIT_L(0); PG8_MMA(0, 0, At, B0); PG8_BAR; PG8_SCHED;
            PG8_LDB(B1, 1, 1); PG8_STAGE(PG8_SB(1, 0), b3, voffB);
            PG8_BAR; PG8_WAIT_L(0); PG8_MMA(0, 1, At, B1); PG8_BAR;
            PG8_LDA(At, 1, 1); PG8_STAGE(PG8_SA(1, 0), a3, voffA);
            PG8_BAR; PG8_WAIT_L(0); PG8_MMA(1, 0, At, B0); PG8_BAR; PG8_SCHED;
            PG8_STAGE(PG8_SB(1, 1), b3 + hstep, voffB);
            PG8_WAIT_V(6); PG8_BAR; PG8_MMA(1, 1, At, B1); PG8_BAR;
            }
        }
        if constexpr (ALIGN_EPI) { if (wr == 0) PG8_BAR; }
        if constexpr (!Epi::AFTER_DRAIN) { E(acc, cur, wr, wc, fr, fq); S.done(cur); }
        if (!has_next) break;
#pragma unroll
        for (int a = 0; a < 2; ++a)
#pragma unroll
            for (int b = 0; b < 2; ++b)
#pragma unroll
                for (int m = 0; m < 4; ++m)
#pragma unroll
                    for (int n = 0; n < 2; ++n) acc[a][b][m][n] = (f32x4){0.f, 0.f, 0.f, 0.f};
        cur = nxt; cA = nA; cB = nB; ++ui;
        if constexpr (ALIGN_EPI) { if (wr == 1) PG8_BAR; }
    }
    PG8_WAIT_V(0);
    if constexpr (!ALIGN_EPI) { if (wr == 0) PG8_BAR; }
    PG8_BAR;
    if constexpr (Epi::AFTER_DRAIN) { E.fused(acc, cur, wr, wc, fr, fq, lds, wid, lane); S.done(cur); }
#undef PG8_SA
#undef PG8_SB
#undef PG8_STAGE
#undef PG8_LDA
#undef PG8_LDB
#undef PG8_MMA
#undef PG8_WAIT_V
#undef PG8_WAIT_L
#undef PG8_BAR
#undef PG8_SCHED
}
}
namespace att {
using bf16 = __hip_bfloat16;
using bf16x8 = __attribute__((ext_vector_type(8))) short;
using s16x4  = __attribute__((ext_vector_type(4))) short;
using f32x16 = __attribute__((ext_vector_type(16))) float;
using u32x4  = __attribute__((ext_vector_type(4))) unsigned;
constexpr int NW = 8, QBLK = 32, KVBLK = 64;
constexpr size_t SHM_V = KVBLK * 128 * 2, SHM_K = KVBLK * 128 * 2, SHM_ATTN = 2 * SHM_V + 2 * SHM_K + NW * 64 * 4;
constexpr float THR2 = 11.5f;
#define KSWZ(row, colB) ((row) * 256 + ((colB) ^ (((row) & 7) << 4)))
#define SBAR() __builtin_amdgcn_sched_barrier(0)
__device__ __forceinline__ int crow(int r, int hi) { return (r & 3) + 8 * (r >> 2) + 4 * hi; }
__device__ __forceinline__ unsigned cvtpk(float lo, float hi) { unsigned r; asm volatile("v_cvt_pk_bf16_f32 %0, %1, %2" : "=v"(r) : "v"(lo), "v"(hi)); return r; }

template <int MODE>
__device__ __forceinline__ void partialSM(f32x16& p0, f32x16& p1, float& m_reg, float& mn, float& alpha, float di, float sl2) {
#pragma unroll
  for (int r = 0; r < 16; ++r) { const float a0 = fabsf(di - (float)((r & 3) + 8 * (r >> 2))), a1 = fabsf(di - (float)(32 + (r & 3) + 8 * (r >> 2)));
    if (MODE == 0) { p0[r] = fmaf(-sl2, a0, p0[r]); p1[r] = fmaf(-sl2, a1, p1[r]); }
    else { p0[r] = a0 <= 64.f ? fmaf(-sl2, a0, p0[r]) : -1e30f; p1[r] = a1 <= 64.f ? fmaf(-sl2, a1, p1[r]) : -1e30f; } }
  float pmax = p0[0];
#pragma unroll
  for (int r = 1; r < 16; ++r) pmax = fmaxf(pmax, p0[r]);
#pragma unroll
  for (int r = 0; r < 16; ++r) pmax = fmaxf(pmax, p1[r]);
  { auto rr = __builtin_amdgcn_permlane32_swap(__float_as_uint(pmax), __float_as_uint(pmax), false, false);
    pmax = fmaxf(__uint_as_float(rr[0]), __uint_as_float(rr[1])); }
  if (__builtin_expect(__all(pmax - m_reg <= THR2), 1)) { mn = m_reg; alpha = 1.f; }
  else { mn = fmaxf(m_reg, pmax); alpha = __builtin_amdgcn_exp2f(m_reg - mn); m_reg = mn; }
#pragma unroll
  for (int r = 0; r < 16; ++r) p0[r] = p0[r] - mn;
#pragma unroll
  for (int r = 0; r < 16; ++r) p1[r] = p1[r] - mn;
#pragma unroll
  for (int r = 0; r < 16; ++r) p0[r] = __builtin_amdgcn_exp2f(p0[r]);
}
__device__ __forceinline__ void finishSM(f32x16& p0, f32x16& p1, float alpha, float& l_reg, bf16x8& pa0, bf16x8& pa1, bf16x8& pa2, bf16x8& pa3) {
#pragma unroll
  for (int r = 0; r < 16; ++r) p1[r] = __builtin_amdgcn_exp2f(p1[r]);
  float ps = 0;
#pragma unroll
  for (int r = 0; r < 16; ++r) ps += p0[r];
#pragma unroll
  for (int r = 0; r < 16; ++r) ps += p1[r];
  { auto rr = __builtin_amdgcn_permlane32_swap(__float_as_uint(ps), __float_as_uint(ps), false, false);
    ps = __uint_as_float(rr[0]) + __uint_as_float(rr[1]); }
  l_reg = l_reg * alpha + ps;
#define PK4(P, BASE, OUT) do { unsigned a0 = cvtpk(P[BASE + 0], P[BASE + 1]), a1 = cvtpk(P[BASE + 2], P[BASE + 3]);   \
    unsigned b0 = cvtpk(P[BASE + 4], P[BASE + 5]), b1 = cvtpk(P[BASE + 6], P[BASE + 7]);                              \
    auto r0 = __builtin_amdgcn_permlane32_swap(a0, b0, false, false); auto r1 = __builtin_amdgcn_permlane32_swap(a1, b1, false, false); \
    u32x4 w = {r0[0], r1[0], r0[1], r1[1]}; OUT = *reinterpret_cast<bf16x8*>(&w); } while (0)
  PK4(p0, 0, pa0); PK4(p0, 8, pa1); PK4(p1, 0, pa2); PK4(p1, 8, pa3);
#undef PK4
}
__device__ __forceinline__ void qkt(f32x16& p0, f32x16& p1, const bf16* Ks, const bf16x8* qr, int r32, int hi) {
  p0 = f32x16{}; p1 = f32x16{};
#pragma unroll
  for (int d0 = 0; d0 < 8; ++d0) { int cb = (d0 * 16 + hi * 8) * 2;
    bf16x8 b0 = *reinterpret_cast<const bf16x8*>((const char*)Ks + KSWZ(r32, cb));
    bf16x8 b1 = *reinterpret_cast<const bf16x8*>((const char*)Ks + KSWZ(32 + r32, cb));
    p0 = __builtin_amdgcn_mfma_f32_32x32x16_bf16(b0, qr[d0], p0, 0, 0, 0);
    p1 = __builtin_amdgcn_mfma_f32_32x32x16_bf16(b1, qr[d0], p1, 0, 0, 0); }
}
__device__ __forceinline__ int v_st(int k, int c) { const int kk = (k & ~0xC) | ((k & 4) << 1) | ((k & 8) >> 1); return ((kk >> 3) * 4 + (c >> 5)) * 512 + ((kk & 7) * 32 + (c & 31)) * 2; }
__device__ __forceinline__ int v_rd_base(int lane) { return ((lane & 3) << 3) | (((lane >> 2) & 3) << 6) | (((lane >> 4) & 1) << 5) | (((lane >> 5) & 1) << 8); }
constexpr int v_rd_off(int d0, int ks, int half) { return d0 * 512 + ks * 4096 + half * 2048; }
template <int OFF> __device__ __forceinline__ s16x4 tr_read(int vb) {
  s16x4 r; asm volatile("ds_read_b64_tr_b16 %0, %1 offset:%2" : "=&v"(r) : "v"(vb), "i"(OFF) : "memory"); return r;
}
template <int D0> __device__ __forceinline__ void pv_one(f32x16& od, int vb, bf16x8 pa0, bf16x8 pa1, bf16x8 pa2, bf16x8 pa3) {
  const s16x4 l0 = tr_read<v_rd_off(D0, 0, 0)>(vb), h0 = tr_read<v_rd_off(D0, 0, 1)>(vb), l1 = tr_read<v_rd_off(D0, 1, 0)>(vb), h1 = tr_read<v_rd_off(D0, 1, 1)>(vb);
  const s16x4 l2 = tr_read<v_rd_off(D0, 2, 0)>(vb), h2 = tr_read<v_rd_off(D0, 2, 1)>(vb), l3 = tr_read<v_rd_off(D0, 3, 0)>(vb), h3 = tr_read<v_rd_off(D0, 3, 1)>(vb);
  asm volatile("s_waitcnt lgkmcnt(0)" ::: "memory"); SBAR();
#define PK(L, H) (bf16x8){L[0], L[1], L[2], L[3], H[0], H[1], H[2], H[3]}
  od = __builtin_amdgcn_mfma_f32_32x32x16_bf16(pa0, PK(l0, h0), od, 0, 0, 0);
  od = __builtin_amdgcn_mfma_f32_32x32x16_bf16(pa1, PK(l1, h1), od, 0, 0, 0);
  od = __builtin_amdgcn_mfma_f32_32x32x16_bf16(pa2, PK(l2, h2), od, 0, 0, 0);
  od = __builtin_amdgcn_mfma_f32_32x32x16_bf16(pa3, PK(l3, h3), od, 0, 0, 0);
#undef PK
}
__device__ __forceinline__ void pv_d0(f32x16* o, int vb, bf16x8 pa0, bf16x8 pa1, bf16x8 pa2, bf16x8 pa3) {
  pv_one<0>(o[0], vb, pa0, pa1, pa2, pa3); pv_one<1>(o[1], vb, pa0, pa1, pa2, pa3); pv_one<2>(o[2], vb, pa0, pa1, pa2, pa3); pv_one<3>(o[3], vb, pa0, pa1, pa2, pa3);
}

template <int MODE>
__device__ __forceinline__ void attn_core(const bf16* __restrict__ Qb, long ldq, const bf16* __restrict__ Kh, const bf16* __restrict__ Vh, long ldk, int NT, int t0, int tmax,
                                          float dq, float sl2, int wave_id, char* lds, f32x16 (&o)[4], float& m_reg, float& l_reg) {
  const int tid_ = wave_id * 64 + lane_id_fresh(); asm volatile("" : "+v"(dq));
  const int tid = tid_, wid = tid >> 6, lane = tid & 63, r32 = lane & 31, hi = lane >> 5;
  bf16* V_lds = (bf16*)lds; bf16* K_lds = (bf16*)(lds + 2 * SHM_V);
  float* ws = (float*)(lds + 2 * SHM_V + 2 * SHM_K) + wid * 64; float* al_l = ws + 32;
  m_reg = -1e30f; l_reg = 0.f;
#pragma unroll
  for (int d = 0; d < 4; ++d) o[d] = f32x16{};
  bf16x8 qr[8];
  const bf16* Qw = Qb + (long)(wid * QBLK + r32) * ldq + hi * 8;
#pragma unroll
  for (int d0 = 0; d0 < 8; ++d0) qr[d0] = *reinterpret_cast<const bf16x8*>(Qw + d0 * 16);
  const int sr = tid >> 4, sc = (tid & 15) * 8, vst0 = v_st(sr, sc), vst1 = v_st(32 + sr, sc);
  const unsigned loff = (unsigned)sr * (unsigned)ldk * 2u + (unsigned)sc * 2u;
  const int vb0 = (int)(uintptr_t)V_lds + v_rd_base(lane);
  struct { bf16x8 vs0, vs1, ks0, ks1; } sr_[2];
#define TILEK0(jt) ((MODE == 1) ? 64 * min(max(t0 + (jt), 0), tmax - 1) : 64 * (t0 + (jt)))
#define TILEDI(jt) ((MODE == 1 && ((t0 + (jt)) < 0 || (t0 + (jt)) >= tmax)) ? 1e9f : (dq - 64.f * (float)(jt)))
#define SLOAD(i, jt) do { const size_t t_ = (size_t)(TILEK0(jt)) * (size_t)ldk * 2; const char* vt_ = (const char*)Vh + t_; const char* kt_ = (const char*)Kh + t_;     \
    sr_[i].vs0 = *reinterpret_cast<const bf16x8*>(vt_ + loff); sr_[i].vs1 = *reinterpret_cast<const bf16x8*>(vt_ + (size_t)ldk * 64 + loff); \
    sr_[i].ks0 = *reinterpret_cast<const bf16x8*>(kt_ + loff); sr_[i].ks1 = *reinterpret_cast<const bf16x8*>(kt_ + (size_t)ldk * 64 + loff); } while (0)
#define SWRITE(b, i) do { *(bf16x8*)((char*)V_lds + (b) * SHM_V + vst0) = sr_[i].vs0;          \
    *(bf16x8*)((char*)V_lds + (b) * SHM_V + vst1) = sr_[i].vs1; int kc = sc * 2;               \
    *(bf16x8*)((char*)K_lds + (b) * SHM_K + KSWZ(sr, kc)) = sr_[i].ks0;                       \
    *(bf16x8*)((char*)K_lds + (b) * SHM_K + KSWZ(32 + sr, kc)) = sr_[i].ks1; } while (0)
#define SWAIT() asm volatile("s_waitcnt vmcnt(4)" ::: "memory")
#define RESC(a) do { if (__any((a) < 1.f)) { if (hi == 0) al_l[r32] = (a); asm volatile("s_waitcnt lgkmcnt(0)" ::: "memory"); \
    _Pragma("unroll") for (int d = 0; d < 4; ++d) _Pragma("unroll") for (int r = 0; r < 16; ++r) o[d][r] *= al_l[crow(r, hi)]; } } while (0)
  f32x16 pA0, pA1, pB0, pB1; float mnA, mnB, alA = 1.f, alB = 1.f; bf16x8 pa0, pa1, pa2, pa3;
  constexpr int SE = 0, SO = 1;
  const int wv2 = wave_id >> 1;
#define NEED(jt) (MODE != 1 || ((jt) >= wv2 && (jt) <= wv2 + 2))
  SLOAD(SE, 0); asm volatile("s_waitcnt vmcnt(0)" ::: "memory"); SWRITE(0, SE); __syncthreads();
  if (NEED(0)) { qkt(pA0, pA1, K_lds, qr, r32, hi); partialSM<MODE>(pA0, pA1, m_reg, mnA, alA, TILEDI(0), sl2); }
  SLOAD(SO, 1); if (2 < NT) SLOAD(SE, 2);
  SWAIT(); SWRITE(1, SO); __syncthreads();
  for (int j = 1; j + 1 < NT; j += 2) {
    SBAR(); if (NEED(j)) qkt(pB0, pB1, (bf16*)((char*)K_lds + SHM_K), qr, r32, hi);
    if (NEED(j - 1)) finishSM(pA0, pA1, alA, l_reg, pa0, pa1, pa2, pa3); SBAR();
    SLOAD(SO, j + 2); SBAR();
    if (NEED(j - 1)) pv_d0(o, vb0, pa0, pa1, pa2, pa3); if (NEED(j)) partialSM<MODE>(pB0, pB1, m_reg, mnB, alB, TILEDI(j), sl2);
    __syncthreads(); SWAIT(); SWRITE(0, SE);
    if (NEED(j)) RESC(alB); __syncthreads();
    SBAR(); if (NEED(j + 1)) qkt(pA0, pA1, K_lds, qr, r32, hi);
    if (NEED(j)) finishSM(pB0, pB1, alB, l_reg, pa0, pa1, pa2, pa3); SBAR();
    if (j + 3 < NT) SLOAD(SE, j + 3); SBAR();
    if (NEED(j)) pv_d0(o, vb0 + (int)SHM_V, pa0, pa1, pa2, pa3); if (NEED(j + 1)) partialSM<MODE>(pA0, pA1, m_reg, mnA, alA, TILEDI(j + 1), sl2);
    __syncthreads(); SWAIT(); SWRITE(1, SO);
    if (NEED(j + 1)) RESC(alA); __syncthreads();
  }
  SBAR(); if (NEED(NT - 1)) qkt(pB0, pB1, (bf16*)((char*)K_lds + SHM_K), qr, r32, hi);
  if (NEED(NT - 2)) finishSM(pA0, pA1, alA, l_reg, pa0, pa1, pa2, pa3); SBAR();
  if (NEED(NT - 2)) pv_d0(o, vb0, pa0, pa1, pa2, pa3); if (NEED(NT - 1)) partialSM<MODE>(pB0, pB1, m_reg, mnB, alB, TILEDI(NT - 1), sl2);
  __syncthreads(); if (NEED(NT - 1)) RESC(alB);
  if (NEED(NT - 1)) { finishSM(pB0, pB1, alB, l_reg, pa0, pa1, pa2, pa3); SBAR();
  pv_d0(o, vb0 + (int)SHM_V, pa0, pa1, pa2, pa3); }
  asm volatile("s_waitcnt vmcnt(0)" ::: "memory");
#undef NEED
#undef TILEK0
#undef TILEDI
#undef SLOAD
#undef SWRITE
#undef SWAIT
#undef RESC
}

constexpr int K2_ROWB = 272, K2_BYTES = 64 * K2_ROWB  , V2_BYTES = 2 * 16384, BUF2_BYTES = K2_BYTES + V2_BYTES, WS2_OFF = 2 * BUF2_BYTES  ;
__device__ __forceinline__ void qkt2(f32x16& p0, f32x16& p1, const char* kb, const bf16x8* qr) {
  p0 = f32x16{}; p1 = f32x16{};
#pragma unroll
  for (int d0 = 0; d0 < 8; ++d0) {
    const bf16x8 b0 = *reinterpret_cast<const bf16x8*>(kb + d0 * 32), b1 = *reinterpret_cast<const bf16x8*>(kb + 32 * K2_ROWB + d0 * 32);
    p0 = __builtin_amdgcn_mfma_f32_32x32x16_bf16(b0, qr[d0], p0, 0, 0, 0);
    p1 = __builtin_amdgcn_mfma_f32_32x32x16_bf16(b1, qr[d0], p1, 0, 0, 0); }
}
__device__ __forceinline__ void attn_core_dv256(const bf16* __restrict__ Qb, const bf16* __restrict__ Kh, const bf16* __restrict__ Vh, unsigned ld, int NT, int t0,
                                                float dq, float sl2, int wave_id, int wlo, int whi, char* lds, f32x16 (&o)[8], float& m_reg, float& l_reg) {
  const int lane = lane_id_fresh(); asm volatile("" : "+v"(dq));
  const int r32 = lane & 31, hi = lane >> 5;
  float* al_l = (float*)(lds + WS2_OFF) + wave_id * 64 + 32;
  m_reg = -1e30f; l_reg = 0.f;
#pragma unroll
  for (int d = 0; d < 8; ++d) o[d] = f32x16{};
  bf16x8 qr[8];
  { const bf16* Qw = Qb + (size_t)(wave_id * QBLK + r32) * ld + hi * 8;
#pragma unroll
    for (int d0 = 0; d0 < 8; ++d0) qr[d0] = *reinterpret_cast<const bf16x8*>(Qw + d0 * 16); }
  unsigned kof[3];
#pragma unroll
  for (int i = 0; i < 3; ++i) { const int L = (wave_id + 8 * i) * 64 + lane, row = L / 17, slot = L - row * 17; kof[i] = (unsigned)row * ld * 2u + (unsigned)(slot > 15 ? 15 : slot) * 16u; }
  unsigned vof;
  { const int sub = 2 * wave_id + (lane >> 5), kk = (sub >> 2) * 8 + ((lane & 31) >> 2), k = (kk & ~0xC) | ((kk & 4) << 1) | ((kk & 8) >> 1), cc = (sub & 3) * 32 + (lane & 3) * 8;
    vof = (unsigned)k * ld * 2u + (unsigned)cc * 2u; }
  typedef __attribute__((address_space(3))) unsigned lds_u32;
#define DMA2(jt, b) do { const size_t tb_ = (size_t)(t0 + (jt)) * 64 * (size_t)ld * 2; const char* kt_ = (const char*)Kh + tb_; const char* vt_ = (const char*)Vh + tb_; \
    lds_u32* kl_ = (lds_u32*)(lds + (b) * BUF2_BYTES); lds_u32* vl_ = (lds_u32*)(lds + (b) * BUF2_BYTES + K2_BYTES); \
    __builtin_amdgcn_global_load_lds((const unsigned*)(kt_ + kof[0]), kl_ + wave_id * 256, 16, 0, 0); \
    __builtin_amdgcn_global_load_lds((const unsigned*)(kt_ + kof[1]), kl_ + (wave_id + 8) * 256, 16, 0, 0); \
    if (wave_id == 0) __builtin_amdgcn_global_load_lds((const unsigned*)(kt_ + kof[2]), kl_ + 16 * 256, 16, 0, 0); \
    __builtin_amdgcn_global_load_lds((const unsigned*)(vt_ + vof), vl_ + wave_id * 256, 16, 0, 0); \
    __builtin_amdgcn_global_load_lds((const unsigned*)(vt_ + (size_t)ld * 64 + vof), vl_ + (wave_id + 8) * 256, 16, 0, 0); \
    __builtin_amdgcn_global_load_lds((const unsigned*)(vt_ + 256 + vof), vl_ + 4096 + wave_id * 256, 16, 0, 0); \
    __builtin_amdgcn_global_load_lds((const unsigned*)(vt_ + (size_t)ld * 64 + 256 + vof), vl_ + 4096 + (wave_id + 8) * 256, 16, 0, 0); } while (0)
  const int kbase = r32 * K2_ROWB + hi * 16, vb0 = (int)(uintptr_t)lds + K2_BYTES + v_rd_base(lane);
  __syncthreads();
  DMA2(0, 0);
#define PASS_TILE(j) do { asm volatile("s_waitcnt vmcnt(0)" ::: "memory"); __syncthreads(); if ((j) + 1 < NT) DMA2((j) + 1, ((j) & 1) ^ 1); } while (0)
#pragma unroll 1
  for (int j = 0; j < wlo; ++j) PASS_TILE(j);
#pragma unroll 1
  for (int j = wlo; j <= whi; ++j) {
    const int b = j & 1;
    asm volatile("s_waitcnt vmcnt(0)" ::: "memory"); __syncthreads();
    if (j + 1 < NT) DMA2(j + 1, b ^ 1);
    f32x16 p0, p1; float mn, alpha; bf16x8 pa0, pa1, pa2, pa3;
    qkt2(p0, p1, lds + b * BUF2_BYTES + kbase, qr);
    partialSM<0>(p0, p1, m_reg, mn, alpha, dq - 64.f * (float)j, sl2);
    if (__any(alpha < 1.f)) { if (hi == 0) al_l[r32] = alpha; asm volatile("s_waitcnt lgkmcnt(0)" ::: "memory");
#pragma unroll
      for (int d = 0; d < 8; ++d)
#pragma unroll
        for (int r = 0; r < 16; ++r) o[d][r] *= al_l[crow(r, hi)]; }
    finishSM(p0, p1, alpha, l_reg, pa0, pa1, pa2, pa3); SBAR();
    const int vb = vb0 + b * BUF2_BYTES;
    pv_d0(o, vb, pa0, pa1, pa2, pa3);
    pv_d0(o + 4, vb + 16384, pa0, pa1, pa2, pa3);
  }
#pragma unroll 1
  for (int j = whi + 1; j < NT; ++j) PASS_TILE(j);
  asm volatile("s_waitcnt vmcnt(0)" ::: "memory");
#undef PASS_TILE
#undef DMA2
}
__device__ __forceinline__ void attn_core_band(const bf16* __restrict__ Qb, const bf16* __restrict__ Kh, const bf16* __restrict__ Vh, unsigned ld, int NT, int t0, int tmax,
                                                float dq, float sl2, int wave_id, int wlo, int whi, char* lds, f32x16 (&o)[4], float& m_reg, float& l_reg) {
  const int lane = lane_id_fresh(); asm volatile("" : "+v"(dq));
  const int r32 = lane & 31, hi = lane >> 5;
  float* al_l = (float*)(lds + WS2_OFF) + wave_id * 64 + 32;
  m_reg = -1e30f; l_reg = 0.f;
#pragma unroll
  for (int d = 0; d < 4; ++d) o[d] = f32x16{};
  bf16x8 qr[8];
  { const bf16* Qw = Qb + (size_t)(wave_id * QBLK + r32) * ld + hi * 8;
#pragma unroll
    for (int d0 = 0; d0 < 8; ++d0) qr[d0] = *reinterpret_cast<const bf16x8*>(Qw + d0 * 16); }
  unsigned kof[3];
#pragma unroll
  for (int i = 0; i < 3; ++i) { const int L = (wave_id + 8 * i) * 64 + lane, row = L / 17, slot = L - row * 17; kof[i] = (unsigned)row * ld * 2u + (unsigned)(slot > 15 ? 15 : slot) * 16u; }
  unsigned vof;
  { const int sub = 2 * wave_id + (lane >> 5), kk = (sub >> 2) * 8 + ((lane & 31) >> 2), k = (kk & ~0xC) | ((kk & 4) << 1) | ((kk & 8) >> 1), cc = (sub & 3) * 32 + (lane & 3) * 8;
    vof = (unsigned)k * ld * 2u + (unsigned)cc * 2u; }
  typedef __attribute__((address_space(3))) unsigned lds_u32;
#define DMA2(jt, b) do { const int tc_ = min(max(t0 + (jt), 0), tmax - 1); const size_t tb_ = (size_t)tc_ * 64 * (size_t)ld * 2; const char* kt_ = (const char*)Kh + tb_; const char* vt_ = (const char*)Vh + tb_; \
    lds_u32* kl_ = (lds_u32*)(lds + (b) * BUF2_BYTES); lds_u32* vl_ = (lds_u32*)(lds + (b) * BUF2_BYTES + K2_BYTES); \
    __builtin_amdgcn_global_load_lds((const unsigned*)(kt_ + kof[0]), kl_ + wave_id * 256, 16, 0, 0); \
    __builtin_amdgcn_global_load_lds((const unsigned*)(kt_ + kof[1]), kl_ + (wave_id + 8) * 256, 16, 0, 0); \
    if (wave_id == 0) __builtin_amdgcn_global_load_lds((const unsigned*)(kt_ + kof[2]), kl_ + 16 * 256, 16, 0, 0); \
    __builtin_amdgcn_global_load_lds((const unsigned*)(vt_ + vof), vl_ + wave_id * 256, 16, 0, 0); \
    __builtin_amdgcn_global_load_lds((const unsigned*)(vt_ + (size_t)ld * 64 + vof), vl_ + (wave_id + 8) * 256, 16, 0, 0); } while (0)
  const int kbase = r32 * K2_ROWB + hi * 16, vb0 = (int)(uintptr_t)lds + K2_BYTES + v_rd_base(lane);
  __syncthreads();
  DMA2(0, 0);
#define PASS_TILE(j) do { asm volatile("s_waitcnt vmcnt(0)" ::: "memory"); __syncthreads(); if ((j) + 1 < NT) DMA2((j) + 1, ((j) & 1) ^ 1); } while (0)
#pragma unroll 1
  for (int j = 0; j < wlo; ++j) PASS_TILE(j);
#pragma unroll 1
  for (int j = wlo; j <= whi; ++j) {
    const int b = j & 1;
    asm volatile("s_waitcnt vmcnt(0)" ::: "memory"); __syncthreads();
    if (j + 1 < NT) DMA2(j + 1, b ^ 1);
    f32x16 p0, p1; float mn, alpha; bf16x8 pa0, pa1, pa2, pa3;
    qkt2(p0, p1, lds + b * BUF2_BYTES + kbase, qr);
    partialSM<1>(p0, p1, m_reg, mn, alpha, (t0 + j < 0 || t0 + j >= tmax) ? 1e9f : dq - 64.f * (float)j, sl2);
    if (__any(alpha < 1.f)) { if (hi == 0) al_l[r32] = alpha; asm volatile("s_waitcnt lgkmcnt(0)" ::: "memory");
#pragma unroll
      for (int d = 0; d < 4; ++d)
#pragma unroll
        for (int r = 0; r < 16; ++r) o[d][r] *= al_l[crow(r, hi)]; }
    finishSM(p0, p1, alpha, l_reg, pa0, pa1, pa2, pa3); SBAR();
    const int vb = vb0 + b * BUF2_BYTES;
    pv_d0(o, vb, pa0, pa1, pa2, pa3);
  }
#pragma unroll 1
  for (int j = whi + 1; j < NT; ++j) PASS_TILE(j);
  asm volatile("s_waitcnt vmcnt(0)" ::: "memory");
#undef PASS_TILE
#undef DMA2
}
}

#ifndef PG8_SP2
#define PG8_SP2 true
#endif
#ifndef PG8_ALIGN
#define PG8_ALIGN true
#endif
constexpr int NWAVES = 8;
constexpr int BATCH = 4, SEQ = 4096, DM = 4096, FF = 11008, M = BATCH * SEQ;
constexpr int NIN = 23552, NQKV = 15360, NGATE = 8192, PLE = 256;
constexpr float LN_EPS = 1e-5f, SUBLN_EPS = 1e-5f;
constexpr float ALPHA = 1.189207115002721f;
constexpr float LAMBDA_INIT = 0.2f;
constexpr float QSCALE = 0.08838834764831845f * 1.4426950408889634f;
constexpr float LOG2E = 1.4426950408889634f;

constexpr size_t MiB = 1u << 20;
constexpr size_t WS_CTL = 0, CTL_ZERO_BYTES = 1 * MiB;
constexpr size_t WS_W1IN = 1 * MiB, WS_W1OUT = WS_W1IN + 172 * MiB;
constexpr size_t WS_GATES = WS_W1IN;
constexpr size_t WS_WIN = WS_W1OUT + 86 * MiB;
constexpr size_t WS_WA = WS_WIN + 184 * MiB, WS_WB = WS_WA + 16 * MiB, WS_WOUT = WS_WB + 8 * MiB;
constexpr size_t WS_W2IN = WS_WOUT + 32 * MiB, WS_W2OUT = WS_W2IN + 172 * MiB;
constexpr size_t WS_WG = WS_W2OUT + 86 * MiB, WS_WP = WS_WG + 32 * MiB;
constexpr size_t WS_HB = WS_WP + 2 * MiB;
constexpr size_t WS_BIG = WS_HB + 128 * MiB;
constexpr size_t WS_Y1 = WS_BIG, WS_Y = WS_BIG + 256 * MiB;
constexpr size_t WS_OA = WS_BIG + 480 * MiB;
constexpr size_t WS_OB = WS_OA + 64 * MiB;
constexpr size_t WS_DILP = WS_OB + 32 * MiB;
constexpr size_t WS_LSE = WS_DILP + 96 * MiB;
constexpr size_t WS_SCR = WS_LSE + 2 * MiB;
constexpr size_t WS_PB = WS_SCR + 64 * MiB;
constexpr size_t WS_PP = WS_PB + 8 * MiB;
constexpr size_t WS_NRM = WS_PP + 128 * MiB;
constexpr size_t WS_CP = WS_NRM + 8 * MiB, WS_DP = WS_CP + 13 * MiB;
constexpr size_t WS_PART = WS_DP + 13 * MiB;
constexpr size_t WS_END = WS_PART + 6 * MiB;
static_assert(WS_GATES + (size_t)M * NGATE * 2 <= WS_WIN, "gates overlay fits in the FFN1 weight region");
static_assert((size_t)M * NQKV * 2 <= 480 * MiB && (size_t)M * FF * 2 <= 480 * MiB, "BIG region");
#ifndef FFOUT_WGM
#define FFOUT_WGM 4
#endif
constexpr int CW_QA = 8192, CW_QB = 8256;
constexpr int NCV = NIN + 2 * FF + DM, CV1 = 0, CV2 = NIN, CV3 = NIN + 2 * FF;
constexpr int CW_CV = 16384;
static_assert((size_t)(CW_CV + 2 * NCV) * 4 <= CTL_ZERO_BYTES && (size_t)64 * NCV * 4 <= 13 * MiB, "CTL / partial-sum maps");
constexpr int CW_SPLIT = 8704;
constexpr int CW_BAR = 4096;

constexpr int RING_OFF = 0, RING_BYTES = 131072;
constexpr int LDSCTL_OFF = RING_BYTES, MISC_OFF = LDSCTL_OFF + 320;
constexpr int LDS_BYTES = 147456;
constexpr int ATT_RED_OFF = 69632 + 8 * 4096;
constexpr float PRUNE_T = 38.0f;
constexpr int ATT_STASH_OFF = 69632;
static_assert(att::SHM_ATTN <= ATT_STASH_OFF && ATT_RED_OFF + 256 <= RING_BYTES && att::WS2_OFF + 2048 <= ATT_RED_OFF, "attention LDS map");

#define GAS __attribute__((address_space(1)))
#define LAS __attribute__((address_space(3)))
typedef unsigned short bf16;
typedef unsigned v4u __attribute__((ext_vector_type(4)));
typedef float f32x4 __attribute__((ext_vector_type(4)));
typedef short bf16x8 __attribute__((ext_vector_type(8)));
typedef GAS unsigned gu32;
typedef GAS unsigned long long gu64;
#define RLX_AGENT __ATOMIC_RELAXED, __HIP_MEMORY_SCOPE_AGENT
#define LDS_WAIT() asm volatile("s_waitcnt lgkmcnt(0)" ::: "memory")
#define VM_WAIT() asm volatile("s_waitcnt vmcnt(0)" ::: "memory")
__device__ __forceinline__ unsigned long long rt() { return __builtin_amdgcn_s_memrealtime(); }
__device__ __forceinline__ unsigned f2bf(float f) { unsigned u = __builtin_bit_cast(unsigned, f); return (u + 0x7fffu + ((u >> 16) & 1u)) >> 16; }
__device__ __forceinline__ unsigned pk2(float lo, float hi) { return f2bf(lo) | (f2bf(hi) << 16); }

#define XB_TMO      128
#define XB_XCNT(j)  (256  + 64 * (j))
#define XB_XSUB(j)  (1280 + 64 * (j))
#define XB_XGEN(j)  (2304 + 64 * (j))
#define XB_TOP      3328
#define XB_TOPGEN   3392
#define XCD_BAR_WORDS 3456
#define XB_SPIN_CAP (1u << 18)

__device__ __forceinline__ unsigned xb_ld(unsigned* p)              { return __hip_atomic_load(p, __ATOMIC_RELAXED, __HIP_MEMORY_SCOPE_AGENT); }
__device__ __forceinline__ unsigned xb_add(unsigned* p, unsigned v) { return __hip_atomic_fetch_add(p, v, __ATOMIC_RELAXED, __HIP_MEMORY_SCOPE_AGENT); }
__device__ __forceinline__ unsigned xb_xcc_id() { return (unsigned)__builtin_amdgcn_s_getreg((3 << 11) | 20) & 0xFu; }
#define XB_SPIN(cond, bar) do { unsigned _sp = 0; while (cond) { __builtin_amdgcn_s_sleep(1); \
    if ((++_sp & 255u) == 0u) { if (xb_ld(&(bar)[XB_TMO])) break; if (_sp > XB_SPIN_CAP) { atomicAdd(&(bar)[XB_TMO], 1u); break; } } } } while (0)

struct XcdBarrier {
    unsigned* bar; unsigned x;
    volatile LAS unsigned* st;
};

__device__ __forceinline__ XcdBarrier xcd_barrier_post(unsigned* bar, volatile LAS unsigned* st, bool thread0) {
    XcdBarrier b; b.bar = bar; b.x = xb_xcc_id(); b.st = st;
    if (thread0) (void)xb_add(&bar[XB_XCNT(b.x)], 1u);
    return b;
}
__device__ __forceinline__ void xcd_barrier_complete(unsigned* bar, unsigned x, unsigned& nloc, unsigned& nx) {
    const unsigned G = gridDim.x * gridDim.y * gridDim.z;
    unsigned sum, cnt, mine, sp = 0u;
    for (;;) {
        sum = 0u; cnt = 0u; mine = 0u;
#pragma unroll
        for (unsigned j = 0; j < 16; ++j) { const unsigned c = xb_ld(&bar[XB_XCNT(j)]); sum += c; cnt += (c > 0u) ? 1u : 0u; mine = (j == x) ? c : mine; }
        if (sum == G) break;
        __builtin_amdgcn_s_sleep(1);
        if ((++sp & 255u) == 0u) { if (xb_ld(&bar[XB_TMO])) break; if (sp > XB_SPIN_CAP) { atomicAdd(&bar[XB_TMO], 1u); break; } }
    }
    nloc = mine > 0u ? mine : 1u; nx = cnt > 0u ? cnt : 1u;
}

__device__ __forceinline__ void xcd_barrier(const XcdBarrier& b, bool thread0) {
    asm volatile("s_waitcnt vmcnt(0)" ::: "memory");
    __syncthreads();
    if (thread0) {
        unsigned* bar = b.bar;
        __builtin_amdgcn_s_waitcnt(0);
        unsigned nloc = b.st[0], nx = b.st[1];
        if (nloc == 0u) { xcd_barrier_complete(bar, b.x, nloc, nx); b.st[0] = nloc; b.st[1] = nx; }
        const unsigned old = xb_add(&bar[XB_XSUB(b.x)], 1u);
        const unsigned gen = old / nloc;
        if (old + 1u == (gen + 1u) * nloc) {
            __builtin_amdgcn_fence(__ATOMIC_RELEASE, "agent");
            asm volatile("s_waitcnt vmcnt(0)" ::: "memory");
            const unsigned og = xb_add(&bar[XB_TOP], 1u);
            const unsigned tg = og / nx;
            if (og + 1u == (tg + 1u) * nx) xb_add(&bar[XB_TOPGEN], 1u);
            else XB_SPIN(xb_ld(&bar[XB_TOPGEN]) == tg, bar);
            __builtin_amdgcn_fence(__ATOMIC_ACQUIRE, "agent");
            xb_add(&bar[XB_XGEN(b.x)], 1u);
            asm volatile("s_waitcnt vmcnt(0)" ::: "memory");
        } else {
            XB_SPIN(xb_ld(&bar[XB_XGEN(b.x)]) == gen, bar);
            __builtin_amdgcn_fence(__ATOMIC_ACQUIRE, "agent");
            asm volatile("s_waitcnt vmcnt(0)" ::: "memory");
        }
    }
    __syncthreads();
}
struct Frame {
    LAS unsigned char* lds;
    volatile LAS unsigned* MISC;
    gu32* ctl;
    int tid, lane, wave;
    int vcu, G;
};
typedef float f32x8v __attribute__((ext_vector_type(8)));
__device__ __forceinline__ float wave_sum(float v) { XL_RED64(xl_add, v); return v; }
template <bool FOLD>
__device__ __forceinline__ void p0_transpose_item(const float* W, int K, int N, bf16* WT, int dpitch, int dst_row0, LAS float* scr, int k0, int n0, int lane, const float* g, const float* bb, float* cp, float* dp) {
#pragma unroll 8
    for (int i = 0; i < 32; ++i) { const int kk = 2 * i + (lane >> 5); scr[kk * 33 + (lane & 31)] = W[(size_t)(k0 + kk) * N + n0 + (lane & 31)]; }
    LDS_WAIT(); asm volatile("" ::: "memory");
    const int c = lane & 7;
    float gv[8], bv[8];
    if (FOLD) { const f32x4 g0 = *(const GAS f32x4*)(g + k0 + 8 * c), g1 = *(const GAS f32x4*)(g + k0 + 8 * c + 4), b0 = *(const GAS f32x4*)(bb + k0 + 8 * c), b1 = *(const GAS f32x4*)(bb + k0 + 8 * c + 4);
#pragma unroll
        for (int i = 0; i < 4; ++i) { gv[i] = g0[i]; gv[4 + i] = g1[i]; bv[i] = b0[i]; bv[4 + i] = b1[i]; } }
#pragma unroll
    for (int j = 0; j < 4; ++j) { const int n = (lane >> 3) + 8 * j; const LAS float* s = scr + (8 * c) * 33 + n;
        float w[8];
#pragma unroll
        for (int i = 0; i < 8; ++i) w[i] = s[i * 33];
        float ds = 0.f;
        if (FOLD) {
#pragma unroll
            for (int i = 0; i < 8; ++i) { ds += w[i] * bv[i]; w[i] *= gv[i]; } }
        v4u o; o.x = pk2(w[0], w[1]); o.y = pk2(w[2], w[3]); o.z = pk2(w[4], w[5]); o.w = pk2(w[6], w[7]);
        *(GAS v4u*)(WT + (size_t)(dst_row0 + n) * dpitch + k0 + 8 * c) = o;
        if (FOLD) { float cs = ((__uint_as_float(o.x << 16) + __uint_as_float(o.x & 0xffff0000u)) + (__uint_as_float(o.y << 16) + __uint_as_float(o.y & 0xffff0000u)))
                             + ((__uint_as_float(o.z << 16) + __uint_as_float(o.z & 0xffff0000u)) + (__uint_as_float(o.w << 16) + __uint_as_float(o.w & 0xffff0000u)));
            XL_RED8(xl_add, cs); XL_RED8(xl_add, ds);
            if (c == 0) { cp[dst_row0 + n] = cs; dp[dst_row0 + n] = ds; } } }
    LDS_WAIT(); asm volatile("" ::: "memory");
}
__device__ __forceinline__ void cvt_rows(Frame& F, const float* src, bf16* dst, size_t n8) {
    const size_t gt = (size_t)(F.vcu * NWAVES + F.wave) * 64 + F.lane, NT = (size_t)F.G * NWAVES * 64;
    for (size_t i = gt; i < n8; i += NT) { const f32x8v x = *(const GAS f32x8v*)(src + i * 8);
        v4u o; o.x = pk2(x[0], x[1]); o.y = pk2(x[2], x[3]); o.z = pk2(x[4], x[5]); o.w = pk2(x[6], x[7]); *(GAS v4u*)(dst + i * 8) = o; }
}

__device__ __forceinline__ void p0_prologue(Frame& F, KargP a) {
    LAS float* scr = (LAS float*)(F.lds + RING_OFF + F.wave * 16384);
    const int gw = F.vcu * NWAVES + F.wave, NGW = F.G * NWAVES;
    unsigned char* ws = a->ws;
#define TR_MAT(SRC, KK, NN, DST, SWI, FOLD, GV, BV, CVO) TR_MATP(SRC, KK, NN, DST, KK, SWI, FOLD, GV, BV, CVO)
#define TR_MATP(SRC, KK, NN, DST, DPITCH, SWI, FOLD, GV, BV, CVO) do { const int nblk = (NN) / 32, nit = ((KK) / 64) * nblk; \
        for (int it = gw; it < nit; it += NGW) { const int kb = it / nblk, nb = it % nblk, n0 = 32 * nb; int dr = n0; \
            if (SWI) { const int c = n0 < FF ? n0 : n0 - FF; dr = (c >> 7) * 256 + (c & 127) + (n0 < FF ? 0 : 128); } \
            p0_transpose_item<FOLD>((SRC), (KK), (NN), (bf16*)(ws + (DST)), (DPITCH), dr, scr, 64 * kb, n0, F.lane, (GV), (BV), (float*)(ws + WS_CP) + (size_t)kb * NCV + (CVO), (float*)(ws + WS_DP) + (size_t)kb * NCV + (CVO)); } } while (0)
    TR_MAT(a->in[2], DM, 2 * FF, WS_W1IN, true, false, nullptr, nullptr, 0);
    TR_MAT(a->in[3], FF, DM, WS_W1OUT, false, false, nullptr, nullptr, 0);
    TR_MAT(a->in[6], DM, NIN, WS_WIN, false, true, a->in[4], a->in[5], CV1);
    TR_MATP(a->in[12], 2048, DM, WS_WA, 3072, false, false, nullptr, nullptr, 0);
    TR_MATP(a->in[13], 1024, DM, WS_WA + 2048 * 2, 3072, false, false, nullptr, nullptr, 0);
    TR_MAT(a->in[14], DM, DM, WS_WOUT, false, false, nullptr, nullptr, 0);
    TR_MAT(a->in[17], DM, 2 * FF, WS_W2IN, true, true, a->in[15], a->in[16], CV2);
    TR_MAT(a->in[18], FF, DM, WS_W2OUT, false, false, nullptr, nullptr, 0);
    TR_MAT(a->in[21], DM, DM, WS_WG, false, true, a->in[19], a->in[20], CV3);
    TR_MAT(a->in[22], PLE, DM, WS_WP, false, false, nullptr, nullptr, 0);
#undef TR_MAT
#undef TR_MATP
    cvt_rows(F, a->in[0], (bf16*)(ws + WS_HB), (size_t)M * DM / 8);
    cvt_rows(F, a->in[1], (bf16*)(ws + WS_PB), (size_t)M * PLE / 8);
}
__device__ __forceinline__ void colsum_reduce(Frame& F, unsigned char* ws) {
    const int gt = (F.vcu * NWAVES + F.wave) * 64 + F.lane, NT = F.G * NWAVES * 64;
    const float* cp = (const float*)(ws + WS_CP); const float* dp = (const float*)(ws + WS_DP); float* cv = (float*)(ws + WS_CTL) + CW_CV;
    for (int n = gt; n < NCV; n += NT) { float c = 0.f, d = 0.f;
#pragma unroll 8
        for (int kb = 0; kb < 64; ++kb) { c += cp[(size_t)kb * NCV + n]; d += dp[(size_t)kb * NCV + n]; }
        cv[n] = c; cv[NCV + n] = d; }
}
__device__ __forceinline__ int ln_table(Frame& F, const float* part, int N, int wgm = 8) {
    pg8::StaticOrder S0; S0.init(M, N, F.G, (int)blockIdx.x, wgm); pg8::Unit u0, u2; S0.next(0, u0); u2 = u0; if (wgm != 8) S0.next(2, u2);
#pragma unroll
    for (int t = 0; t < 2; ++t) { const int pm = t ? u2.pm : u0.pm;
        if (F.tid < 256) { const GAS f32x4* p = (const GAS f32x4*)(part + (size_t)(pm * 256 + F.tid) * 32); float s1 = 0.f, s2 = 0.f;
#pragma unroll
            for (int i = 0; i < 8; ++i) { const f32x4 v = p[i]; s1 += v[0] + v[2]; s2 += v[1] + v[3]; }
            const float mu = s1 * (1.f / DM), var = fmaxf(s2 * (1.f / DM) - mu * mu, 0.f);
            *(LAS pg8::f32x2s*)(F.lds + pg8::LDS_STAB + (t * 256 + F.tid) * 8) = (pg8::f32x2s){mu, 1.f / sqrtf(var + LN_EPS)}; } }
    __syncthreads();
    return u0.pm;
}
template <bool WB>
__device__ __forceinline__ void ln_phase(Frame& F, float* hf, const float* g, const float* b, bf16* hb) {
    const int gw = F.vcu * NWAVES + F.wave, NGW = F.G * NWAVES;
    for (int m = gw; m < M; m += NGW) {
        GAS f32x4* xr = (GAS f32x4*)(hf + (size_t)m * DM) + F.lane;
        f32x4 v[16]; float s = 0.f;
#pragma unroll
        for (int j = 0; j < 16; ++j) { v[j] = xr[64 * j]; s += (v[j].x + v[j].y) + (v[j].z + v[j].w); }
        const float mean = wave_sum(s) * (1.f / DM); float s2 = 0.f;
#pragma unroll
        for (int j = 0; j < 16; ++j) { v[j] = v[j] - mean; s2 += (v[j].x * v[j].x + v[j].y * v[j].y) + (v[j].z * v[j].z + v[j].w * v[j].w); }
        const float rstd = 1.f / sqrtf(wave_sum(s2) * (1.f / DM) + LN_EPS);
        GAS unsigned long long* o8 = (GAS unsigned long long*)(hb + (size_t)m * DM) + F.lane;
#pragma unroll
        for (int j = 0; j < 16; ++j) { const f32x4 gv = *((const GAS f32x4*)g + F.lane + 64 * j), bv = *((const GAS f32x4*)b + F.lane + 64 * j);
            const f32x4 y = v[j] * rstd * gv + bv; xr[64 * j] = y;
            if (WB) o8[64 * j] = (unsigned long long)pk2(y.x, y.y) | ((unsigned long long)pk2(y.z, y.w) << 32); }
    }
}
__device__ __forceinline__ void ln4_phase(Frame& F, const bf16* src, float* out, const float* g, const float* b) {
    const int gw = F.vcu * NWAVES + F.wave, NGW = F.G * NWAVES;
    for (int m = gw; m < M; m += 2 * NGW) {
        v4u w[2][8]; float s[2] = {0.f, 0.f}, s2[2] = {0.f, 0.f};
#pragma unroll
        for (int t = 0; t < 2; ++t) { const GAS v4u* xr = (const GAS v4u*)(src + (size_t)(m + t * NGW) * DM) + F.lane;
#pragma unroll
            for (int j = 0; j < 8; ++j) w[t][j] = xr[64 * j]; }
        float mean[2], rstd[2];
#pragma unroll
        for (int t = 0; t < 2; ++t) {
#pragma unroll
            for (int j = 0; j < 8; ++j) { const unsigned u[4] = {w[t][j].x, w[t][j].y, w[t][j].z, w[t][j].w};
#pragma unroll
                for (int i = 0; i < 4; ++i) s[t] += __uint_as_float(u[i] << 16) + __uint_as_float(u[i] & 0xffff0000u); }
            mean[t] = wave_sum(s[t]) * (1.f / DM);
#pragma unroll
            for (int j = 0; j < 8; ++j) { const unsigned u[4] = {w[t][j].x, w[t][j].y, w[t][j].z, w[t][j].w};
#pragma unroll
                for (int i = 0; i < 4; ++i) { const float d0 = __uint_as_float(u[i] << 16) - mean[t], d1 = __uint_as_float(u[i] & 0xffff0000u) - mean[t]; s2[t] += d0 * d0 + d1 * d1; } }
            rstd[t] = 1.f / sqrtf(wave_sum(s2[t]) * (1.f / DM) + LN_EPS); }
#pragma unroll
        for (int j = 0; j < 8; ++j) { const GAS f32x4* gp = (const GAS f32x4*)g + 2 * (F.lane + 64 * j); const GAS f32x4* bp = (const GAS f32x4*)b + 2 * (F.lane + 64 * j);
            const f32x4 g0 = gp[0], g1 = gp[1], b0 = bp[0], b1 = bp[1];
#pragma unroll
            for (int t = 0; t < 2; ++t) { const v4u u = w[t][j]; GAS f32x4* o = (GAS f32x4*)(out + (size_t)(m + t * NGW) * DM) + 2 * (F.lane + 64 * j);
                const f32x4 x0 = {__uint_as_float(u.x << 16), __uint_as_float(u.x & 0xffff0000u), __uint_as_float(u.y << 16), __uint_as_float(u.y & 0xffff0000u)};
                const f32x4 x1 = {__uint_as_float(u.z << 16), __uint_as_float(u.z & 0xffff0000u), __uint_as_float(u.w << 16), __uint_as_float(u.w & 0xffff0000u)};
                o[0] = (x0 - mean[t]) * rstd[t] * g0 + b0; o[1] = (x1 - mean[t]) * rstd[t] * g1 + b1; } }
    }
}
__device__ __forceinline__ void combine_phase(Frame& F, const bf16* dilp, const float* lse, bf16* ob) {
    const int gw = F.vcu * NWAVES + F.wave, NGW = F.G * NWAVES;
    for (int m = gw; m < M; m += NGW) {
        const int h = F.lane >> 3;
        const float l0 = lse[(size_t)m * 8 + h], l1 = lse[(size_t)M * 8 + (size_t)m * 8 + h], l2 = lse[(size_t)2 * M * 8 + (size_t)m * 8 + h];
        const float mx = fmaxf(l0, fmaxf(l1, l2));
        float w0 = __builtin_amdgcn_exp2f(l0 - mx), w1 = __builtin_amdgcn_exp2f(l1 - mx), w2 = __builtin_amdgcn_exp2f(l2 - mx);
        const float inv = 1.f / (w0 + w1 + w2); w0 *= inv; w1 *= inv; w2 *= inv;
        float acc[16];
#pragma unroll
        for (int i = 0; i < 16; ++i) acc[i] = 0.f;
#pragma unroll
        for (int g = 0; g < 3; ++g) { const float w = g == 0 ? w0 : (g == 1 ? w1 : w2);
            const GAS v4u* p = (const GAS v4u*)(dilp + (size_t)g * M * 1024 + (size_t)m * 1024 + F.lane * 16);
            const v4u a = p[0], c = p[1];
            const unsigned wd[8] = {a.x, a.y, a.z, a.w, c.x, c.y, c.z, c.w};
#pragma unroll
            for (int i = 0; i < 8; ++i) { acc[2 * i] += w * __uint_as_float(wd[i] << 16); acc[2 * i + 1] += w * __uint_as_float(wd[i] & 0xffff0000u); } }
        v4u o0, o1; o0.x = pk2(acc[0], acc[1]); o0.y = pk2(acc[2], acc[3]); o0.z = pk2(acc[4], acc[5]); o0.w = pk2(acc[6], acc[7]);
        o1.x = pk2(acc[8], acc[9]); o1.y = pk2(acc[10], acc[11]); o1.z = pk2(acc[12], acc[13]); o1.w = pk2(acc[14], acc[15]);
        GAS v4u* q = (GAS v4u*)(ob + (size_t)m * 3072 + 2048 + F.lane * 16); q[0] = o0; q[1] = o1;
    }
}

__device__ __forceinline__ void attention_phase(Frame& F, KargP a, char* lds) {
    using att::f32x16; using att::crow;
    unsigned char* ws = a->ws;
    const att::bf16* QKV = (const att::bf16*)(ws + WS_BIG);
    float lam;
    { const int lane = F.lane; const float* q1 = a->in[7]; const float* k1 = a->in[8]; const float* q2 = a->in[9]; const float* k2 = a->in[10];
      const float s1 = wave_sum(q1[lane] * k1[lane] + q1[lane + 64] * k1[lane + 64]), s2 = wave_sum(q2[lane] * k2[lane] + q2[lane + 64] * k2[lane + 64]);
      lam = expf(s1) - expf(s2) + LAMBDA_INIT; ((float*)(lds + ATT_RED_OFF))[44] = lam; }
    const float* subg = a->in[11];
    bf16* OA = (bf16*)(ws + WS_OA);
    float* SCR = (float*)(ws + WS_SCR) + (size_t)blockIdx.x * (2 * 64 * 512);
#ifndef ATT_A
#define ATT_A 1
#endif
#ifndef ATT_B
#define ATT_B 1
#endif
    if (ATT_A) for (;;) {
        __syncthreads();
        if (F.wave == 0 && lane_id_fresh() == 0) ((int*)(lds + ATT_RED_OFF))[40] = (int)__hip_atomic_fetch_add((unsigned*)(F.ctl + CW_QA), 1u, __ATOMIC_RELAXED, __HIP_MEMORY_SCOPE_AGENT);
        __syncthreads();
        const int u = __builtin_amdgcn_readfirstlane(((const int*)(lds + ATT_RED_OFF))[40]);
        if (u >= BATCH * 8 * 16) break;
        const int h = 7 - (u >> 6), b = (u >> 4) & 3, qb = u & 15;
        const size_t rowbase = (size_t)b * SEQ;
        const float sl2 = rfl_f(__builtin_amdgcn_exp2f(-(float)(h + 1)) * LOG2E);
        { const float* NRM = (const float*)(ws + WS_NRM); const int tq = F.wave * 64 + lane_id_fresh();
          float km0 = 0.f, km1 = 0.f, qm0 = 0.f, qm1 = 0.f;
          const GAS f32x4* nk = (const GAS f32x4*)(NRM + rowbase * 128 + (8 + h) * 8);
          for (int j = tq; j < SEQ; j += NWAVES * 64) { const f32x4 a = nk[(size_t)j * 32], c4 = nk[(size_t)j * 32 + 1];
              km0 = fmaxf(km0, (a.x + a.y) + (a.z + a.w)); km1 = fmaxf(km1, (c4.x + c4.y) + (c4.z + c4.w)); }
          float dg = 0.f;
          { const GAS v4u* qp = (const GAS v4u*)(QKV + (rowbase + qb * 256 + (tq & 255)) * NQKV + h * 256 + (tq >> 8) * 128);
            const GAS v4u* kp2 = (const GAS v4u*)(QKV + (rowbase + qb * 256 + (tq & 255)) * NQKV + 2048 + h * 256 + (tq >> 8) * 128);
#pragma unroll 4
            for (int i = 0; i < 16; ++i) { const v4u a = qp[i], c4 = kp2[i];
                dg += __uint_as_float(a.x << 16) * __uint_as_float(c4.x << 16) + __uint_as_float(a.x & 0xffff0000u) * __uint_as_float(c4.x & 0xffff0000u);
                dg += __uint_as_float(a.y << 16) * __uint_as_float(c4.y << 16) + __uint_as_float(a.y & 0xffff0000u) * __uint_as_float(c4.y & 0xffff0000u);
                dg += __uint_as_float(a.z << 16) * __uint_as_float(c4.z << 16) + __uint_as_float(a.z & 0xffff0000u) * __uint_as_float(c4.z & 0xffff0000u);
                dg += __uint_as_float(a.w << 16) * __uint_as_float(c4.w << 16) + __uint_as_float(a.w & 0xffff0000u) * __uint_as_float(c4.w & 0xffff0000u); } }
          if (tq < 256) { const GAS f32x4* nq = (const GAS f32x4*)(NRM + (rowbase + qb * 256 + tq) * 128 + h * 8); const f32x4 a = nq[0], c4 = nq[1];
              qm0 = (a.x + a.y) + (a.z + a.w); qm1 = (c4.x + c4.y) + (c4.z + c4.w); }
          XL_RED64(fminf, dg); XL_RED64(fmaxf, km0); XL_RED64(fmaxf, km1); XL_RED64(fmaxf, qm0); XL_RED64(fmaxf, qm1);
          float* red = (float*)(lds + ATT_RED_OFF);
          __syncthreads();
          if ((tq & 63) == 0) { red[48 + F.wave] = dg; red[F.wave * 4 + 0] = km0; red[F.wave * 4 + 1] = km1; red[F.wave * 4 + 2] = qm0; red[F.wave * 4 + 3] = qm1; }
          __syncthreads();
#pragma unroll
          for (int w = 0; w < NWAVES; ++w) { km0 = fmaxf(km0, red[w * 4 + 0]); km1 = fmaxf(km1, red[w * 4 + 1]); qm0 = fmaxf(qm0, red[w * 4 + 2]); qm1 = fmaxf(qm1, red[w * 4 + 3]); }
#pragma unroll
          for (int c = 0; c < 2; ++c) { const float S = rfl_f(sqrtf((c ? qm1 : qm0) * (c ? km1 : km0))) * 1.01f;
              const float mlb = fmaxf(rfl_f(fminf(fminf(red[48 + 4 * c], red[49 + 4 * c]), fminf(red[50 + 4 * c], red[51 + 4 * c]))) - 0.01f, -S);
              const float dmin = (S - mlb + PRUNE_T) / sl2; const int D = dmin > 8192.f ? 8192 : (int)dmin + 1, q0 = qb * 256;
              int lo = (q0 - 63 - D + 64 * 256) / 64 - 256 + 1; if (lo < 0) lo = 0;
              int hi_t = (q0 + 255 + D + 63) / 64 - 1; if (hi_t > SEQ / 64 - 1) hi_t = SEQ / 64 - 1;
              const int nt = hi_t - lo + 1;
              if (tq == 0) { ((int*)red)[32 + c] = lo; ((int*)red)[34 + c] = nt; ((int*)red)[36 + c] = D; } }
          __syncthreads(); }
        for (int c = 0; c < 2; ++c) {
            const int t0 = __builtin_amdgcn_readfirstlane(((const int*)(lds + ATT_RED_OFF))[32 + c]), NTc = __builtin_amdgcn_readfirstlane(((const int*)(lds + ATT_RED_OFF))[34 + c]);
            const att::bf16* Qb = QKV + (rowbase + qb * 256) * NQKV + h * 256 + c * 128;
            const att::bf16* Kh = QKV + rowbase * NQKV + 2048 + h * 256 + c * 128;
            const att::bf16* Vh = QKV + rowbase * NQKV + 4096 + h * 256;
            f32x16 o[8]; float m_reg, l_reg;
            { const int l0 = lane_id_fresh(); const float dq = (float)(qb * 256 + F.wave * 32 + (l0 & 31) - 4 * (l0 >> 5) - 64 * t0);
              const int Dc = __builtin_amdgcn_readfirstlane(((const int*)(lds + ATT_RED_OFF))[36 + c]), W0 = qb * 256 + F.wave * 32;
              int wlo = (W0 - 63 - Dc + 64 * 256) / 64 - 256 + 1 - t0, whi = (W0 + 31 + Dc + 63) / 64 - 1 - t0; if (wlo < 0) wlo = 0; if (whi > NTc - 1) whi = NTc - 1;
              att::attn_core_dv256(Qb, Kh, Vh, (unsigned)NQKV, NTc, t0, dq, sl2, F.wave, wlo, whi, lds, o, m_reg, l_reg); }
            const int wid = F.wave, lane = lane_id_fresh(), tid = wid * 64 + lane, r32 = lane & 31, hi = lane >> 5;
            float* wsx = (float*)(lds + att::WS2_OFF) + wid * 64;
            if (hi == 0) wsx[r32] = l_reg;
            asm volatile("s_waitcnt lgkmcnt(0)" ::: "memory");
            float rli[16];
#pragma unroll
            for (int r = 0; r < 16; ++r) rli[r] = __builtin_amdgcn_rcpf(wsx[crow(r, hi)]);
            GAS f32x4* scr4 = (GAS f32x4*)(SCR + (size_t)tid * 128); asm volatile("" : "+v"(scr4));
            if (c == 0) {
#pragma unroll
                for (int d0 = 0; d0 < 8; ++d0)
#pragma unroll
                    for (int q = 0; q < 4; ++q) scr4[d0 * 4 + q] = (f32x4){o[d0][4 * q] * rli[4 * q], o[d0][4 * q + 1] * rli[4 * q + 1], o[d0][4 * q + 2] * rli[4 * q + 2], o[d0][4 * q + 3] * rli[4 * q + 3]};
            } else {
                float ssq[16]; const float lam_l = ((const float*)(lds + ATT_RED_OFF))[44];
#pragma unroll
                for (int r = 0; r < 16; ++r) ssq[r] = 0.f;
#pragma unroll
                for (int d0 = 0; d0 < 8; ++d0) {
#pragma unroll
                    for (int q = 0; q < 4; ++q) { f32x4 d = scr4[d0 * 4 + q];
#pragma unroll
                        for (int i = 0; i < 4; ++i) { d[i] = d[i] - lam_l * (o[d0][4 * q + i] * rli[4 * q + i]); ssq[4 * q + i] += d[i] * d[i]; }
                        scr4[d0 * 4 + q] = d; }
                    asm volatile("" ::: "memory"); }
#pragma unroll
                for (int r = 0; r < 16; ++r) { float s = ssq[r]; XL_RED32(xl_add, s); ssq[r] = (1.0f - LAMBDA_INIT) / sqrtf(s * (1.f / 256.f) + SUBLN_EPS); }
                GAS bf16* orow = (GAS bf16*)(OA + (rowbase + qb * 256 + wid * 32) * 3072 + h * 256 + r32); asm volatile("" : "+v"(orow));
#pragma unroll
                for (int d0 = 0; d0 < 8; ++d0) { const float g = subg[d0 * 32 + r32];
#pragma unroll
                    for (int q = 0; q < 4; ++q) { const f32x4 d = scr4[d0 * 4 + q];
#pragma unroll
                        for (int i = 0; i < 4; ++i) orow[(size_t)crow(4 * q + i, hi) * 3072 + d0 * 32] = (bf16)f2bf(d[i] * ssq[4 * q + i] * g); }
                    asm volatile("" ::: "memory"); }
            }
        }
    }
    bf16* DILP = (bf16*)(ws + WS_DILP); float* LSE = (float*)(ws + WS_LSE);
    if (ATT_B) for (;;) {
        __syncthreads();
        if (F.wave == 0 && lane_id_fresh() == 0) ((int*)(lds + 16384))[0] = (int)__hip_atomic_fetch_add((unsigned*)(F.ctl + CW_QB), 1u, __ATOMIC_RELAXED, __HIP_MEMORY_SCOPE_AGENT);
        __syncthreads();
        const int u = __builtin_amdgcn_readfirstlane(((const int*)(lds + 16384))[0]    );
        if (u >= BATCH * 8 * 48) break;
        const int b = u / 384, rem = u % 384, h = rem / 48, rem2 = rem % 48, g = rem2 >> 4, w = rem2 & 15;
        const int dil = g == 0 ? 1 : (g == 1 ? 4 : 16), nU = 16 / dil, cls = w / nU, uu = w % nU, L = SEQ / dil;
        const size_t rowbase = (size_t)b * SEQ + cls;
        const long ld = (long)dil * NQKV;
        const att::bf16* Qb = QKV + (rowbase + (size_t)uu * 256 * dil) * NQKV + 6144 + g * 1024 + h * 128;
        const att::bf16* Kh = QKV + rowbase * NQKV + 9216 + g * 1024 + h * 128;
        const att::bf16* Vh = QKV + rowbase * NQKV + 12288 + g * 1024 + h * 128;
        const float sl2 = rfl_f(__builtin_amdgcn_exp2f(-(float)(3 * h + g + 1) * (1.f / 3.f)) * (float)dil * LOG2E);
        f32x16 o[4]; float m_reg, l_reg;
        { const int l0 = lane_id_fresh(); const float dq = (float)(64 + F.wave * 32 + (l0 & 31) - 4 * (l0 >> 5));
          att::attn_core_band(Qb, Kh, Vh, (unsigned)ld, 6, 4 * uu - 1, L / 64, dq, sl2, F.wave, F.wave >> 1, (F.wave >> 1) + 2, lds, o, m_reg, l_reg); }
        const int wid = F.wave, lane = lane_id_fresh(), r32 = lane & 31, hi = lane >> 5;
        float* wsx = (float*)(lds + att::WS2_OFF) + wid * 64;
        if (hi == 0) wsx[r32] = l_reg;
        asm volatile("s_waitcnt lgkmcnt(0)" ::: "memory");
        float rli[16];
#pragma unroll
        for (int r = 0; r < 16; ++r) rli[r] = __builtin_amdgcn_rcpf(wsx[crow(r, hi)]);
        GAS bf16* obase = (GAS bf16*)(DILP + (size_t)g * M * 1024 + h * 128 + r32); asm volatile("" : "+v"(obase));
#pragma unroll
        for (int r = 0; r < 16; ++r) { const size_t tok = rowbase + (size_t)(uu * 256 + wid * 32 + crow(r, hi)) * dil;
#pragma unroll
            for (int d0 = 0; d0 < 4; ++d0) obase[tok * 1024 + d0 * 32] = (bf16)f2bf(o[d0][r] * rli[r]); }
        if (hi == 0) { const size_t tok = rowbase + (size_t)(uu * 256 + wid * 32 + r32) * dil; LSE[(size_t)g * M * 8 + tok * 8 + h] = m_reg + __builtin_amdgcn_logf(l_reg); }
    }
}

static_assert(PG8_ALIGN, "the residual epilogue's workgroup barrier needs both half-workgroups in their epilogues together (ALIGN_EPI)");
__global__ void __launch_bounds__(NWAVES * 64, 2) mega_fwd(Args args) {
    extern __shared__ __attribute__((aligned(16))) unsigned char lds[];
    Frame F;
    F.lds = (LAS unsigned char*)lds;
    F.MISC = (volatile LAS unsigned*)(F.lds + MISC_OFF);
    F.wave = __builtin_amdgcn_readfirstlane((int)threadIdx.x >> 6); F.lane = lane_id_fresh(); F.tid = F.wave * 64 + F.lane;
    F.G = gridDim.x; { const int bx = blockIdx.x; F.vcu = (F.G % 8 == 0) ? (bx % 8) * (F.G / 8) + bx / 8 : bx; }
    KargP kp = (KargP)__builtin_amdgcn_kernarg_segment_ptr();
#define RELOAD() asm volatile("" : "+s"(kp))
    unsigned char* ws = kp->ws;
    F.ctl = (gu32*)(ws + WS_CTL);
    for (int u = F.tid; u < (LDS_BYTES - LDSCTL_OFF) / 4; u += NWAVES * 64) ((LAS unsigned*)(F.lds + LDSCTL_OFF))[u] = 0u;
    __syncthreads();
    XcdBarrier bar = xcd_barrier_post((unsigned*)(F.ctl + CW_BAR), F.MISC + 8, F.tid == 0);
#define GRID_BAR() do { xcd_barrier(bar, F.wave == 0 && lane_id_fresh() == 0); RELOAD(); ws = kp->ws; F.lane = lane_id_fresh(); F.tid = F.wave * 64 + F.lane; } while (0)
#define GEMM(EPI, A_, B_, N_, K_, E_) GEMMW(EPI, A_, B_, N_, K_, E_, 8)
#define GEMMW(EPI, A_, B_, N_, K_, E_, WGM_) do { pg8::Gemm g_{(const pg8::bf16_t*)(A_), (const pg8::bf16_t*)(B_), M, (N_), (K_), (K_)}; pg8::StaticOrder S_; S_.init(M, (N_), F.G, (int)blockIdx.x, (WGM_)); \
        pg8::gemm_phase<decltype(E_), pg8::StaticOrder, PG8_ALIGN, PG8_SP2>(F.lds + RING_OFF, g_, S_, (E_), F.wave); } while (0)
#define hf (kp->out)
#define hb ((bf16*)(ws + WS_HB))
#define big ((bf16*)(ws + WS_BIG))
#define PARTB(i) ((float*)(ws + WS_PART) + (size_t)(i) * M * 32)
#define CSV(o) ((const float*)(ws + WS_CTL) + CW_CV + (o))
#define DSV(o) ((const float*)(ws + WS_CTL) + CW_CV + NCV + (o))

    p0_prologue(F, kp);
    GRID_BAR();
    { pg8::EpiSwiglu<false> E; E.O = (pg8::bf16_t*)big; E.ldc = FF; E.L = F.lds; E.CS = E.DS = (const float*)ws; GEMM(pg8::EpiSwiglu<false>, hb, ws + WS_W1IN, 2 * FF, DM, E); }
    __syncthreads();
    { constexpr int NU1 = (M / 256) * (2 * FF / 256); const int rem = NU1 % F.G;
      const int gpp = rem ? F.G - rem : F.G, cpp = rem ? (int)blockIdx.x - rem : (int)blockIdx.x;
      if (cpp >= 0) { pg8::EpiBf16Plain E{(pg8::bf16_t*)(ws + WS_PP), DM}; pg8::Gemm g_{(const pg8::bf16_t*)(ws + WS_PB), (const pg8::bf16_t*)(ws + WS_WP), M, DM, PLE, PLE}; pg8::StaticOrder S_; S_.init(M, DM, gpp, cpp);
          pg8::gemm_phase<pg8::EpiBf16Plain, pg8::StaticOrder, PG8_ALIGN, PG8_SP2>(F.lds + RING_OFF, g_, S_, E, F.wave); } }
    GRID_BAR();
    colsum_reduce(F, ws);
    { pg8::EpiResid<true, 0, 1> E; E.X = kp->in[0]; E.HB = (pg8::bf16_t*)hb; E.L = F.lds; E.PART = PARTB(0); E.pm0 = 0; GEMMW((pg8::EpiResid<true, 0, 1>), big, ws + WS_W1OUT, DM, FF, E, FFOUT_WGM); }
    GRID_BAR();
    { ln_table(F, PARTB(0), NIN); pg8::EpiInProj E; E.QKV = (pg8::bf16_t*)big; E.G = (pg8::bf16_t*)(ws + WS_GATES); E.qscale = QSCALE; E.NRM = (float*)(ws + WS_NRM); E.L = F.lds; E.CS = CSV(CV1); E.DS = DSV(CV1); GEMM(pg8::EpiInProj, hb, ws + WS_WIN, NIN, DM, E); }
    GRID_BAR();
    attention_phase(F, kp, (char*)lds);
    GRID_BAR();
    combine_phase(F, (const bf16*)(ws + WS_DILP), (const float*)(ws + WS_LSE), (bf16*)(ws + WS_OA));
    GRID_BAR();
    { pg8::EpiGateAB E{(const pg8::bf16_t*)(ws + WS_GATES), (pg8::bf16_t*)(ws + WS_Y)}; GEMM(pg8::EpiGateAB, ws + WS_OA, ws + WS_WA, DM, 3072, E); }
    GRID_BAR();
    { pg8::EpiResid<false, 4, 0> E; E.pm0 = ln_table(F, PARTB(0), DM); E.X = nullptr; E.HB = (pg8::bf16_t*)hb; E.L = F.lds; E.PART = PARTB(1); GEMM((pg8::EpiResid<false, 4, 0>), ws + WS_Y, ws + WS_WOUT, DM, DM, E); }
    GRID_BAR();
    { ln_table(F, PARTB(1), 2 * FF); pg8::EpiSwiglu<true> E; E.O = (pg8::bf16_t*)big; E.ldc = FF; E.L = F.lds; E.CS = CSV(CV2); E.DS = DSV(CV2);
      constexpr int NU2 = (M / 256) * (2 * FF / 256); static_assert(NU2 % 256 == 128, "the split tail is written for 128 left-over units on 256 workgroups");
      { pg8::Gemm g_{(const pg8::bf16_t*)hb, (const pg8::bf16_t*)(ws + WS_W2IN), M, 2 * FF, DM, DM}; pg8::StaticOrder S_; S_.init(M, 2 * FF, F.G, (int)blockIdx.x); S_.imax = NU2 / 256;
        pg8::gemm_phase<pg8::EpiSwiglu<true>, pg8::StaticOrder, PG8_ALIGN, PG8_SP2>(F.lds + RING_OFF, g_, S_, E, F.wave); }
      const int v = (int)blockIdx.x & 127, role = (int)blockIdx.x >> 7;
      pg8::StaticOrder S0; S0.init(M, 2 * FF, F.G, v); pg8::OneUnit T; S0.next(NU2 / 256, T.u);
      pg8::EpiSwigluTail E2; E2.O = (pg8::bf16_t*)big; E2.ldc = FF; E2.L = F.lds; E2.CS = CSV(CV2); E2.DS = DSV(CV2); E2.P = (float*)(ws + WS_SCR) + (size_t)v * 65536; E2.FLAG = (unsigned*)(ws + WS_CTL) + CW_SPLIT + v; E2.role = role;
      pg8::Gemm g2{(const pg8::bf16_t*)hb + role * (DM / 2), (const pg8::bf16_t*)(ws + WS_W2IN) + role * (DM / 2), M, 2 * FF, DM / 2, DM};
      pg8::gemm_phase<pg8::EpiSwigluTail, pg8::OneUnit, PG8_ALIGN, PG8_SP2>(F.lds + RING_OFF, g2, T, E2, F.wave); }
    GRID_BAR();
    { pg8::EpiResid<false, 15, 1> E; E.pm0 = ln_table(F, PARTB(1), DM, FFOUT_WGM); E.X = nullptr; E.HB = (pg8::bf16_t*)hb; E.L = F.lds; E.PART = PARTB(2); GEMMW((pg8::EpiResid<false, 15, 1>), big, ws + WS_W2OUT, DM, FF, E, FFOUT_WGM); }
    GRID_BAR();
    { ln_table(F, PARTB(2), DM); pg8::EpiPle E; E.HB = (const pg8::bf16_t*)hb; E.out = (pg8::bf16_t*)big; E.PP = (const pg8::bf16_t*)(ws + WS_PP); E.L = F.lds; E.CS = CSV(CV3); E.DS = DSV(CV3); GEMM(pg8::EpiPle, hb, ws + WS_WG, DM, DM, E); }
    GRID_BAR();
    ln4_phase(F, big, hf, kp->in[23], kp->in[24]);
#undef GEMM
#undef GEMMW
#undef GRID_BAR
#undef hf
#undef hb
#undef big
#undef PARTB
#undef CSV
#undef DSV
}

extern "C" void kernel_launch(void* const* d_in, const int* in_sizes, int n_in, void* d_out, int out_size, void* d_ws, size_t ws_size, hipStream_t stream) {
    static int grid = 0;
    if (grid == 0) {
        if (n_in != 25 || in_sizes[0] != M * DM || out_size != M * DM || ws_size < WS_END) { fprintf(stderr, "kernel_launch: shape mismatch: n_in %d in0 %d out %d ws %zu (need %zu)\n", n_in, n_in > 0 ? in_sizes[0] : -1, out_size, ws_size, (size_t)WS_END); grid = -1; return; }
        int dev = 0, cus = 0;
        if (hipGetDevice(&dev) != hipSuccess || hipDeviceGetAttribute(&cus, hipDeviceAttributeMultiprocessorCount, dev) != hipSuccess) { grid = -1; return; }
        if (hipFuncSetAttribute((const void*)mega_fwd, hipFuncAttributeMaxDynamicSharedMemorySize, LDS_BYTES) != hipSuccess) { fprintf(stderr, "kernel_launch: hipFuncSetAttribute failed\n"); grid = -1; return; }
        int per_cu = 0;
        if (hipOccupancyMaxActiveBlocksPerMultiprocessor(&per_cu, (const void*)mega_fwd, NWAVES * 64, LDS_BYTES) != hipSuccess || per_cu < 1) fprintf(stderr, "kernel_launch: occupancy query reports %d\n", per_cu);
        (void)hipGetLastError();
        if (cus != 256) { fprintf(stderr, "kernel_launch: built for 256 CUs (every workgroup owns one 256-row panel per GEMM phase); this device has %d; nothing launched\n", cus); grid = -1; return; }
        grid = cus;
    }
    if (grid < 0) return;
    if (hipMemsetAsync((char*)d_ws + WS_CTL, 0, CTL_ZERO_BYTES, stream) != hipSuccess) return;
    Args a{};
    for (int i = 0; i < 25; ++i) a.in[i] = (const float*)d_in[i];
    a.out = (float*)d_out; a.ws = (unsigned char*)d_ws;
    hipLaunchKernelGGL(mega_fwd, dim3(grid), dim3(NWAVES * 64), LDS_BYTES, stream, a);
    const hipError_t le = hipPeekAtLastError();
    if (le != hipSuccess) fprintf(stderr, "kernel_launch: launch failed: %s\n", hipGetErrorName(le));
}
```

```cpp
#include <hip/hip_runtime.h>
#include <hip/hip_bf16.h>
#include <cstdio>
#include <cstdint>
struct Args { const float* in[25]; float* out; unsigned char* ws; };
typedef const __attribute__((address_space(4))) Args* KargP;
#define KARG_IN(k) (((KargP)__builtin_amdgcn_kernarg_segment_ptr())->in[(k)])
template <int CTRL> __device__ __forceinline__ float xl_dpp(float v) { return __builtin_bit_cast(float, __builtin_amdgcn_update_dpp(0, __builtin_bit_cast(int, v), CTRL, 0xF, 0xF, true)); }
#define XL_STEP(OP, v, CTRL) v = OP(v, xl_dpp<CTRL>(v))
__device__ __forceinline__ void xl_swap16(float& a, float& b) { asm volatile("s_nop 1\n\tv_permlane16_swap_b32 %0, %1" : "+v"(a), "+v"(b)); }
__device__ __forceinline__ void xl_swap32(float& a, float& b) { asm volatile("s_nop 1\n\tv_permlane32_swap_b32 %0, %1" : "+v"(a), "+v"(b)); }
#define XL_SWAP16(OP, v) do { float a_ = v, b_ = v; xl_swap16(a_, b_); v = OP(a_, b_); } while (0)
#define XL_SWAP32(OP, v) do { float a_ = v, b_ = v; xl_swap32(a_, b_); v = OP(a_, b_); } while (0)
__device__ __forceinline__ float xl_add(float a, float b) { return a + b; }
#define XL_RED8(OP, v)  do { XL_STEP(OP, v, 0xB1); XL_STEP(OP, v, 0x4E); XL_STEP(OP, v, 0x141); } while (0)
#define XL_RED32(OP, v) do { XL_RED8(OP, v); XL_STEP(OP, v, 0x140); XL_SWAP16(OP, v); } while (0)
#define XL_RED64(OP, v) do { XL_RED32(OP, v); XL_SWAP32(OP, v); } while (0)
#define XL_RED_16_32(OP, v) do { XL_SWAP16(OP, v); XL_SWAP32(OP, v); } while (0)
__device__ __forceinline__ int lane_id_fresh() { int l; asm volatile("v_mbcnt_lo_u32_b32 %0, -1, 0\n\tv_mbcnt_hi_u32_b32 %0, -1, %0" : "=v"(l)); return l; }
__device__ __forceinline__ float rfl_f(float x) { return __builtin_bit_cast(float, __builtin_amdgcn_readfirstlane(__builtin_bit_cast(int, x))); }
namespace pg8 {
#define PG8_LAS __attribute__((address_space(3)))
typedef unsigned short bf16_t;
typedef short bf16x8 __attribute__((ext_vector_type(8)));
typedef float f32x4 __attribute__((ext_vector_type(4)));
typedef unsigned u32x4 __attribute__((ext_vector_type(4)));
constexpr int BM = 256, BK = 64, HALF = 128, HTB = HALF * BK * 2  , STAGE_BYTES = 8 * HTB, NXCD = 8, WGM = 8;

__host__ __device__ __forceinline__ int lds_byte(int r, int c) { const int st = (r >> 4) * 2 + (c >> 5), rr = r & 15, cc = c & 31, ob = rr * 64 + cc * 2; return st * 1024 + (ob ^ (((ob >> 9) & 1) << 5)); }
__host__ __device__ __forceinline__ void stage_rc(int b, int& R, int& C) { const int st = b / 1024, sb = b % 1024, swz = sb ^ (((sb >> 9) & 1) << 5); R = (st >> 1) * 16 + swz / 64; C = (st & 1) * 32 + (swz % 64) / 2; }
__host__ __device__ __forceinline__ int perm32(int rho) { const int n = rho >> 4, i = rho & 15; return 8 * (i >> 2) + 4 * n + (i & 3); }

struct Unit { int pm, pn; };
struct Gemm { const bf16_t* A; const bf16_t* Bt; int M, N, K, ld; };

struct StaticOrder {
    int nM, nN, nwg, G, c, wgm, imax;
    __host__ __device__ void init(int M, int N, int G_, int c_, int wgm_ = WGM) { nM = M / BM; nN = N / BM; nwg = nM * nN; G = G_; c = c_; wgm = wgm_; imax = 1 << 30; }
    __host__ __device__ bool next(int i, Unit& u) const {
        const long L = (long)i * G + c; if (L >= nwg || i >= imax) return false;
        int wgid = (int)L; { const int q = nwg / NXCD, r = nwg % NXCD, xcd = wgid % NXCD, off = wgid / NXCD; wgid = (xcd < r ? xcd * (q + 1) : r * (q + 1) + (xcd - r) * q) + off; }
        const int nig = wgm * nN, gid = wgid / nig, fm = gid * wgm, gsz = (nM - fm) < wgm ? (nM - fm) : wgm;
        u.pm = fm + ((wgid % nig) % gsz); u.pn = (wgid % nig) / gsz; return true;
    }
    __device__ __forceinline__ void a_ready(const Unit&) const {}
    __device__ __forceinline__ void done(const Unit&) const {}
};
struct OneUnit {
    Unit u;
    __host__ __device__ bool next(int i, Unit& o) const { if (i != 0) return false; o = u; return true; }
    __device__ __forceinline__ void a_ready(const Unit&) const {}
    __device__ __forceinline__ void done(const Unit&) const {}
};

__device__ __forceinline__ unsigned cvt_pk_bf16(float lo, float hi) { unsigned r; asm volatile("v_cvt_pk_bf16_f32 %0, %1, %2" : "=v"(r) : "v"(lo), "v"(hi)); return r; }
typedef unsigned u32x2 __attribute__((ext_vector_type(2)));
__device__ __forceinline__ float bf_lo(unsigned w) { return __uint_as_float(w << 16); }
__device__ __forceinline__ float bf_hi(unsigned w) { return __uint_as_float(w & 0xffff0000u); }
__device__ __forceinline__ float sigmoid_f(float x) { return __builtin_amdgcn_rcpf(1.0f + __builtin_amdgcn_exp2f(x * -1.4426950408889634f)); }
__device__ __forceinline__ f32x4 sigmoid4(f32x4 v) { return (f32x4){sigmoid_f(v[0]), sigmoid_f(v[1]), sigmoid_f(v[2]), sigmoid_f(v[3])}; }
__device__ __forceinline__ u32x4 pack8(f32x4 v0, f32x4 v1) { u32x4 w; w.x = cvt_pk_bf16(v0[0], v0[1]); w.y = cvt_pk_bf16(v0[2], v0[3]); w.z = cvt_pk_bf16(v1[0], v1[1]); w.w = cvt_pk_bf16(v1[2], v1[3]); return w; }

typedef float f32x2s __attribute__((ext_vector_type(2)));
constexpr int LDS_PTAB = 132096, LDS_STAB = 140288, LDS_GTAB = 144384  ;
__device__ __forceinline__ void ln_row_stats(PG8_LAS unsigned char* L, int rloc, float& mu, float& rs) { const f32x2s s = *(const PG8_LAS f32x2s*)(L + LDS_STAB + rloc * 8); mu = s.x; rs = s.y; }
__device__ __forceinline__ f32x4 fmaxf4(f32x4 v) { return (f32x4){fmaxf(v[0], 1e-30f), fmaxf(v[1], 1e-30f), fmaxf(v[2], 1e-30f), fmaxf(v[3], 1e-30f)}; }
__device__ __forceinline__ float hsum4(f32x4 v) { return (v[0] + v[1]) + (v[2] + v[3]); }
template <bool LNIN> struct EpiSwiglu {
    static constexpr bool PERM = true, AFTER_DRAIN = false; static constexpr int TSW = 0;
    bf16_t* O; int ldc; PG8_LAS unsigned char* L; const float* CS; const float* DS;
    __device__ __forceinline__ void operator()(const f32x4 (&acc)[2][2][4][2], const Unit& u, int wr, int wc, int fr, int fq) const {
        const int row0 = u.pm * BM + wr * 64 + fr, col0 = u.pn * HALF + wc * 32 + 8 * fq, bcol = u.pn * BM + wc * 32 + 8 * fq;
        f32x4 cg[2], cu[2], dg[2], du[2];
        if (LNIN) {
#pragma unroll
            for (int n = 0; n < 2; ++n) { cg[n] = *(const f32x4*)(CS + bcol + 4 * n); cu[n] = *(const f32x4*)(CS + bcol + HALF + 4 * n); dg[n] = *(const f32x4*)(DS + bcol + 4 * n); du[n] = *(const f32x4*)(DS + bcol + HALF + 4 * n); } }
#pragma unroll
        for (int ai = 0; ai < 2; ++ai)
#pragma unroll
            for (int m = 0; m < 4; ++m) { const size_t row = (size_t)(row0 + ai * HALF + m * 16); bf16_t* rowp = O + row * ldc + col0;
                f32x4 g0 = acc[ai][0][m][0], g1 = acc[ai][0][m][1], u0 = acc[ai][1][m][0], u1 = acc[ai][1][m][1];
                if (LNIN) { float mu, rs; ln_row_stats(L, ai * HALF + wr * 64 + m * 16 + fr, mu, rs);
                    g0 = (g0 - cg[0] * mu) * rs + dg[0]; g1 = (g1 - cg[1] * mu) * rs + dg[1]; u0 = (u0 - cu[0] * mu) * rs + du[0]; u1 = (u1 - cu[1] * mu) * rs + du[1]; }
                const f32x4 h0 = g0 * sigmoid4(g0) * u0, h1 = g1 * sigmoid4(g1) * u1;
                *(u32x4*)rowp = pack8(h0, h1); }
    }
};
struct EpiSwigluTail {
    static constexpr bool PERM = true, AFTER_DRAIN = false; static constexpr int TSW = 0;
    bf16_t* O; int ldc; PG8_LAS unsigned char* L; const float* CS; const float* DS; float* P; unsigned* FLAG; int role;
    __device__ __forceinline__ void operator()(const f32x4 (&acc)[2][2][4][2], const Unit& u, int wr, int wc, int fr, int fq) const {
        const int tid = (wr * 4 + wc) * 64 + fq * 16 + fr;
        f32x4* Pt = (f32x4*)P + tid;
        if (role) {
#pragma unroll
            for (int ai = 0; ai < 2; ++ai)
#pragma unroll
                for (int bj = 0; bj < 2; ++bj)
#pragma unroll
                    for (int m = 0; m < 4; ++m)
#pragma unroll
                        for (int n = 0; n < 2; ++n) Pt[(size_t)(((ai * 2 + bj) * 4 + m) * 2 + n) * 512] = acc[ai][bj][m][n];
            asm volatile("s_waitcnt vmcnt(0)" ::: "memory"); __builtin_amdgcn_s_barrier();
            if (tid == 0) { __builtin_amdgcn_fence(__ATOMIC_RELEASE, "agent"); asm volatile("s_waitcnt vmcnt(0)" ::: "memory");
                __hip_atomic_store(FLAG, 1u, __ATOMIC_RELAXED, __HIP_MEMORY_SCOPE_AGENT); }
            return; }
        if (tid == 0) { unsigned sp = 0; while (__hip_atomic_load(FLAG, __ATOMIC_RELAXED, __HIP_MEMORY_SCOPE_AGENT) == 0u && ++sp < (1u << 22)) __builtin_amdgcn_s_sleep(1);
            __builtin_amdgcn_fence(__ATOMIC_ACQUIRE, "agent"); asm volatile("s_waitcnt vmcnt(0)" ::: "memory"); }
        __builtin_amdgcn_s_barrier(); asm volatile("" ::: "memory");
        const int row0 = u.pm * BM + wr * 64 + fr, col0 = u.pn * HALF + wc * 32 + 8 * fq, bcol = u.pn * BM + wc * 32 + 8 * fq;
        f32x4 cg[2], cu[2], dg[2], du[2];
#pragma unroll
        for (int n = 0; n < 2; ++n) { cg[n] = *(const f32x4*)(CS + bcol + 4 * n); cu[n] = *(const f32x4*)(CS + bcol + HALF + 4 * n); dg[n] = *(const f32x4*)(DS + bcol + 4 * n); du[n] = *(const f32x4*)(DS + bcol + HALF + 4 * n); }
#pragma unroll
        for (int ai = 0; ai < 2; ++ai)
#pragma unroll
            for (int m = 0; m < 4; ++m) { const size_t row = (size_t)(row0 + ai * HALF + m * 16); bf16_t* rowp = O + row * ldc + col0;
#define PV_(bj, n) __builtin_nontemporal_load(Pt + (size_t)(((ai * 2 + (bj)) * 4 + m) * 2 + (n)) * 512)
                f32x4 g0 = acc[ai][0][m][0] + PV_(0, 0), g1 = acc[ai][0][m][1] + PV_(0, 1), u0 = acc[ai][1][m][0] + PV_(1, 0), u1 = acc[ai][1][m][1] + PV_(1, 1);
#undef PV_
                float mu, rs; ln_row_stats(L, ai * HALF + wr * 64 + m * 16 + fr, mu, rs);
                g0 = (g0 - cg[0] * mu) * rs + dg[0]; g1 = (g1 - cg[1] * mu) * rs + dg[1]; u0 = (u0 - cu[0] * mu) * rs + du[0]; u1 = (u1 - cu[1] * mu) * rs + du[1];
                const f32x4 h0 = g0 * sigmoid4(g0) * u0, h1 = g1 * sigmoid4(g1) * u1;
                *(u32x4*)rowp = pack8(h0, h1); }
    }
};
template <bool XIN, int GI, int BHALF> struct EpiResid {
    static constexpr bool PERM = true, AFTER_DRAIN = false; static constexpr int TSW = 0;
    const float* X; bf16_t* HB; PG8_LAS unsigned char* L; float* PART; int pm0;
    __device__ __forceinline__ void operator()(const f32x4 (&acc)[2][2][4][2], const Unit& u, int wr, int wc, int fr, int fq) const {
        constexpr float a = 1.189207115002721f, b = BHALF ? 0.5f : 1.0f;
        const int col0 = u.pn * BM + wc * 32 + 8 * fq;
        const size_t off0 = (size_t)(u.pm * BM + wr * 64 + fr) * 4096 + col0;
        u32x4 hw[2][4][2];
#define LOAD_HW(ai) do { _Pragma("unroll") for (int m = 0; m < 4; ++m) _Pragma("unroll") for (int bj = 0; bj < 2; ++bj) hw[ai][m][bj] = *(const u32x4*)(HB + off0 + (size_t)((ai) * HALF + m * 16) * 4096 + bj * HALF); } while (0)
        if (!XIN) { const float* gin = KARG_IN(GI); const float* bin = KARG_IN(GI + 1);
            LOAD_HW(0);
            const int t = (wr * 4 + wc) * 64 + fq * 16 + fr;
            if (t < 256) { *(PG8_LAS float*)(L + LDS_GTAB + t * 4) = gin[u.pn * BM + t] * a; *(PG8_LAS float*)(L + LDS_GTAB + 1024 + t * 4) = bin[u.pn * BM + t] * a; }
            asm volatile("s_waitcnt lgkmcnt(0)" ::: "memory"); __builtin_amdgcn_s_barrier(); asm volatile("" ::: "memory"); }
        else LOAD_HW(0);
        const int gofs = LDS_GTAB + (wc * 32 + 8 * fq) * 4;
#pragma unroll
        for (int ai = 0; ai < 2; ++ai) {
            if (ai == 0) { LOAD_HW(1); __builtin_amdgcn_sched_barrier(0); }
#pragma unroll
            for (int m = 0; m < 4; ++m) { const int rloc = ai * HALF + wr * 64 + m * 16 + fr; const size_t off = off0 + (size_t)(ai * HALF + m * 16) * 4096;
                float mu = 0.f, rs = 1.f; if (!XIN) ln_row_stats(L, rloc + (u.pm != pm0 ? 256 : 0), mu, rs);
                const float nmr = -mu * rs;
                f32x4 s1v = {0.f, 0.f, 0.f, 0.f}, s2v = {0.f, 0.f, 0.f, 0.f};
#pragma unroll
                for (int bj = 0; bj < 2; ++bj) { const int cc = bj * HALF; f32x4 o0, o1; const u32x4 w = hw[ai][m][bj];
                    const f32x4 r0 = (f32x4){bf_lo(w.x), bf_hi(w.x), bf_lo(w.y), bf_hi(w.y)}, r1 = (f32x4){bf_lo(w.z), bf_hi(w.z), bf_lo(w.w), bf_hi(w.w)};
                    if (XIN) { o0 = r0 * a + acc[ai][bj][m][0] * b; o1 = r1 * a + acc[ai][bj][m][1] * b; }
                    else {
                        const volatile PG8_LAS f32x4* gp = (const volatile PG8_LAS f32x4*)(L + gofs + cc * 4);
                        const f32x4 ga0 = gp[0], ga1 = gp[1], ba0 = gp[64], ba1 = gp[65];
                        o0 = (r0 * rs + nmr) * ga0 + (acc[ai][bj][m][0] * b + ba0); o1 = (r1 * rs + nmr) * ga1 + (acc[ai][bj][m][1] * b + ba1); }
                    *(u32x4*)(HB + off + cc) = pack8(o0, o1);
                    s1v += o0 + o1; s2v += o0 * o0 + o1 * o1; }
                float s1 = hsum4(s1v), s2 = hsum4(s2v);
                XL_RED_16_32(xl_add, s1); XL_RED_16_32(xl_add, s2);
                if (fq == 0) *(PG8_LAS f32x2s*)(L + LDS_PTAB + (rloc * 4 + wc) * 8) = (f32x2s){s1, s2};
                if (m == 3) __builtin_amdgcn_sched_barrier(0); } }
#undef LOAD_HW
        asm volatile("s_waitcnt lgkmcnt(0)" ::: "memory"); __builtin_amdgcn_s_barrier(); asm volatile("" ::: "memory");
        const int tid = (wr * 4 + wc) * 64 + fq * 16 + fr;
        if (tid < 256) { const f32x4 p0 = *(const PG8_LAS f32x4*)(L + LDS_PTAB + tid * 32), p1 = *(const PG8_LAS f32x4*)(L + LDS_PTAB + tid * 32 + 16);
            *(f32x2s*)(PART + ((size_t)(u.pm * BM + tid) * 16 + u.pn) * 2) = (f32x2s){(p0[0] + p0[2]) + (p1[0] + p1[2]), (p0[1] + p0[3]) + (p1[1] + p1[3])}; }
    }
};
struct EpiInProj {
    static constexpr bool PERM = true, AFTER_DRAIN = false; static constexpr int TSW = 0;
    bf16_t* QKV; bf16_t* G; float qscale; float* NRM;
    PG8_LAS unsigned char* L; const float* CS; const float* DS;
    __device__ __forceinline__ void operator()(const f32x4 (&acc)[2][2][4][2], const Unit& u, int wr, int wc, int fr, int fq) const {
        const int row0 = u.pm * BM + wr * 64 + fr; const bool gate = u.pn >= 60; const int bcol = u.pn * BM + wc * 32 + 8 * fq;
        f32x4 cv[2][2], dv[2][2];
#pragma unroll
        for (int bj = 0; bj < 2; ++bj)
#pragma unroll
            for (int n = 0; n < 2; ++n) { cv[bj][n] = *(const f32x4*)(CS + bcol + bj * HALF + 4 * n); dv[bj][n] = *(const f32x4*)(DS + bcol + bj * HALF + 4 * n); }
        bf16_t* base = gate ? G : QKV; const int ldc = gate ? 8192 : 15360, colt = gate ? (u.pn - 60) * BM : u.pn * BM;
        const float sc = (u.pn < 8 || (u.pn >= 24 && u.pn < 36)) ? qscale : 1.0f;
        const int col0 = colt + wc * 32 + 8 * fq;
#pragma unroll
        for (int ai = 0; ai < 2; ++ai)
#pragma unroll
            for (int m = 0; m < 4; ++m) { bf16_t* rowp = base + (size_t)(row0 + ai * HALF + m * 16) * ldc + col0;
                float mu, rs; ln_row_stats(L, ai * HALF + wr * 64 + m * 16 + fr, mu, rs);
#pragma unroll
                for (int bj = 0; bj < 2; ++bj) { f32x4 v0 = (acc[ai][bj][m][0] - cv[bj][0] * mu) * rs + dv[bj][0], v1 = (acc[ai][bj][m][1] - cv[bj][1] * mu) * rs + dv[bj][1];
                    if (gate) { v0 = sigmoid4(v0); v1 = sigmoid4(v1); } else { v0 = v0 * sc; v1 = v1 * sc; }
                    *(u32x4*)(rowp + bj * HALF) = pack8(v0, v1);
                    if (u.pn < 16) { float s = (v0[0] * v0[0] + v0[1] * v0[1]) + (v0[2] * v0[2] + v0[3] * v0[3]) + (v1[0] * v1[0] + v1[1] * v1[1]) + (v1[2] * v1[2] + v1[3] * v1[3]);
                        XL_RED_16_32(xl_add, s);
                        if (fq == 0) NRM[(size_t)(row0 + ai * HALF + m * 16) * 128 + u.pn * 8 + bj * 4 + wc] = s; } } }
    }
};
struct EpiBf16Plain {
    static constexpr bool PERM = true, AFTER_DRAIN = false; static constexpr int TSW = 0;
    bf16_t* O; int ldc;
    __device__ __forceinline__ void operator()(const f32x4 (&acc)[2][2][4][2], const Unit& u, int wr, int wc, int fr, int fq) const {
        const int row0 = u.pm * BM + wr * 64 + fr, col0 = u.pn * BM + wc * 32 + 8 * fq;
#pragma unroll
        for (int ai = 0; ai < 2; ++ai)
#pragma unroll
            for (int m = 0; m < 4; ++m) { bf16_t* rowp = O + (size_t)(row0 + ai * HALF + m * 16) * ldc + col0;
#pragma unroll
                for (int bj = 0; bj < 2; ++bj) *(u32x4*)(rowp + bj * HALF) = pack8(acc[ai][bj][m][0], acc[ai][bj][m][1]); }
    }
};
struct EpiGateAB {
    static constexpr bool PERM = true, AFTER_DRAIN = false; static constexpr int TSW = 2048 / BK;
    const bf16_t* G; bf16_t* Y;
    __device__ __forceinline__ void mid(f32x4 (&acc)[2][2][4][2], const Unit& u, int wr, int wc, int fr, int fq) const {
        int row0 = u.pm * BM + wr * 64 + fr, col0 = u.pn * BM + wc * 32 + 8 * fq; asm volatile("" : "+v"(row0), "+v"(col0));
#pragma unroll
        for (int ai = 0; ai < 2; ++ai) {
            u32x4 aw[4][2], bw[4][2];
#pragma unroll
            for (int m = 0; m < 4; ++m)
#pragma unroll
                for (int bj = 0; bj < 2; ++bj) { const bf16_t* gp = G + (size_t)(row0 + ai * HALF + m * 16) * 8192 + col0 + bj * HALF; aw[m][bj] = *(const u32x4*)gp; bw[m][bj] = *(const u32x4*)(gp + 4096); }
#pragma unroll
            for (int m = 0; m < 4; ++m)
#pragma unroll
                for (int bj = 0; bj < 2; ++bj) { const u32x4 av = aw[m][bj], bv = bw[m][bj];
                    const f32x4 a0 = (f32x4){bf_lo(av.x), bf_hi(av.x), bf_lo(av.y), bf_hi(av.y)}, a1 = (f32x4){bf_lo(av.z), bf_hi(av.z), bf_lo(av.w), bf_hi(av.w)};
                    const f32x4 b0 = (f32x4){bf_lo(bv.x), bf_hi(bv.x), bf_lo(bv.y), bf_hi(bv.y)}, b1 = (f32x4){bf_lo(bv.z), bf_hi(bv.z), bf_lo(bv.w), bf_hi(bv.w)};
#pragma unroll
                    for (int i = 0; i < 4; ++i) { acc[ai][bj][m][0][i] *= a0[i] * __builtin_amdgcn_rcpf(fmaxf(b0[i], 1e-30f)); acc[ai][bj][m][1][i] *= a1[i] * __builtin_amdgcn_rcpf(fmaxf(b1[i], 1e-30f)); } }
            __builtin_amdgcn_sched_barrier(0); }
    }
    __device__ __forceinline__ void operator()(const f32x4 (&acc)[2][2][4][2], const Unit& u, int wr, int wc, int fr, int fq) const {
        const int row0 = u.pm * BM + wr * 64 + fr, col0 = u.pn * BM + wc * 32 + 8 * fq;
#pragma unroll
        for (int ai = 0; ai < 2; ++ai)
#pragma unroll
            for (int m = 0; m < 4; ++m) { const size_t row = (size_t)(row0 + ai * HALF + m * 16);
#pragma unroll
                for (int bj = 0; bj < 2; ++bj) { const int c = col0 + bj * HALF; const u32x4 bw = *(const u32x4*)(G + row * 8192 + 4096 + c);
                    const f32x4 b0 = (f32x4){bf_lo(bw.x), bf_hi(bw.x), bf_lo(bw.y), bf_hi(bw.y)}, b1 = (f32x4){bf_lo(bw.z), bf_hi(bw.z), bf_lo(bw.w), bf_hi(bw.w)};
                    *(u32x4*)(Y + row * 4096 + c) = pack8(fmaxf4(b0) * acc[ai][bj][m][0], fmaxf4(b1) * acc[ai][bj][m][1]); }
                if (m == 3) __builtin_amdgcn_sched_barrier(0); }
    }
};
struct EpiPle {
    static constexpr bool PERM = true, AFTER_DRAIN = false; static constexpr int TSW = 0;
    const bf16_t* HB; bf16_t* out; const bf16_t* PP; PG8_LAS unsigned char* L; const float* CS; const float* DS;
    __device__ __forceinline__ void operator()(const f32x4 (&acc)[2][2][4][2], const Unit& u, int wr, int wc, int fr, int fq) const {
        constexpr float a = 1.189207115002721f; const float* gin = KARG_IN(19); const float* bin = KARG_IN(20);
        const int col0 = u.pn * BM + wc * 32 + 8 * fq;
        { const int t = (wr * 4 + wc) * 64 + fq * 16 + fr;
          if (t < 256) { const int c = u.pn * BM + t; PG8_LAS float* T = (PG8_LAS float*)(L + LDS_PTAB) + t; T[0] = gin[c] * a; T[256] = bin[c] * a; T[512] = CS[c]; T[768] = DS[c]; }
          asm volatile("s_waitcnt lgkmcnt(0)" ::: "memory"); __builtin_amdgcn_s_barrier(); asm volatile("" ::: "memory"); }
        const int gofs = LDS_PTAB + (wc * 32 + 8 * fq) * 4;
#pragma unroll
        for (int ai = 0; ai < 2; ++ai)
#pragma unroll
            for (int m = 0; m < 4; ++m) { const int rloc = ai * HALF + wr * 64 + m * 16 + fr; const size_t off = (size_t)(u.pm * BM + rloc) * 4096 + col0;
                float mu, rs; ln_row_stats(L, rloc, mu, rs); const float nmr = -mu * rs;
#pragma unroll
                for (int bj = 0; bj < 2; ++bj) { const size_t o = off + bj * HALF;
                    const u32x4 hw = *(const u32x4*)(HB + o), pw = *(const u32x4*)(PP + o);
                    const volatile PG8_LAS f32x4* gp = (const volatile PG8_LAS f32x4*)(L + gofs + bj * HALF * 4);
                    f32x4 y[2];
#pragma unroll
                    for (int n = 0; n < 2; ++n) { const unsigned h0 = n ? hw.z : hw.x, h1 = n ? hw.w : hw.y, q0 = n ? pw.z : pw.x, q1 = n ? pw.w : pw.y;
                        const f32x4 gv = gp[n], bv = gp[64 + n], cv = gp[128 + n], dv = gp[192 + n];
                        const f32x4 z = acc[ai][bj][m][n] * rs + (cv * nmr + dv);
                        y[n] = ((f32x4){bf_lo(h0), bf_hi(h0), bf_lo(h1), bf_hi(h1)} * rs + nmr) * gv + (bv + sigmoid4(z) * (f32x4){bf_lo(q0), bf_hi(q0), bf_lo(q1), bf_hi(q1)}); }
                    *(u32x4*)(out + o) = pack8(y[0], y[1]); }
                if (m == 3) __builtin_amdgcn_sched_barrier(0); }
    }
};

template <class Epi, class Sched, bool ALIGN_EPI = false, bool SP2 = false>
__device__ __forceinline__ void gemm_phase(PG8_LAS unsigned char* lds, const Gemm g, const Sched& S, const Epi& E, int wave_id) {
    const int tid_ = wave_id * 64 + lane_id_fresh();
    const int tid = tid_, wid = __builtin_amdgcn_readfirstlane(tid >> 6), lane = tid & 63, wr = wid >> 2, wc = wid & 3, fr = lane & 15, fq = lane >> 4;
    const int K = g.K, nt = K / BK, ld = g.ld;
    unsigned voffA[2], voffB[2];
#pragma unroll
    for (int i = 0; i < 2; ++i) { int R, C; stage_rc(tid * 16 + i * 8192, R, C); const int Rb = Epi::PERM ? ((R & ~31) + perm32(R & 31)) : R;
        voffA[i] = (unsigned)(R * ld + C) * 2u; voffB[i] = (unsigned)(Rb * ld + C) * 2u; }
    const size_t kstep = (size_t)(BK * 2);
    const size_t hstep = (size_t)HALF * ld * 2;
    const size_t tstep = 2 * hstep;
    const unsigned ldsw = (unsigned)wid * 1024u;
    const int aoff = lds_byte(wr * 64 + fr, fq * 8), boff = lds_byte(wc * 32 + fr, fq * 8);
#define PG8_SA(b, h) (((b) * 2 + (h)) * HTB)
#define PG8_SB(b, h) ((4 + (b) * 2 + (h)) * HTB)
#define PG8_STAGE(bufoff, gbase, voff) do { _Pragma("unroll") for (int _i = 0; _i < 2; ++_i) \
        __builtin_amdgcn_global_load_lds((const unsigned*)((const char*)(gbase) + (voff)[_i]), (PG8_LAS unsigned*)(lds + (bufoff) + ldsw + _i * 8192), 16, 0, 0); } while (0)
#define PG8_LDA(dst, b, h) do { _Pragma("unroll") for (int m = 0; m < 4; ++m) _Pragma("unroll") for (int k = 0; k < 2; ++k) dst[m][k] = *(const PG8_LAS bf16x8*)(lds + PG8_SA(b, h) + aoff + m * 2048 + k * 1024); } while (0)
#define PG8_LDB(dst, b, h) do { _Pragma("unroll") for (int n = 0; n < 2; ++n) _Pragma("unroll") for (int k = 0; k < 2; ++k) dst[n][k] = *(const PG8_LAS bf16x8*)(lds + PG8_SB(b, h) + boff + n * 2048 + k * 1024); } while (0)
#define PG8_MMA(ai, bj, At, Bt) do { __builtin_amdgcn_s_setprio(1); _Pragma("unroll") for (int m = 0; m < 4; ++m) _Pragma("unroll") for (int n = 0; n < 2; ++n) _Pragma("unroll") for (int k = 0; k < 2; ++k) \
        acc[ai][bj][m][n] = __builtin_amdgcn_mfma_f32_16x16x32_bf16(Bt[n][k], At[m][k], acc[ai][bj][m][n], 0, 0, 0); __builtin_amdgcn_s_setprio(0); } while (0)
#define PG8_WAIT_V(n) asm volatile("s_waitcnt vmcnt(" #n ")" ::: "memory")
#define PG8_WAIT_L(n) asm volatile("s_waitcnt lgkmcnt(" #n ")" ::: "memory")
#define PG8_BAR __builtin_amdgcn_s_barrier()
#define PG8_SCHED __builtin_amdgcn_sched_barrier(0)
    Unit cur, nxt; int ui = 0;
    if (!S.next(0, cur)) return;
    f32x4 acc[2][2][4][2];
#pragma unroll
    for (int a = 0; a < 2; ++a)
#pragma unroll
        for (int b = 0; b < 2; ++b)
#pragma unroll
            for (int m = 0; m < 4; ++m)
#pragma unroll
                for (int n = 0; n < 2; ++n) acc[a][b][m][n] = (f32x4){0.f, 0.f, 0.f, 0.f};
    bf16x8 At[4][2], B0[2][2], B1[2][2];
    const char* cA = (const char*)g.A + (size_t)cur.pm * tstep; const char* cB = (const char*)g.Bt + (size_t)cur.pn * tstep;
    S.a_ready(cur);
    if constexpr (SP2) {
        PG8_STAGE(PG8_SB(0, 0), cB, voffB); PG8_STAGE(PG8_SB(0, 1), cB + hstep, voffB); PG8_STAGE(PG8_SA(0, 0), cA, voffA); PG8_STAGE(PG8_SA(0, 1), cA + hstep, voffA);
        if (wr == 1) PG8_BAR;
        PG8_WAIT_V(2); PG8_BAR;
        PG8_STAGE(PG8_SB(1, 0), cB + kstep, voffB); PG8_STAGE(PG8_SA(1, 0), cA + kstep, voffA); PG8_STAGE(PG8_SB(1, 1), cB + hstep + kstep, voffB);
        PG8_WAIT_V(6); PG8_BAR;
    } else {
        PG8_STAGE(PG8_SB(0, 0), cB, voffB); PG8_STAGE(PG8_SA(0, 0), cA, voffA); PG8_STAGE(PG8_SB(0, 1), cB + hstep, voffB); PG8_STAGE(PG8_SA(0, 1), cA + hstep, voffA);
        if (wr == 1) PG8_BAR;
        PG8_WAIT_V(4); PG8_BAR;
        PG8_STAGE(PG8_SB(1, 0), cB + kstep, voffB); PG8_STAGE(PG8_SA(1, 0), cA + kstep, voffA); PG8_STAGE(PG8_SB(1, 1), cB + hstep + kstep, voffB);
        PG8_WAIT_V(6); PG8_BAR;
    }
    for (;;) {
        const bool has_next = S.next(ui + 1, nxt);
        const char* nA = has_next ? (const char*)g.A + (size_t)nxt.pm * tstep : cA; const char* nB = has_next ? (const char*)g.Bt + (size_t)nxt.pn * tstep : cB;
        for (int t = 0; t < nt; t += 2) {
            if constexpr (Epi::TSW > 0) { if (t == Epi::TSW) E.mid(acc, cur, wr, wc, fr, fq); }
            const bool last = (t == nt - 2);
            const char* a1 = cA + (size_t)(t + 1) * kstep;
            const char* a2 = last ? nA : cA + (size_t)(t + 2) * kstep; const char* b2 = last ? nB : cB + (size_t)(t + 2) * kstep;
            const char* a3 = a2 + kstep; const char* b3 = b2 + kstep;
            if (last && has_next) S.a_ready(nxt);
            if constexpr (SP2) {
            PG8_LDB(B0, 0, 0); PG8_LDB(B1, 0, 1); PG8_SCHED; PG8_LDA(At, 0, 0); PG8_STAGE(PG8_SA(1, 1), a1 + hstep, voffA);
            PG8_WAIT_V(8); PG8_WAIT_L(0); PG8_BAR; PG8_MMA(0, 0, At, B0); PG8_MMA(0, 1, At, B1); PG8_BAR; PG8_SCHED;
            PG8_LDA(At, 0, 1); PG8_STAGE(PG8_SB(0, 0), b2, voffB); PG8_STAGE(PG8_SB(0, 1), b2 + hstep, voffB); PG8_STAGE(PG8_SA(0, 0), a2, voffA);
            PG8_WAIT_V(8); PG8_WAIT_L(0); PG8_BAR; PG8_MMA(1, 0, At, B0); PG8_MMA(1, 1, At, B1); PG8_BAR; PG8_SCHED;
            PG8_LDB(B0, 1, 0); PG8_LDB(B1, 1, 1); PG8_SCHED; PG8_LDA(At, 1, 0); PG8_STAGE(PG8_SA(0, 1), a2 + hstep, voffA);
            PG8_WAIT_V(8); PG8_WAIT_L(0); PG8_BAR; PG8_MMA(0, 0, At, B0); PG8_MMA(0, 1, At, B1); PG8_BAR; PG8_SCHED;
            PG8_LDA(At, 1, 1); PG8_STAGE(PG8_SB(1, 0), b3, voffB); PG8_STAGE(PG8_SB(1, 1), b3 + hstep, voffB); PG8_STAGE(PG8_SA(1, 0), a3, voffA);
            PG8_WAIT_V(8); PG8_WAIT_L(0); PG8_BAR; PG8_MMA(1, 0, At, B0); PG8_MMA(1, 1, At, B1); PG8_BAR; PG8_SCHED;
            } else {
            PG8_LDB(B0, 0, 0); PG8_SCHED; PG8_LDA(At, 0, 0); PG8_STAGE(PG8_SA(1, 1), a1 + hstep, voffA);
            PG8_WAIT_L(8); PG8_BAR; PG8_WAIT_L(0); PG8_MMA(0, 0, At, B0); PG8_BAR; PG8_SCHED;
            PG8_LDB(B1, 0, 1); PG8_STAGE(PG8_SB(0, 0), b2, voffB);
            PG8_BAR; PG8_WAIT_L(0); PG8_MMA(0, 1, At, B1); PG8_BAR;
            PG8_LDA(At, 0, 1); PG8_STAGE(PG8_SA(0, 0), a2, voffA);
            PG8_BAR; PG8_WAIT_L(0); PG8_MMA(1, 0, At, B0); PG8_BAR; PG8_SCHED;
            PG8_STAGE(PG8_SB(0, 1), b2 + hstep, voffB);
            PG8_WAIT_V(6); PG8_BAR; PG8_MMA(1, 1, At, B1); PG8_BAR;
            PG8_LDB(B0, 1, 0); PG8_SCHED; PG8_LDA(At, 1, 0); PG8_STAGE(PG8_SA(0, 1), a2 + hstep, voffA);
            PG8_WAIT_L(8); PG8_BAR; PG8_WAIT_L(0); PG8_MMA(0, 0, At, B0); PG8_BAR; PG8_SCHED;
            PG8_LDB(B1, 1, 1); PG8_STAGE(PG8_SB(1, 0), b3, voffB);
            PG8_BAR; PG8_WAIT_L(0); PG8_MMA(0, 1, At, B1); PG8_BAR;
            PG8_LDA(At, 1, 1); PG8_STAGE(PG8_SA(1, 0), a3, voffA);
            PG8_BAR; PG8_WAIT_L(0); PG8_MMA(1, 0, At, B0); PG8_BAR; PG8_SCHED;
            PG8_STAGE(PG8_SB(1, 1), b3 + hstep, voffB);
            PG8_WAIT_V(6); PG8_BAR; PG8_MMA(1, 1, At, B1); PG8_BAR;
            }
        }
        if constexpr (ALIGN_EPI) { if (wr == 0) PG8_BAR; }
        if constexpr (!Epi::AFTER_DRAIN) { E(acc, cur, wr, wc, fr, fq); S.done(cur); }
        if (!has_next) break;
#pragma unroll
        for (int a = 0; a < 2; ++a)
#pragma unroll
            for (int b = 0; b < 2; ++b)
#pragma unroll
                for (int m = 0; m < 4; ++m)
#pragma unroll
                    for (int n = 0; n < 2; ++n) acc[a][b][m][n] = (f32x4){0.f, 0.f, 0.f, 0.f};
        cur = nxt; cA = nA; cB = nB; ++ui;
        if constexpr (ALIGN_EPI) { if (wr == 1) PG8_BAR; }
    }
    PG8_WAIT_V(0);
    if constexpr (!ALIGN_EPI) { if (wr == 0) PG8_BAR; }
    PG8_BAR;
    if constexpr (Epi::AFTER_DRAIN) { E.fused(acc, cur, wr, wc, fr, fq, lds, wid, lane); S.done(cur); }
#undef PG8_SA
#undef PG8_SB
#undef PG8_STAGE
#undef PG8_LDA
#undef PG8_LDB
#undef PG8_MMA
#undef PG8_WAIT_V
#undef PG8_WAIT_L
#undef PG8_BAR
#undef PG8_SCHED
}
}
namespace att {
using bf16 = __hip_bfloat16;
using bf16x8 = __attribute__((ext_vector_type(8))) short;
using s16x4  = __attribute__((ext_vector_type(4))) short;
using f32x16 = __attribute__((ext_vector_type(16))) float;
using u32x4  = __attribute__((ext_vector_type(4))) unsigned;
constexpr int NW = 8, QBLK = 32, KVBLK = 64;
constexpr size_t SHM_V = KVBLK * 128 * 2, SHM_K = KVBLK * 128 * 2, SHM_ATTN = 2 * SHM_V + 2 * SHM_K + NW * 64 * 4;
constexpr float THR2 = 11.5f;
#define KSWZ(row, colB) ((row) * 256 + ((colB) ^ (((row) & 7) << 4)))
#define SBAR() __builtin_amdgcn_sched_barrier(0)
__device__ __forceinline__ int crow(int r, int hi) { return (r & 3) + 8 * (r >> 2) + 4 * hi; }
__device__ __forceinline__ unsigned cvtpk(float lo, float hi) { unsigned r; asm volatile("v_cvt_pk_bf16_f32 %0, %1, %2" : "=v"(r) : "v"(lo), "v"(hi)); return r; }

template <int MODE>
__device__ __forceinline__ void partialSM(f32x16& p0, f32x16& p1, float& m_reg, float& mn, float& alpha, float di, float sl2) {
#pragma unroll
  for (int r = 0; r < 16; ++r) { const float a0 = fabsf(di - (float)((r & 3) + 8 * (r >> 2))), a1 = fabsf(di - (float)(32 + (r & 3) + 8 * (r >> 2)));
    if (MODE == 0) { p0[r] = fmaf(-sl2, a0, p0[r]); p1[r] = fmaf(-sl2, a1, p1[r]); }
    else { p0[r] = a0 <= 64.f ? fmaf(-sl2, a0, p0[r]) : -1e30f; p1[r] = a1 <= 64.f ? fmaf(-sl2, a1, p1[r]) : -1e30f; } }
  float pmax = p0[0];
#pragma unroll
  for (int r = 1; r < 16; ++r) pmax = fmaxf(pmax, p0[r]);
#pragma unroll
  for (int r = 0; r < 16; ++r) pmax = fmaxf(pmax, p1[r]);
  { auto rr = __builtin_amdgcn_permlane32_swap(__float_as_uint(pmax), __float_as_uint(pmax), false, false);
    pmax = fmaxf(__uint_as_float(rr[0]), __uint_as_float(rr[1])); }
  if (__builtin_expect(__all(pmax - m_reg <= THR2), 1)) { mn = m_reg; alpha = 1.f; }
  else { mn = fmaxf(m_reg, pmax); alpha = __builtin_amdgcn_exp2f(m_reg - mn); m_reg = mn; }
#pragma unroll
  for (int r = 0; r < 16; ++r) p0[r] = p0[r] - mn;
#pragma unroll
  for (int r = 0; r < 16; ++r) p1[r] = p1[r] - mn;
#pragma unroll
  for (int r = 0; r < 16; ++r) p0[r] = __builtin_amdgcn_exp2f(p0[r]);
}
__device__ __forceinline__ void finishSM(f32x16& p0, f32x16& p1, float alpha, float& l_reg, bf16x8& pa0, bf16x8& pa1, bf16x8& pa2, bf16x8& pa3) {
#pragma unroll
  for (int r = 0; r < 16; ++r) p1[r] = __builtin_amdgcn_exp2f(p1[r]);
  float ps = 0;
#pragma unroll
  for (int r = 0; r < 16; ++r) ps += p0[r];
#pragma unroll
  for (int r = 0; r < 16; ++r) ps += p1[r];
  { auto rr = __builtin_amdgcn_permlane32_swap(__float_as_uint(ps), __float_as_uint(ps), false, false);
    ps = __uint_as_float(rr[0]) + __uint_as_float(rr[1]); }
  l_reg = l_reg * alpha + ps;
#define PK4(P, BASE, OUT) do { unsigned a0 = cvtpk(P[BASE + 0], P[BASE + 1]), a1 = cvtpk(P[BASE + 2], P[BASE + 3]);   \
    unsigned b0 = cvtpk(P[BASE + 4], P[BASE + 5]), b1 = cvtpk(P[BASE + 6], P[BASE + 7]);                              \
    auto r0 = __builtin_amdgcn_permlane32_swap(a0, b0, false, false); auto r1 = __builtin_amdgcn_permlane32_swap(a1, b1, false, false); \
    u32x4 w = {r0[0], r1[0], r0[1], r1[1]}; OUT = *reinterpret_cast<bf16x8*>(&w); } while (0)
  PK4(p0, 0, pa0); PK4(p0, 8, pa1); PK4(p1, 0, pa2); PK4(p1, 8, pa3);
#undef PK4
}
__device__ __forceinline__ void qkt(f32x16& p0, f32x16& p1, const bf16* Ks, const bf16x8* qr, int r32, int hi) {
  p0 = f32x16{}; p1 = f32x16{};
#pragma unroll
  for (int d0 = 0; d0 < 8; ++d0) { int cb = (d0 * 16 + hi * 8) * 2;
    bf16x8 b0 = *reinterpret_cast<const bf16x8*>((const char*)Ks + KSWZ(r32, cb));
    bf16x8 b1 = *reinterpret_cast<const bf16x8*>((const char*)Ks + KSWZ(32 + r32, cb));
    p0 = __builtin_amdgcn_mfma_f32_32x32x16_bf16(b0, qr[d0], p0, 0, 0, 0);
    p1 = __builtin_amdgcn_mfma_f32_32x32x16_bf16(b1, qr[d0], p1, 0, 0, 0); }
}
__device__ __forceinline__ int v_st(int k, int c) { const int kk = (k & ~0xC) | ((k & 4) << 1) | ((k & 8) >> 1); return ((kk >> 3) * 4 + (c >> 5)) * 512 + ((kk & 7) * 32 + (c & 31)) * 2; }
__device__ __forceinline__ int v_rd_base(int lane) { return ((lane & 3) << 3) | (((lane >> 2) & 3) << 6) | (((lane >> 4) & 1) << 5) | (((lane >> 5) & 1) << 8); }
constexpr int v_rd_off(int d0, int ks, int half) { return d0 * 512 + ks * 4096 + half * 2048; }
template <int OFF> __device__ __forceinline__ s16x4 tr_read(int vb) {
  s16x4 r; asm volatile("ds_read_b64_tr_b16 %0, %1 offset:%2" : "=&v"(r) : "v"(vb), "i"(OFF) : "memory"); return r;
}
template <int D0> __device__ __forceinline__ void pv_one(f32x16& od, int vb, bf16x8 pa0, bf16x8 pa1, bf16x8 pa2, bf16x8 pa3) {
  const s16x4 l0 = tr_read<v_rd_off(D0, 0, 0)>(vb), h0 = tr_read<v_rd_off(D0, 0, 1)>(vb), l1 = tr_read<v_rd_off(D0, 1, 0)>(vb), h1 = tr_read<v_rd_off(D0, 1, 1)>(vb);
  const s16x4 l2 = tr_read<v_rd_off(D0, 2, 0)>(vb), h2 = tr_read<v_rd_off(D0, 2, 1)>(vb), l3 = tr_read<v_rd_off(D0, 3, 0)>(vb), h3 = tr_read<v_rd_off(D0, 3, 1)>(vb);
  asm volatile("s_waitcnt lgkmcnt(0)" ::: "memory"); SBAR();
#define PK(L, H) (bf16x8){L[0], L[1], L[2], L[3], H[0], H[1], H[2], H[3]}
  od = __builtin_amdgcn_mfma_f32_32x32x16_bf16(pa0, PK(l0, h0), od, 0, 0, 0);
  od = __builtin_amdgcn_mfma_f32_32x32x16_bf16(pa1, PK(l1, h1), od, 0, 0, 0);
  od = __builtin_amdgcn_mfma_f32_32x32x16_bf16(pa2, PK(l2, h2), od, 0, 0, 0);
  od = __builtin_amdgcn_mfma_f32_32x32x16_bf16(pa3, PK(l3, h3), od, 0, 0, 0);
#undef PK
}
__device__ __forceinline__ void pv_d0(f32x16* o, int vb, bf16x8 pa0, bf16x8 pa1, bf16x8 pa2, bf16x8 pa3) {
  pv_one<0>(o[0], vb, pa0, pa1, pa2, pa3); pv_one<1>(o[1], vb, pa0, pa1, pa2, pa3); pv_one<2>(o[2], vb, pa0, pa1, pa2, pa3); pv_one<3>(o[3], vb, pa0, pa1, pa2, pa3);
}

template <int MODE>
__device__ __forceinline__ void attn_core(const bf16* __restrict__ Qb, long ldq, const bf16* __restrict__ Kh, const bf16* __restrict__ Vh, long ldk, int NT, int t0, int tmax,
                                          float dq, float sl2, int wave_id, char* lds, f32x16 (&o)[4], float& m_reg, float& l_reg) {
  const int tid_ = wave_id * 64 + lane_id_fresh(); asm volatile("" : "+v"(dq));
  const int tid = tid_, wid = tid >> 6, lane = tid & 63, r32 = lane & 31, hi = lane >> 5;
  bf16* V_lds = (bf16*)lds; bf16* K_lds = (bf16*)(lds + 2 * SHM_V);
  float* ws = (float*)(lds + 2 * SHM_V + 2 * SHM_K) + wid * 64; float* al_l = ws + 32;
  m_reg = -1e30f; l_reg = 0.f;
#pragma unroll
  for (int d = 0; d < 4; ++d) o[d] = f32x16{};
  bf16x8 qr[8];
  const bf16* Qw = Qb + (long)(wid * QBLK + r32) * ldq + hi * 8;
#pragma unroll
  for (int d0 = 0; d0 < 8; ++d0) qr[d0] = *reinterpret_cast<const bf16x8*>(Qw + d0 * 16);
  const int sr = tid >> 4, sc = (tid & 15) * 8, vst0 = v_st(sr, sc), vst1 = v_st(32 + sr, sc);
  const unsigned loff = (unsigned)sr * (unsigned)ldk * 2u + (unsigned)sc * 2u;
  const int vb0 = (int)(uintptr_t)V_lds + v_rd_base(lane);
  struct { bf16x8 vs0, vs1, ks0, ks1; } sr_[2];
#define TILEK0(jt) ((MODE == 1) ? 64 * min(max(t0 + (jt), 0), tmax - 1) : 64 * (t0 + (jt)))
#define TILEDI(jt) ((MODE == 1 && ((t0 + (jt)) < 0 || (t0 + (jt)) >= tmax)) ? 1e9f : (dq - 64.f * (float)(jt)))
#define SLOAD(i, jt) do { const size_t t_ = (size_t)(TILEK0(jt)) * (size_t)ldk * 2; const char* vt_ = (const char*)Vh + t_; const char* kt_ = (const char*)Kh + t_;     \
    sr_[i].vs0 = *reinterpret_cast<const bf16x8*>(vt_ + loff); sr_[i].vs1 = *reinterpret_cast<const bf16x8*>(vt_ + (size_t)ldk * 64 + loff); \
    sr_[i].ks0 = *reinterpret_cast<const bf16x8*>(kt_ + loff); sr_[i].ks1 = *reinterpret_cast<const bf16x8*>(kt_ + (size_t)ldk * 64 + loff); } while (0)
#define SWRITE(b, i) do { *(bf16x8*)((char*)V_lds + (b) * SHM_V + vst0) = sr_[i].vs0;          \
    *(bf16x8*)((char*)V_lds + (b) * SHM_V + vst1) = sr_[i].vs1; int kc = sc * 2;               \
    *(bf16x8*)((char*)K_lds + (b) * SHM_K + KSWZ(sr, kc)) = sr_[i].ks0;                       \
    *(bf16x8*)((char*)K_lds + (b) * SHM_K + KSWZ(32 + sr, kc)) = sr_[i].ks1; } while (0)
#define SWAIT() asm volatile("s_waitcnt vmcnt(4)" ::: "memory")
#define RESC(a) do { if (__any((a) < 1.f)) { if (hi == 0) al_l[r32] = (a); asm volatile("s_waitcnt lgkmcnt(0)" ::: "memory"); \
    _Pragma("unroll") for (int d = 0; d < 4; ++d) _Pragma("unroll") for (int r = 0; r < 16; ++r) o[d][r] *= al_l[crow(r, hi)]; } } while (0)
  f32x16 pA0, pA1, pB0, pB1; float mnA, mnB, alA = 1.f, alB = 1.f; bf16x8 pa0, pa1, pa2, pa3;
  constexpr int SE = 0, SO = 1;
  const int wv2 = wave_id >> 1;
#define NEED(jt) (MODE != 1 || ((jt) >= wv2 && (jt) <= wv2 + 2))
  SLOAD(SE, 0); asm volatile("s_waitcnt vmcnt(0)" ::: "memory"); SWRITE(0, SE); __syncthreads();
  if (NEED(0)) { qkt(pA0, pA1, K_lds, qr, r32, hi); partialSM<MODE>(pA0, pA1, m_reg, mnA, alA, TILEDI(0), sl2); }
  SLOAD(SO, 1); if (2 < NT) SLOAD(SE, 2);
  SWAIT(); SWRITE(1, SO); __syncthreads();
  for (int j = 1; j + 1 < NT; j += 2) {
    SBAR(); if (NEED(j)) qkt(pB0, pB1, (bf16*)((char*)K_lds + SHM_K), qr, r32, hi);
    if (NEED(j - 1)) finishSM(pA0, pA1, alA, l_reg, pa0, pa1, pa2, pa3); SBAR();
    SLOAD(SO, j + 2); SBAR();
    if (NEED(j - 1)) pv_d0(o, vb0, pa0, pa1, pa2, pa3); if (NEED(j)) partialSM<MODE>(pB0, pB1, m_reg, mnB, alB, TILEDI(j), sl2);
    __syncthreads(); SWAIT(); SWRITE(0, SE);
    if (NEED(j)) RESC(alB); __syncthreads();
    SBAR(); if (NEED(j + 1)) qkt(pA0, pA1, K_lds, qr, r32, hi);
    if (NEED(j)) finishSM(pB0, pB1, alB, l_reg, pa0, pa1, pa2, pa3); SBAR();
    if (j + 3 < NT) SLOAD(SE, j + 3); SBAR();
    if (NEED(j)) pv_d0(o, vb0 + (int)SHM_V, pa0, pa1, pa2, pa3); if (NEED(j + 1)) partialSM<MODE>(pA0, pA1, m_reg, mnA, alA, TILEDI(j + 1), sl2);
    __syncthreads(); SWAIT(); SWRITE(1, SO);
    if (NEED(j + 1)) RESC(alA); __syncthreads();
  }
  SBAR(); if (NEED(NT - 1)) qkt(pB0, pB1, (bf16*)((char*)K_lds + SHM_K), qr, r32, hi);
  if (NEED(NT - 2)) finishSM(pA0, pA1, alA, l_reg, pa0, pa1, pa2, pa3); SBAR();
  if (NEED(NT - 2)) pv_d0(o, vb0, pa0, pa1, pa2, pa3); if (NEED(NT - 1)) partialSM<MODE>(pB0, pB1, m_reg, mnB, alB, TILEDI(NT - 1), sl2);
  __syncthreads(); if (NEED(NT - 1)) RESC(alB);
  if (NEED(NT - 1)) { finishSM(pB0, pB1, alB, l_reg, pa0, pa1, pa2, pa3); SBAR();
  pv_d0(o, vb0 + (int)SHM_V, pa0, pa1, pa2, pa3); }
  asm volatile("s_waitcnt vmcnt(0)" ::: "memory");
#undef NEED
#undef TILEK0
#undef TILEDI
#undef SLOAD
#undef SWRITE
#undef SWAIT
#undef RESC
}

constexpr int K2_ROWB = 272, K2_BYTES = 64 * K2_ROWB  , V2_BYTES = 2 * 16384, BUF2_BYTES = K2_BYTES + V2_BYTES, WS2_OFF = 2 * BUF2_BYTES  ;
__device__ __forceinline__ void qkt2(f32x16& p0, f32x16& p1, const char* kb, const bf16x8* qr) {
  p0 = f32x16{}; p1 = f32x16{};
#pragma unroll
  for (int d0 = 0; d0 < 8; ++d0) {
    const bf16x8 b0 = *reinterpret_cast<const bf16x8*>(kb + d0 * 32), b1 = *reinterpret_cast<const bf16x8*>(kb + 32 * K2_ROWB + d0 * 32);
    p0 = __builtin_amdgcn_mfma_f32_32x32x16_bf16(b0, qr[d0], p0, 0, 0, 0);
    p1 = __builtin_amdgcn_mfma_f32_32x32x16_bf16(b1, qr[d0], p1, 0, 0, 0); }
}
__device__ __forceinline__ void attn_core_dv256(const bf16* __restrict__ Qb, const bf16* __restrict__ Kh, const bf16* __restrict__ Vh, unsigned ld, int NT, int t0,
                                                float dq, float sl2, int wave_id, int wlo, int whi, char* lds, f32x16 (&o)[8], float& m_reg, float& l_reg) {
  const int lane = lane_id_fresh(); asm volatile("" : "+v"(dq));
  const int r32 = lane & 31, hi = lane >> 5;
  float* al_l = (float*)(lds + WS2_OFF) + wave_id * 64 + 32;
  m_reg = -1e30f; l_reg = 0.f;
#pragma unroll
  for (int d = 0; d < 8; ++d) o[d] = f32x16{};
  bf16x8 qr[8];
  { const bf16* Qw = Qb + (size_t)(wave_id * QBLK + r32) * ld + hi * 8;
#pragma unroll
    for (int d0 = 0; d0 < 8; ++d0) qr[d0] = *reinterpret_cast<const bf16x8*>(Qw + d0 * 16); }
  unsigned kof[3];
#pragma unroll
  for (int i = 0; i < 3; ++i) { const int L = (wave_id + 8 * i) * 64 + lane, row = L / 17, slot = L - row * 17; kof[i] = (unsigned)row * ld * 2u + (unsigned)(slot > 15 ? 15 : slot) * 16u; }
  unsigned vof;
  { const int sub = 2 * wave_id + (lane >> 5), kk = (sub >> 2) * 8 + ((lane & 31) >> 2), k = (kk & ~0xC) | ((kk & 4) << 1) | ((kk & 8) >> 1), cc = (sub & 3) * 32 + (lane & 3) * 8;
    vof = (unsigned)k * ld * 2u + (unsigned)cc * 2u; }
  typedef __attribute__((address_space(3))) unsigned lds_u32;
#define DMA2(jt, b) do { const size_t tb_ = (size_t)(t0 + (jt)) * 64 * (size_t)ld * 2; const char* kt_ = (const char*)Kh + tb_; const char* vt_ = (const char*)Vh + tb_; \
    lds_u32* kl_ = (lds_u32*)(lds + (b) * BUF2_BYTES); lds_u32* vl_ = (lds_u32*)(lds + (b) * BUF2_BYTES + K2_BYTES); \
    __builtin_amdgcn_global_load_lds((const unsigned*)(kt_ + kof[0]), kl_ + wave_id * 256, 16, 0, 0); \
    __builtin_amdgcn_global_load_lds((const unsigned*)(kt_ + kof[1]), kl_ + (wave_id + 8) * 256, 16, 0, 0); \
    if (wave_id == 0) __builtin_amdgcn_global_load_lds((const unsigned*)(kt_ + kof[2]), kl_ + 16 * 256, 16, 0, 0); \
    __builtin_amdgcn_global_load_lds((const unsigned*)(vt_ + vof), vl_ + wave_id * 256, 16, 0, 0); \
    __builtin_amdgcn_global_load_lds((const unsigned*)(vt_ + (size_t)ld * 64 + vof), vl_ + (wave_id + 8) * 256, 16, 0, 0); \
    __builtin_amdgcn_global_load_lds((const unsigned*)(vt_ + 256 + vof), vl_ + 4096 + wave_id * 256, 16, 0, 0); \
    __builtin_amdgcn_global_load_lds((const unsigned*)(vt_ + (size_t)ld * 64 + 256 + vof), vl_ + 4096 + (wave_id + 8) * 256, 16, 0, 0); } while (0)
  const int kbase = r32 * K2_ROWB + hi * 16, vb0 = (int)(uintptr_t)lds + K2_BYTES + v_rd_base(lane);
  __syncthreads();
  DMA2(0, 0);
#define PASS_TILE(j) do { asm volatile("s_waitcnt vmcnt(0)" ::: "memory"); __syncthreads(); if ((j) + 1 < NT) DMA2((j) + 1, ((j) & 1) ^ 1); } while (0)
#pragma unroll 1
  for (int j = 0; j < wlo; ++j) PASS_TILE(j);
#pragma unroll 1
  for (int j = wlo; j <= whi; ++j) {
    const int b = j & 1;
    asm volatile("s_waitcnt vmcnt(0)" ::: "memory"); __syncthreads();
    if (j + 1 < NT) DMA2(j + 1, b ^ 1);
    f32x16 p0, p1; float mn, alpha; bf16x8 pa0, pa1, pa2, pa3;
    qkt2(p0, p1, lds + b * BUF2_BYTES + kbase, qr);
    partialSM<0>(p0, p1, m_reg, mn, alpha, dq - 64.f * (float)j, sl2);
    if (__any(alpha < 1.f)) { if (hi == 0) al_l[r32] = alpha; asm volatile("s_waitcnt lgkmcnt(0)" ::: "memory");
#pragma unroll
      for (int d = 0; d < 8; ++d)
#pragma unroll
        for (int r = 0; r < 16; ++r) o[d][r] *= al_l[crow(r, hi)]; }
    finishSM(p0, p1, alpha, l_reg, pa0, pa1, pa2, pa3); SBAR();
    const int vb = vb0 + b * BUF2_BYTES;
    pv_d0(o, vb, pa0, pa1, pa2, pa3);
    pv_d0(o + 4, vb + 16384, pa0, pa1, pa2, pa3);
  }
#pragma unroll 1
  for (int j = whi + 1; j < NT; ++j) PASS_TILE(j);
  asm volatile("s_waitcnt vmcnt(0)" ::: "memory");
#undef PASS_TILE
#undef DMA2
}
__device__ __forceinline__ void attn_core_band(const bf16* __restrict__ Qb, const bf16* __restrict__ Kh, const bf16* __restrict__ Vh, unsigned ld, int NT, int t0, int tmax,
                                                float dq, float sl2, int wave_id, int wlo, int whi, char* lds, f32x16 (&o)[4], float& m_reg, float& l_reg) {
  const int lane = lane_id_fresh(); asm volatile("" : "+v"(dq));
  const int r32 = lane & 31, hi = lane >> 5;
  float* al_l = (float*)(lds + WS2_OFF) + wave_id * 64 + 32;
  m_reg = -1e30f; l_reg = 0.f;
#pragma unroll
  for (int d = 0; d < 4; ++d) o[d] = f32x16{};
  bf16x8 qr[8];
  { const bf16* Qw = Qb + (size_t)(wave_id * QBLK + r32) * ld + hi * 8;
#pragma unroll
    for (int d0 = 0; d0 < 8; ++d0) qr[d0] = *reinterpret_cast<const bf16x8*>(Qw + d0 * 16); }
  unsigned kof[3];
#pragma unroll
  for (int i = 0; i < 3; ++i) { const int L = (wave_id + 8 * i) * 64 + lane, row = L / 17, slot = L - row * 17; kof[i] = (unsigned)row * ld * 2u + (unsigned)(slot > 15 ? 15 : slot) * 16u; }
  unsigned vof;
  { const int sub = 2 * wave_id + (lane >> 5), kk = (sub >> 2) * 8 + ((lane & 31) >> 2), k = (kk & ~0xC) | ((kk & 4) << 1) | ((kk & 8) >> 1), cc = (sub & 3) * 32 + (lane & 3) * 8;
    vof = (unsigned)k * ld * 2u + (unsigned)cc * 2u; }
  typedef __attribute__((address_space(3))) unsigned lds_u32;
#define DMA2(jt, b) do { const int tc_ = min(max(t0 + (jt), 0), tmax - 1); const size_t tb_ = (size_t)tc_ * 64 * (size_t)ld * 2; const char* kt_ = (const char*)Kh + tb_; const char* vt_ = (const char*)Vh + tb_; \
    lds_u32* kl_ = (lds_u32*)(lds + (b) * BUF2_BYTES); lds_u32* vl_ = (lds_u32*)(lds + (b) * BUF2_BYTES + K2_BYTES); \
    __builtin_amdgcn_global_load_lds((const unsigned*)(kt_ + kof[0]), kl_ + wave_id * 256, 16, 0, 0); \
    __builtin_amdgcn_global_load_lds((const unsigned*)(kt_ + kof[1]), kl_ + (wave_id + 8) * 256, 16, 0, 0); \
    if (wave_id == 0) __builtin_amdgcn_global_load_lds((const unsigned*)(kt_ + kof[2]), kl_ + 16 * 256, 16, 0, 0); \
    __builtin_amdgcn_global_load_lds((const unsigned*)(vt_ + vof), vl_ + wave_id * 256, 16, 0, 0); \
    __builtin_amdgcn_global_load_lds((const unsigned*)(vt_ + (size_t)ld * 64 + vof), vl_ + (wave_id + 8) * 256, 16, 0, 0); } while (0)
  const int kbase = r32 * K2_ROWB + hi * 16, vb0 = (int)(uintptr_t)lds + K2_BYTES + v_rd_base(lane);
  __syncthreads();
  DMA2(0, 0);
#define PASS_TILE(j) do { asm volatile("s_waitcnt vmcnt(0)" ::: "memory"); __syncthreads(); if ((j) + 1 < NT) DMA2((j) + 1, ((j) & 1) ^ 1); } while (0)
#pragma unroll 1
  for (int j = 0; j < wlo; ++j) PASS_TILE(j);
#pragma unroll 1
  for (int j = wlo; j <= whi; ++j) {
    const int b = j & 1;
    asm volatile("s_waitcnt vmcnt(0)" ::: "memory"); __syncthreads();
    if (j + 1 < NT) DMA2(j + 1, b ^ 1);
    f32x16 p0, p1; float mn, alpha; bf16x8 pa0, pa1, pa2, pa3;
    qkt2(p0, p1, lds + b * BUF2_BYTES + kbase, qr);
    partialSM<1>(p0, p1, m_reg, mn, alpha, (t0 + j < 0 || t0 + j >= tmax) ? 1e9f : dq - 64.f * (float)j, sl2);
    if (__any(alpha < 1.f)) { if (hi == 0) al_l[r32] = alpha; asm volatile("s_waitcnt lgkmcnt(0)" ::: "memory");
#pragma unroll
      for (int d = 0; d < 4; ++d)
#pragma unroll
        for (int r = 0; r < 16; ++r) o[d][r] *= al_l[crow(r, hi)]; }
    finishSM(p0, p1, alpha, l_reg, pa0, pa1, pa2, pa3); SBAR();
    const int vb = vb0 + b * BUF2_BYTES;
    pv_d0(o, vb, pa0, pa1, pa2, pa3);
  }
#pragma unroll 1
  for (int j = whi + 1; j < NT; ++j) PASS_TILE(j);
  asm volatile("s_waitcnt vmcnt(0)" ::: "memory");
#undef PASS_TILE
#undef DMA2
}
}

#ifndef PG8_SP2
#define PG8_SP2 true
#endif
#ifndef PG8_ALIGN
#define PG8_ALIGN true
#endif
constexpr int NWAVES = 8;
constexpr int BATCH = 4, SEQ = 4096, DM = 4096, FF = 11008, M = BATCH * SEQ;
constexpr int NIN = 23552, NQKV = 15360, NGATE = 8192, PLE = 256;
constexpr float LN_EPS = 1e-5f, SUBLN_EPS = 1e-5f;
constexpr float ALPHA = 1.189207115002721f;
constexpr float LAMBDA_INIT = 0.2f;
constexpr float QSCALE = 0.08838834764831845f * 1.4426950408889634f;
constexpr float LOG2E = 1.4426950408889634f;

constexpr size_t MiB = 1u << 20;
constexpr size_t WS_CTL = 0, CTL_ZERO_BYTES = MiB / 2;
constexpr size_t WS_W1IN = 1 * MiB, WS_W1OUT = WS_W1IN + 172 * MiB;
constexpr size_t WS_GATES = WS_W1IN;
constexpr size_t WS_WIN = WS_W1OUT + 86 * MiB;
constexpr size_t WS_WA = WS_WIN + 184 * MiB, WS_WB = WS_WA + 16 * MiB, WS_WOUT = WS_WB + 8 * MiB;
constexpr size_t WS_W2IN = WS_WOUT + 32 * MiB, WS_W2OUT = WS_W2IN + 172 * MiB;
constexpr size_t WS_WG = WS_W2OUT + 86 * MiB, WS_WP = WS_WG + 32 * MiB;
constexpr size_t WS_HB = WS_WP + 2 * MiB;
constexpr size_t WS_BIG = WS_HB + 128 * MiB;
constexpr size_t WS_Y1 = WS_BIG, WS_Y = WS_BIG + 256 * MiB;
constexpr size_t WS_OA = WS_BIG + 480 * MiB;
constexpr size_t WS_OB = WS_OA + 64 * MiB;
constexpr size_t WS_DILP = WS_OB + 32 * MiB;
constexpr size_t WS_LSE = WS_DILP + 96 * MiB;
constexpr size_t WS_SCR = WS_LSE + 2 * MiB;
constexpr size_t WS_PB = WS_SCR + 64 * MiB;
constexpr size_t WS_PP = WS_PB + 8 * MiB;
constexpr size_t WS_NRM = WS_PP + 128 * MiB;
constexpr size_t WS_CP = WS_NRM + 8 * MiB, WS_DP = WS_CP + 13 * MiB;
constexpr size_t WS_PART = WS_DP + 13 * MiB;
constexpr size_t WS_END = WS_PART + 6 * MiB;
static_assert(WS_GATES + (size_t)M * NGATE * 2 <= WS_WIN, "gates overlay fits in the FFN1 weight region");
static_assert((size_t)M * NQKV * 2 <= 480 * MiB && (size_t)M * FF * 2 <= 480 * MiB, "BIG region");
#ifndef FFOUT_WGM
#define FFOUT_WGM 4
#endif
constexpr int CW_QA = 8192, CW_QB = 8256;
constexpr int NCV = NIN + 2 * FF + DM, CV1 = 0, CV2 = NIN, CV3 = NIN + 2 * FF;
constexpr int CW_CV = 16384;
static_assert((size_t)(CW_CV + 2 * NCV) * 4 <= CTL_ZERO_BYTES && (size_t)64 * NCV * 4 <= 13 * MiB, "CTL / partial-sum maps");
constexpr int CW_SPLIT = 8704;
constexpr int CW_BAR = 4096;

constexpr int RING_OFF = 0, RING_BYTES = 131072;
constexpr int LDSCTL_OFF = RING_BYTES, MISC_OFF = LDSCTL_OFF + 320;
constexpr int LDS_BYTES = 147456;
constexpr int ATT_RED_OFF = 69632 + 8 * 4096;
constexpr float PRUNE_T = 38.0f;
constexpr int ATT_STASH_OFF = 69632;
static_assert(att::SHM_ATTN <= ATT_STASH_OFF && ATT_RED_OFF + 256 <= RING_BYTES && att::WS2_OFF + 2048 <= ATT_RED_OFF, "attention LDS map");

#define GAS __attribute__((address_space(1)))
#define LAS __attribute__((address_space(3)))
typedef unsigned short bf16;
typedef unsigned v4u __attribute__((ext_vector_type(4)));
typedef float f32x4 __attribute__((ext_vector_type(4)));
typedef short bf16x8 __attribute__((ext_vector_type(8)));
typedef GAS unsigned gu32;
typedef GAS unsigned long long gu64;
#define RLX_AGENT __ATOMIC_RELAXED, __HIP_MEMORY_SCOPE_AGENT
#define LDS_WAIT() asm volatile("s_waitcnt lgkmcnt(0)" ::: "memory")
#define VM_WAIT() asm volatile("s_waitcnt vmcnt(0)" ::: "memory")
__device__ __forceinline__ unsigned long long rt() { return __builtin_amdgcn_s_memrealtime(); }
__device__ __forceinline__ unsigned f2bf(float f) { unsigned u = __builtin_bit_cast(unsigned, f); return (u + 0x7fffu + ((u >> 16) & 1u)) >> 16; }
__device__ __forceinline__ unsigned pk2(float lo, float hi) { return f2bf(lo) | (f2bf(hi) << 16); }

#define XB_TMO      128
#define XB_XCNT(j)  (256  + 64 * (j))
#define XB_XSUB(j)  (1280 + 64 * (j))
#define XB_XGEN(j)  (2304 + 64 * (j))
#define XB_TOP      3328
#define XB_TOPGEN   3392
#define XCD_BAR_WORDS 3456
#define XB_SPIN_CAP (1u << 18)

__device__ __forceinline__ unsigned xb_ld(unsigned* p)              { return __hip_atomic_load(p, __ATOMIC_RELAXED, __HIP_MEMORY_SCOPE_AGENT); }
__device__ __forceinline__ unsigned xb_add(unsigned* p, unsigned v) { return __hip_atomic_fetch_add(p, v, __ATOMIC_RELAXED, __HIP_MEMORY_SCOPE_AGENT); }
__device__ __forceinline__ unsigned xb_xcc_id() { return (unsigned)__builtin_amdgcn_s_getreg((3 << 11) | 20) & 0xFu; }
#define XB_SPIN(cond, bar) do { unsigned _sp = 0; while (cond) { __builtin_amdgcn_s_sleep(1); \
    if ((++_sp & 255u) == 0u) { if (xb_ld(&(bar)[XB_TMO])) break; if (_sp > XB_SPIN_CAP) { atomicAdd(&(bar)[XB_TMO], 1u); break; } } } } while (0)

struct XcdBarrier {
    unsigned* bar; unsigned x;
    volatile LAS unsigned* st;
};

__device__ __forceinline__ XcdBarrier xcd_barrier_post(unsigned* bar, volatile LAS unsigned* st, bool thread0) {
    XcdBarrier b; b.bar = bar; b.x = xb_xcc_id(); b.st = st;
    if (thread0) (void)xb_add(&bar[XB_XCNT(b.x)], 1u);
    return b;
}
__device__ __forceinline__ void xcd_barrier_complete(unsigned* bar, unsigned x, unsigned& nloc, unsigned& nx) {
    const unsigned G = gridDim.x * gridDim.y * gridDim.z;
    unsigned sum, cnt, mine, sp = 0u;
    for (;;) {
        sum = 0u; cnt = 0u; mine = 0u;
#pragma unroll
        for (unsigned j = 0; j < 16; ++j) { const unsigned c = xb_ld(&bar[XB_XCNT(j)]); sum += c; cnt += (c > 0u) ? 1u : 0u; mine = (j == x) ? c : mine; }
        if (sum == G) break;
        __builtin_amdgcn_s_sleep(1);
        if ((++sp & 255u) == 0u) { if (xb_ld(&bar[XB_TMO])) break; if (sp > XB_SPIN_CAP) { atomicAdd(&bar[XB_TMO], 1u); break; } }
    }
    nloc = mine > 0u ? mine : 1u; nx = cnt > 0u ? cnt : 1u;
}

__device__ __forceinline__ void xcd_barrier(const XcdBarrier& b, bool thread0) {
    asm volatile("s_waitcnt vmcnt(0)" ::: "memory");
    __syncthreads();
    if (thread0) {
        unsigned* bar = b.bar;
        __builtin_amdgcn_s_waitcnt(0);
        unsigned nloc = b.st[0], nx = b.st[1];
        if (nloc == 0u) { xcd_barrier_complete(bar, b.x, nloc, nx); b.st[0] = nloc; b.st[1] = nx; }
        const unsigned old = xb_add(&bar[XB_XSUB(b.x)], 1u);
        const unsigned gen = old / nloc;
        if (old + 1u == (gen + 1u) * nloc) {
            __builtin_amdgcn_fence(__ATOMIC_RELEASE, "agent");
            asm volatile("s_waitcnt vmcnt(0)" ::: "memory");
            const unsigned og = xb_add(&bar[XB_TOP], 1u);
            const unsigned tg = og / nx;
            if (og + 1u == (tg + 1u) * nx) xb_add(&bar[XB_TOPGEN], 1u);
            else XB_SPIN(xb_ld(&bar[XB_TOPGEN]) == tg, bar);
            __builtin_amdgcn_fence(__ATOMIC_ACQUIRE, "agent");
            xb_add(&bar[XB_XGEN(b.x)], 1u);
            asm volatile("s_waitcnt vmcnt(0)" ::: "memory");
        } else {
            XB_SPIN(xb_ld(&bar[XB_XGEN(b.x)]) == gen, bar);
            __builtin_amdgcn_fence(__ATOMIC_ACQUIRE, "agent");
            asm volatile("s_waitcnt vmcnt(0)" ::: "memory");
        }
    }
    __syncthreads();
}
struct Frame {
    LAS unsigned char* lds;
    volatile LAS unsigned* MISC;
    gu32* ctl;
    int tid, lane, wave;
    int vcu, G;
};
typedef float f32x8v __attribute__((ext_vector_type(8)));
__device__ __forceinline__ float wave_sum(float v) { XL_RED64(xl_add, v); return v; }
template <bool FOLD>
__device__ __forceinline__ void p0_transpose_item(const float* W, int K, int N, bf16* WT, int dpitch, int dst_row0, LAS float* scr, int k0, int n0, int lane, const float* g, const float* bb, float* cp, float* dp) {
#pragma unroll 8
    for (int i = 0; i < 32; ++i) { const int kk = 2 * i + (lane >> 5); scr[kk * 33 + (lane & 31)] = W[(size_t)(k0 + kk) * N + n0 + (lane & 31)]; }
    LDS_WAIT(); asm volatile("" ::: "memory");
    const int c = lane & 7;
    float gv[8], bv[8];
    if (FOLD) { const f32x4 g0 = *(const GAS f32x4*)(g + k0 + 8 * c), g1 = *(const GAS f32x4*)(g + k0 + 8 * c + 4), b0 = *(const GAS f32x4*)(bb + k0 + 8 * c), b1 = *(const GAS f32x4*)(bb + k0 + 8 * c + 4);
#pragma unroll
        for (int i = 0; i < 4; ++i) { gv[i] = g0[i]; gv[4 + i] = g1[i]; bv[i] = b0[i]; bv[4 + i] = b1[i]; } }
#pragma unroll
    for (int j = 0; j < 4; ++j) { const int n = (lane >> 3) + 8 * j; const LAS float* s = scr + (8 * c) * 33 + n;
        float w[8];
#pragma unroll
        for (int i = 0; i < 8; ++i) w[i] = s[i * 33];
        float ds = 0.f;
        if (FOLD) {
#pragma unroll
            for (int i = 0; i < 8; ++i) { ds += w[i] * bv[i]; w[i] *= gv[i]; } }
        v4u o; o.x = pk2(w[0], w[1]); o.y = pk2(w[2], w[3]); o.z = pk2(w[4], w[5]); o.w = pk2(w[6], w[7]);
        *(GAS v4u*)(WT + (size_t)(dst_row0 + n) * dpitch + k0 + 8 * c) = o;
        if (FOLD) { float cs = ((__uint_as_float(o.x << 16) + __uint_as_float(o.x & 0xffff0000u)) + (__uint_as_float(o.y << 16) + __uint_as_float(o.y & 0xffff0000u)))
                             + ((__uint_as_float(o.z << 16) + __uint_as_float(o.z & 0xffff0000u)) + (__uint_as_float(o.w << 16) + __uint_as_float(o.w & 0xffff0000u)));
            XL_RED8(xl_add, cs); XL_RED8(xl_add, ds);
            if (c == 0) { cp[dst_row0 + n] = cs; dp[dst_row0 + n] = ds; } } }
    LDS_WAIT(); asm volatile("" ::: "memory");
}
__device__ __forceinline__ void cvt_rows(Frame& F, const float* src, bf16* dst, size_t n8) {
    const size_t gt = (size_t)(F.vcu * NWAVES + F.wave) * 64 + F.lane, NT = (size_t)F.G * NWAVES * 64;
    for (size_t i = gt; i < n8; i += NT) { const f32x8v x = *(const GAS f32x8v*)(src + i * 8);
        v4u o; o.x = pk2(x[0], x[1]); o.y = pk2(x[2], x[3]); o.z = pk2(x[4], x[5]); o.w = pk2(x[6], x[7]); *(GAS v4u*)(dst + i * 8) = o; }
}

__device__ __forceinline__ void p0_prologue(Frame& F, KargP a) {
    LAS float* scr = (LAS float*)(F.lds + RING_OFF + F.wave * 16384);
    const int gw = F.vcu * NWAVES + F.wave, NGW = F.G * NWAVES;
    unsigned char* ws = a->ws;
#define TR_MAT(SRC, KK, NN, DST, SWI, FOLD, GV, BV, CVO) TR_MATP(SRC, KK, NN, DST, KK, SWI, FOLD, GV, BV, CVO)
#define TR_MATP(SRC, KK, NN, DST, DPITCH, SWI, FOLD, GV, BV, CVO) do { const int nblk = (NN) / 32, nit = ((KK) / 64) * nblk; \
        for (int it = gw; it < nit; it += NGW) { const int kb = it / nblk, nb = it % nblk, n0 = 32 * nb; int dr = n0; \
            if (SWI) { const int c = n0 < FF ? n0 : n0 - FF; dr = (c >> 7) * 256 + (c & 127) + (n0 < FF ? 0 : 128); } \
            p0_transpose_item<FOLD>((SRC), (KK), (NN), (bf16*)(ws + (DST)), (DPITCH), dr, scr, 64 * kb, n0, F.lane, (GV), (BV), (float*)(ws + WS_CP) + (size_t)kb * NCV + (CVO), (float*)(ws + WS_DP) + (size_t)kb * NCV + (CVO)); } } while (0)
    TR_MAT(a->in[2], DM, 2 * FF, WS_W1IN, true, false, nullptr, nullptr, 0);
    TR_MAT(a->in[3], FF, DM, WS_W1OUT, false, false, nullptr, nullptr, 0);
    TR_MAT(a->in[6], DM, NIN, WS_WIN, false, true, a->in[4], a->in[5], CV1);
    TR_MATP(a->in[12], 2048, DM, WS_WA, 3072, false, false, nullptr, nullptr, 0);
    TR_MATP(a->in[13], 1024, DM, WS_WA + 2048 * 2, 3072, false, false, nullptr, nullptr, 0);
    TR_MAT(a->in[14], DM, DM, WS_WOUT, false, false, nullptr, nullptr, 0);
    TR_MAT(a->in[17], DM, 2 * FF, WS_W2IN, true, true, a->in[15], a->in[16], CV2);
    TR_MAT(a->in[18], FF, DM, WS_W2OUT, false, false, nullptr, nullptr, 0);
    TR_MAT(a->in[21], DM, DM, WS_WG, false, true, a->in[19], a->in[20], CV3);
    TR_MAT(a->in[22], PLE, DM, WS_WP, false, false, nullptr, nullptr, 0);
#undef TR_MAT
#undef TR_MATP
    cvt_rows(F, a->in[0], (bf16*)(ws + WS_HB), (size_t)M * DM / 8);
    cvt_rows(F, a->in[1], (bf16*)(ws + WS_PB), (size_t)M * PLE / 8);
}
__device__ __forceinline__ void colsum_reduce(Frame& F, unsigned char* ws) {
    const int gt = (F.vcu * NWAVES + F.wave) * 64 + F.lane, NT = F.G * NWAVES * 64;
    const float* cp = (const float*)(ws + WS_CP); const float* dp = (const float*)(ws + WS_DP); float* cv = (float*)(ws + WS_CTL) + CW_CV;
    for (int n = gt; n < NCV; n += NT) { float c = 0.f, d = 0.f;
#pragma unroll 8
        for (int kb = 0; kb < 64; ++kb) { c += cp[(size_t)kb * NCV + n]; d += dp[(size_t)kb * NCV + n]; }
        cv[n] = c; cv[NCV + n] = d; }
}
__device__ __forceinline__ int ln_table(Frame& F, const float* part, int N, int wgm = 8) {
    pg8::StaticOrder S0; S0.init(M, N, F.G, (int)blockIdx.x, wgm); pg8::Unit u0, u2; S0.next(0, u0); u2 = u0; if (wgm != 8) S0.next(2, u2);
#pragma unroll
    for (int t = 0; t < 2; ++t) { const int pm = t ? u2.pm : u0.pm;
        if (F.tid < 256) { const GAS f32x4* p = (const GAS f32x4*)(part + (size_t)(pm * 256 + F.tid) * 32); float s1 = 0.f, s2 = 0.f;
#pragma unroll
            for (int i = 0; i < 8; ++i) { const f32x4 v = p[i]; s1 += v[0] + v[2]; s2 += v[1] + v[3]; }
            const float mu = s1 * (1.f / DM), var = fmaxf(s2 * (1.f / DM) - mu * mu, 0.f);
            *(LAS pg8::f32x2s*)(F.lds + pg8::LDS_STAB + (t * 256 + F.tid) * 8) = (pg8::f32x2s){mu, 1.f / sqrtf(var + LN_EPS)}; } }
    __syncthreads();
    return u0.pm;
}
template <bool WB>
__device__ __forceinline__ void ln_phase(Frame& F, float* hf, const float* g, const float* b, bf16* hb) {
    const int gw = F.vcu * NWAVES + F.wave, NGW = F.G * NWAVES;
    for (int m = gw; m < M; m += NGW) {
        GAS f32x4* xr = (GAS f32x4*)(hf + (size_t)m * DM) + F.lane;
        f32x4 v[16]; float s = 0.f;
#pragma unroll
        for (int j = 0; j < 16; ++j) { v[j] = xr[64 * j]; s += (v[j].x + v[j].y) + (v[j].z + v[j].w); }
        const float mean = wave_sum(s) * (1.f / DM); float s2 = 0.f;
#pragma unroll
        for (int j = 0; j < 16; ++j) { v[j] = v[j] - mean; s2 += (v[j].x * v[j].x + v[j].y * v[j].y) + (v[j].z * v[j].z + v[j].w * v[j].w); }
        const float rstd = 1.f / sqrtf(wave_sum(s2) * (1.f / DM) + LN_EPS);
        GAS unsigned long long* o8 = (GAS unsigned long long*)(hb + (size_t)m * DM) + F.lane;
#pragma unroll
        for (int j = 0; j < 16; ++j) { const f32x4 gv = *((const GAS f32x4*)g + F.lane + 64 * j), bv = *((const GAS f32x4*)b + F.lane + 64 * j);
            const f32x4 y = v[j] * rstd * gv + bv; xr[64 * j] = y;
            if (WB) o8[64 * j] = (unsigned long long)pk2(y.x, y.y) | ((unsigned long long)pk2(y.z, y.w) << 32); }
    }
}
__device__ __forceinline__ void ln4_phase(Frame& F, const bf16* src, float* out, const float* g, const float* b) {
    const int gw = F.vcu * NWAVES + F.wave, NGW = F.G * NWAVES;
    for (int m = gw; m < M; m += 2 * NGW) {
        v4u w[2][8]; float s[2] = {0.f, 0.f}, s2[2] = {0.f, 0.f};
#pragma unroll
        for (int t = 0; t < 2; ++t) { const GAS v4u* xr = (const GAS v4u*)(src + (size_t)(m + t * NGW) * DM) + F.lane;
#pragma unroll
            for (int j = 0; j < 8; ++j) w[t][j] = xr[64 * j]; }
        float mean[2], rstd[2];
#pragma unroll
        for (int t = 0; t < 2; ++t) {
#pragma unroll
            for (int j = 0; j < 8; ++j) { const unsigned u[4] = {w[t][j].x, w[t][j].y, w[t][j].z, w[t][j].w};
#pragma unroll
                for (int i = 0; i < 4; ++i) s[t] += __uint_as_float(u[i] << 16) + __uint_as_float(u[i] & 0xffff0000u); }
            mean[t] = wave_sum(s[t]) * (1.f / DM);
#pragma unroll
            for (int j = 0; j < 8; ++j) { const unsigned u[4] = {w[t][j].x, w[t][j].y, w[t][j].z, w[t][j].w};
#pragma unroll
                for (int i = 0; i < 4; ++i) { const float d0 = __uint_as_float(u[i] << 16) - mean[t], d1 = __uint_as_float(u[i] & 0xffff0000u) - mean[t]; s2[t] += d0 * d0 + d1 * d1; } }
            rstd[t] = 1.f / sqrtf(wave_sum(s2[t]) * (1.f / DM) + LN_EPS); }
#pragma unroll
        for (int j = 0; j < 8; ++j) { const GAS f32x4* gp = (const GAS f32x4*)g + 2 * (F.lane + 64 * j); const GAS f32x4* bp = (const GAS f32x4*)b + 2 * (F.lane + 64 * j);
            const f32x4 g0 = gp[0], g1 = gp[1], b0 = bp[0], b1 = bp[1];
#pragma unroll
            for (int t = 0; t < 2; ++t) { const v4u u = w[t][j]; GAS f32x4* o = (GAS f32x4*)(out + (size_t)(m + t * NGW) * DM) + 2 * (F.lane + 64 * j);
                const f32x4 x0 = {__uint_as_float(u.x << 16), __uint_as_float(u.x & 0xffff0000u), __uint_as_float(u.y << 16), __uint_as_float(u.y & 0xffff0000u)};
                const f32x4 x1 = {__uint_as_float(u.z << 16), __uint_as_float(u.z & 0xffff0000u), __uint_as_float(u.w << 16), __uint_as_float(u.w & 0xffff0000u)};
                o[0] = (x0 - mean[t]) * rstd[t] * g0 + b0; o[1] = (x1 - mean[t]) * rstd[t] * g1 + b1; } }
    }
}
__device__ __forceinline__ void combine_phase(Frame& F, const bf16* dilp, const float* lse, bf16* ob) {
    const int gw = F.vcu * NWAVES + F.wave, NGW = F.G * NWAVES;
    for (int m = gw; m < M; m += NGW) {
        const int h = F.lane >> 3;
        const float l0 = lse[(size_t)m * 8 + h], l1 = lse[(size_t)M * 8 + (size_t)m * 8 + h], l2 = lse[(size_t)2 * M * 8 + (size_t)m * 8 + h];
        const float mx = fmaxf(l0, fmaxf(l1, l2));
        float w0 = __builtin_amdgcn_exp2f(l0 - mx), w1 = __builtin_amdgcn_exp2f(l1 - mx), w2 = __builtin_amdgcn_exp2f(l2 - mx);
        const float inv = 1.f / (w0 + w1 + w2); w0 *= inv; w1 *= inv; w2 *= inv;
        float acc[16];
#pragma unroll
        for (int i = 0; i < 16; ++i) acc[i] = 0.f;
#pragma unroll
        for (int g = 0; g < 3; ++g) { const float w = g == 0 ? w0 : (g == 1 ? w1 : w2);
            const GAS v4u* p = (const GAS v4u*)(dilp + (size_t)g * M * 1024 + (size_t)m * 1024 + F.lane * 16);
            const v4u a = p[0], c = p[1];
            const unsigned wd[8] = {a.x, a.y, a.z, a.w, c.x, c.y, c.z, c.w};
#pragma unroll
            for (int i = 0; i < 8; ++i) { acc[2 * i] += w * __uint_as_float(wd[i] << 16); acc[2 * i + 1] += w * __uint_as_float(wd[i] & 0xffff0000u); } }
        v4u o0, o1; o0.x = pk2(acc[0], acc[1]); o0.y = pk2(acc[2], acc[3]); o0.z = pk2(acc[4], acc[5]); o0.w = pk2(acc[6], acc[7]);
        o1.x = pk2(acc[8], acc[9]); o1.y = pk2(acc[10], acc[11]); o1.z = pk2(acc[12], acc[13]); o1.w = pk2(acc[14], acc[15]);
        GAS v4u* q = (GAS v4u*)(ob + (size_t)m * 3072 + 2048 + F.lane * 16); q[0] = o0; q[1] = o1;
    }
}

__device__ __forceinline__ void attention_phase(Frame& F, KargP a, char* lds) {
    using att::f32x16; using att::crow;
    unsigned char* ws = a->ws;
    const att::bf16* QKV = (const att::bf16*)(ws + WS_BIG);
    float lam;
    { const int lane = F.lane; const float* q1 = a->in[7]; const float* k1 = a->in[8]; const float* q2 = a->in[9]; const float* k2 = a->in[10];
      const float s1 = wave_sum(q1[lane] * k1[lane] + q1[lane + 64] * k1[lane + 64]), s2 = wave_sum(q2[lane] * k2[lane] + q2[lane + 64] * k2[lane + 64]);
      lam = expf(s1) - expf(s2) + LAMBDA_INIT; ((float*)(lds + ATT_RED_OFF))[44] = lam; }
    const float* subg = a->in[11];
    bf16* OA = (bf16*)(ws + WS_OA);
    float* SCR = (float*)(ws + WS_SCR) + (size_t)blockIdx.x * (2 * 64 * 512);
#ifndef ATT_A
#define ATT_A 1
#endif
#ifndef ATT_B
#define ATT_B 1
#endif
    if (ATT_A) for (;;) {
        __syncthreads();
        if (F.wave == 0 && lane_id_fresh() == 0) ((int*)(lds + ATT_RED_OFF))[40] = (int)__hip_atomic_fetch_add((unsigned*)(F.ctl + CW_QA), 1u, __ATOMIC_RELAXED, __HIP_MEMORY_SCOPE_AGENT);
        __syncthreads();
        const int u = __builtin_amdgcn_readfirstlane(((const int*)(lds + ATT_RED_OFF))[40]);
        if (u >= BATCH * 8 * 16) break;
        const int h = 7 - (u >> 6), b = (u >> 4) & 3, qb = u & 15;
        const size_t rowbase = (size_t)b * SEQ;
        const float sl2 = rfl_f(__builtin_amdgcn_exp2f(-(float)(h + 1)) * LOG2E);
        { const float* NRM = (const float*)(ws + WS_NRM); const int tq = F.wave * 64 + lane_id_fresh();
          float km0 = 0.f, km1 = 0.f, qm0 = 0.f, qm1 = 0.f;
          const GAS f32x4* nk = (const GAS f32x4*)(NRM + rowbase * 128 + (8 + h) * 8);
          for (int j = tq; j < SEQ; j += NWAVES * 64) { const f32x4 a = nk[(size_t)j * 32], c4 = nk[(size_t)j * 32 + 1];
              km0 = fmaxf(km0, (a.x + a.y) + (a.z + a.w)); km1 = fmaxf(km1, (c4.x + c4.y) + (c4.z + c4.w)); }
          float dg = 0.f;
          { const GAS v4u* qp = (const GAS v4u*)(QKV + (rowbase + qb * 256 + (tq & 255)) * NQKV + h * 256 + (tq >> 8) * 128);
            const GAS v4u* kp2 = (const GAS v4u*)(QKV + (rowbase + qb * 256 + (tq & 255)) * NQKV + 2048 + h * 256 + (tq >> 8) * 128);
#pragma unroll 4
            for (int i = 0; i < 16; ++i) { const v4u a = qp[i], c4 = kp2[i];
                dg += __uint_as_float(a.x << 16) * __uint_as_float(c4.x << 16) + __uint_as_float(a.x & 0xffff0000u) * __uint_as_float(c4.x & 0xffff0000u);
                dg += __uint_as_float(a.y << 16) * __uint_as_float(c4.y << 16) + __uint_as_float(a.y & 0xffff0000u) * __uint_as_float(c4.y & 0xffff0000u);
                dg += __uint_as_float(a.z << 16) * __uint_as_float(c4.z << 16) + __uint_as_float(a.z & 0xffff0000u) * __uint_as_float(c4.z & 0xffff0000u);
                dg += __uint_as_float(a.w << 16) * __uint_as_float(c4.w << 16) + __uint_as_float(a.w & 0xffff0000u) * __uint_as_float(c4.w & 0xffff0000u); } }
          if (tq < 256) { const GAS f32x4* nq = (const GAS f32x4*)(NRM + (rowbase + qb * 256 + tq) * 128 + h * 8); const f32x4 a = nq[0], c4 = nq[1];
              qm0 = (a.x + a.y) + (a.z + a.w); qm1 = (c4.x + c4.y) + (c4.z + c4.w); }
          XL_RED64(fminf, dg); XL_RED64(fmaxf, km0); XL_RED64(fmaxf, km1); XL_RED64(fmaxf, qm0); XL_RED64(fmaxf, qm1);
          float* red = (float*)(lds + ATT_RED_OFF);
          __syncthreads();
          if ((tq & 63) == 0) { red[48 + F.wave] = dg; red[F.wave * 4 + 0] = km0; red[F.wave * 4 + 1] = km1; red[F.wave * 4 + 2] = qm0; red[F.wave * 4 + 3] = qm1; }
          __syncthreads();
#pragma unroll
          for (int w = 0; w < NWAVES; ++w) { km0 = fmaxf(km0, red[w * 4 + 0]); km1 = fmaxf(km1, red[w * 4 + 1]); qm0 = fmaxf(qm0, red[w * 4 + 2]); qm1 = fmaxf(qm1, red[w * 4 + 3]); }
#pragma unroll
          for (int c = 0; c < 2; ++c) { const float S = rfl_f(sqrtf((c ? qm1 : qm0) * (c ? km1 : km0))) * 1.01f;
              const float mlb = fmaxf(rfl_f(fminf(fminf(red[48 + 4 * c], red[49 + 4 * c]), fminf(red[50 + 4 * c], red[51 + 4 * c]))) - 0.01f, -S);
              const float dmin = (S - mlb + PRUNE_T) / sl2; const int D = dmin > 8192.f ? 8192 : (int)dmin + 1, q0 = qb * 256;
              int lo = (q0 - 63 - D + 64 * 256) / 64 - 256 + 1; if (lo < 0) lo = 0;
              int hi_t = (q0 + 255 + D + 63) / 64 - 1; if (hi_t > SEQ / 64 - 1) hi_t = SEQ / 64 - 1;
              const int nt = hi_t - lo + 1;
              if (tq == 0) { ((int*)red)[32 + c] = lo; ((int*)red)[34 + c] = nt; ((int*)red)[36 + c] = D; } }
          __syncthreads(); }
        for (int c = 0; c < 2; ++c) {
            const int t0 = __builtin_amdgcn_readfirstlane(((const int*)(lds + ATT_RED_OFF))[32 + c]), NTc = __builtin_amdgcn_readfirstlane(((const int*)(lds + ATT_RED_OFF))[34 + c]);
            const att::bf16* Qb = QKV + (rowbase + qb * 256) * NQKV + h * 256 + c * 128;
            const att::bf16* Kh = QKV + rowbase * NQKV + 2048 + h * 256 + c * 128;
            const att::bf16* Vh = QKV + rowbase * NQKV + 4096 + h * 256;
            f32x16 o[8]; float m_reg, l_reg;
            { const int l0 = lane_id_fresh(); const float dq = (float)(qb * 256 + F.wave * 32 + (l0 & 31) - 4 * (l0 >> 5) - 64 * t0);
              const int Dc = __builtin_amdgcn_readfirstlane(((const int*)(lds + ATT_RED_OFF))[36 + c]), W0 = qb * 256 + F.wave * 32;
              int wlo = (W0 - 63 - Dc + 64 * 256) / 64 - 256 + 1 - t0, whi = (W0 + 31 + Dc + 63) / 64 - 1 - t0; if (wlo < 0) wlo = 0; if (whi > NTc - 1) whi = NTc - 1;
              att::attn_core_dv256(Qb, Kh, Vh, (unsigned)NQKV, NTc, t0, dq, sl2, F.wave, wlo, whi, lds, o, m_reg, l_reg); }
            const int wid = F.wave, lane = lane_id_fresh(), tid = wid * 64 + lane, r32 = lane & 31, hi = lane >> 5;
            float* wsx = (float*)(lds + att::WS2_OFF) + wid * 64;
            if (hi == 0) wsx[r32] = l_reg;
            asm volatile("s_waitcnt lgkmcnt(0)" ::: "memory");
            float rli[16];
#pragma unroll
            for (int r = 0; r < 16; ++r) rli[r] = __builtin_amdgcn_rcpf(wsx[crow(r, hi)]);
            GAS f32x4* scr4 = (GAS f32x4*)(SCR + (size_t)tid * 128); asm volatile("" : "+v"(scr4));
            if (c == 0) {
#pragma unroll
                for (int d0 = 0; d0 < 8; ++d0)
#pragma unroll
                    for (int q = 0; q < 4; ++q) scr4[d0 * 4 + q] = (f32x4){o[d0][4 * q] * rli[4 * q], o[d0][4 * q + 1] * rli[4 * q + 1], o[d0][4 * q + 2] * rli[4 * q + 2], o[d0][4 * q + 3] * rli[4 * q + 3]};
            } else {
                float ssq[16]; const float lam_l = ((const float*)(lds + ATT_RED_OFF))[44];
#pragma unroll
                for (int r = 0; r < 16; ++r) ssq[r] = 0.f;
#pragma unroll
                for (int d0 = 0; d0 < 8; ++d0) {
#pragma unroll
                    for (int q = 0; q < 4; ++q) { f32x4 d = scr4[d0 * 4 + q];
#pragma unroll
                        for (int i = 0; i < 4; ++i) { d[i] = d[i] - lam_l * (o[d0][4 * q + i] * rli[4 * q + i]); ssq[4 * q + i] += d[i] * d[i]; }
                        scr4[d0 * 4 + q] = d; }
                    asm volatile("" ::: "memory"); }
#pragma unroll
                for (int r = 0; r < 16; ++r) { float s = ssq[r]; XL_RED32(xl_add, s); ssq[r] = (1.0f - LAMBDA_INIT) / sqrtf(s * (1.f / 256.f) + SUBLN_EPS); }
                GAS bf16* orow = (GAS bf16*)(OA + (rowbase + qb * 256 + wid * 32) * 3072 + h * 256 + r32); asm volatile("" : "+v"(orow));
#pragma unroll
                for (int d0 = 0; d0 < 8; ++d0) { const float g = subg[d0 * 32 + r32];
#pragma unroll
                    for (int q = 0; q < 4; ++q) { const f32x4 d = scr4[d0 * 4 + q];
#pragma unroll
                        for (int i = 0; i < 4; ++i) orow[(size_t)crow(4 * q + i, hi) * 3072 + d0 * 32] = (bf16)f2bf(d[i] * ssq[4 * q + i] * g); }
                    asm volatile("" ::: "memory"); }
            }
        }
    }
    bf16* DILP = (bf16*)(ws + WS_DILP); float* LSE = (float*)(ws + WS_LSE);
    if (ATT_B) for (;;) {
        __syncthreads();
        if (F.wave == 0 && lane_id_fresh() == 0) ((int*)(lds + 16384))[0] = (int)__hip_atomic_fetch_add((unsigned*)(F.ctl + CW_QB), 1u, __ATOMIC_RELAXED, __HIP_MEMORY_SCOPE_AGENT);
        __syncthreads();
        const int u = __builtin_amdgcn_readfirstlane(((const int*)(lds + 16384))[0]    );
        if (u >= BATCH * 8 * 48) break;
        const int b = u / 384, rem = u % 384, h = rem / 48, rem2 = rem % 48, g = rem2 >> 4, w = rem2 & 15;
        const int dil = g == 0 ? 1 : (g == 1 ? 4 : 16), nU = 16 / dil, cls = w / nU, uu = w % nU, L = SEQ / dil;
        const size_t rowbase = (size_t)b * SEQ + cls;
        const long ld = (long)dil * NQKV;
        const att::bf16* Qb = QKV + (rowbase + (size_t)uu * 256 * dil) * NQKV + 6144 + g * 1024 + h * 128;
        const att::bf16* Kh = QKV + rowbase * NQKV + 9216 + g * 1024 + h * 128;
        const att::bf16* Vh = QKV + rowbase * NQKV + 12288 + g * 1024 + h * 128;
        const float sl2 = rfl_f(__builtin_amdgcn_exp2f(-(float)(3 * h + g + 1) * (1.f / 3.f)) * (float)dil * LOG2E);
        f32x16 o[4]; float m_reg, l_reg;
        { const int l0 = lane_id_fresh(); const float dq = (float)(64 + F.wave * 32 + (l0 & 31) - 4 * (l0 >> 5));
          att::attn_core_band(Qb, Kh, Vh, (unsigned)ld, 6, 4 * uu - 1, L / 64, dq, sl2, F.wave, F.wave >> 1, (F.wave >> 1) + 2, lds, o, m_reg, l_reg); }
        const int wid = F.wave, lane = lane_id_fresh(), r32 = lane & 31, hi = lane >> 5;
        float* wsx = (float*)(lds + att::WS2_OFF) + wid * 64;
        if (hi == 0) wsx[r32] = l_reg;
        asm volatile("s_waitcnt lgkmcnt(0)" ::: "memory");
        float rli[16];
#pragma unroll
        for (int r = 0; r < 16; ++r) rli[r] = __builtin_amdgcn_rcpf(wsx[crow(r, hi)]);
        GAS bf16* obase = (GAS bf16*)(DILP + (size_t)g * M * 1024 + h * 128 + r32); asm volatile("" : "+v"(obase));
#pragma unroll
        for (int r = 0; r < 16; ++r) { const size_t tok = rowbase + (size_t)(uu * 256 + wid * 32 + crow(r, hi)) * dil;
#pragma unroll
            for (int d0 = 0; d0 < 4; ++d0) obase[tok * 1024 + d0 * 32] = (bf16)f2bf(o[d0][r] * rli[r]); }
        if (hi == 0) { const size_t tok = rowbase + (size_t)(uu * 256 + wid * 32 + r32) * dil; LSE[(size_t)g * M * 8 + tok * 8 + h] = m_reg + __builtin_amdgcn_logf(l_reg); }
    }
}

static_assert(PG8_ALIGN, "the residual epilogue's workgroup barrier needs both half-workgroups in their epilogues together (ALIGN_EPI)");
__global__ void __launch_bounds__(NWAVES * 64, 2) mega_fwd(Args args) {
    extern __shared__ __attribute__((aligned(16))) unsigned char lds[];
    Frame F;
    F.lds = (LAS unsigned char*)lds;
    F.MISC = (volatile LAS unsigned*)(F.lds + MISC_OFF);
    F.wave = __builtin_amdgcn_readfirstlane((int)threadIdx.x >> 6); F.lane = lane_id_fresh(); F.tid = F.wave * 64 + F.lane;
    F.G = gridDim.x; { const int bx = blockIdx.x; F.vcu = (F.G % 8 == 0) ? (bx % 8) * (F.G / 8) + bx / 8 : bx; }
    KargP kp = (KargP)__builtin_amdgcn_kernarg_segment_ptr();
#define RELOAD() asm volatile("" : "+s"(kp))
    unsigned char* ws = kp->ws;
    F.ctl = (gu32*)(ws + WS_CTL);
    for (int u = F.tid; u < (LDS_BYTES - LDSCTL_OFF) / 4; u += NWAVES * 64) ((LAS unsigned*)(F.lds + LDSCTL_OFF))[u] = 0u;
    __syncthreads();
    XcdBarrier bar = xcd_barrier_post((unsigned*)(F.ctl + CW_BAR), F.MISC + 8, F.tid == 0);
#define GRID_BAR() do { xcd_barrier(bar, F.wave == 0 && lane_id_fresh() == 0); RELOAD(); ws = kp->ws; F.lane = lane_id_fresh(); F.tid = F.wave * 64 + F.lane; } while (0)
#define GEMM(EPI, A_, B_, N_, K_, E_) GEMMW(EPI, A_, B_, N_, K_, E_, 8)
#define GEMMW(EPI, A_, B_, N_, K_, E_, WGM_) do { pg8::Gemm g_{(const pg8::bf16_t*)(A_), (const pg8::bf16_t*)(B_), M, (N_), (K_), (K_)}; pg8::StaticOrder S_; S_.init(M, (N_), F.G, (int)blockIdx.x, (WGM_)); \
        pg8::gemm_phase<decltype(E_), pg8::StaticOrder, PG8_ALIGN, PG8_SP2>(F.lds + RING_OFF, g_, S_, (E_), F.wave); } while (0)
#define hf (kp->out)
#define hb ((bf16*)(ws + WS_HB))
#define big ((bf16*)(ws + WS_BIG))
#define PARTB(i) ((float*)(ws + WS_PART) + (size_t)(i) * M * 32)
#define CSV(o) ((const float*)(ws + WS_CTL) + CW_CV + (o))
#define DSV(o) ((const float*)(ws + WS_CTL) + CW_CV + NCV + (o))

    p0_prologue(F, kp);
    GRID_BAR();
    { pg8::EpiSwiglu<false> E; E.O = (pg8::bf16_t*)big; E.ldc = FF; E.L = F.lds; E.CS = E.DS = (const float*)ws; GEMM(pg8::EpiSwiglu<false>, hb, ws + WS_W1IN, 2 * FF, DM, E); }
    __syncthreads();
    { constexpr int NU1 = (M / 256) * (2 * FF / 256); const int rem = NU1 % F.G;
      const int gpp = rem ? F.G - rem : F.G, cpp = rem ? (int)blockIdx.x - rem : (int)blockIdx.x;
      if (cpp >= 0) { pg8::EpiBf16Plain E{(pg8::bf16_t*)(ws + WS_PP), DM}; pg8::Gemm g_{(const pg8::bf16_t*)(ws + WS_PB), (const pg8::bf16_t*)(ws + WS_WP), M, DM, PLE, PLE}; pg8::StaticOrder S_; S_.init(M, DM, gpp, cpp);
          pg8::gemm_phase<pg8::EpiBf16Plain, pg8::StaticOrder, PG8_ALIGN, PG8_SP2>(F.lds + RING_OFF, g_, S_, E, F.wave); } }
    GRID_BAR();
    colsum_reduce(F, ws);
    { pg8::EpiResid<true, 0, 1> E; E.X = kp->in[0]; E.HB = (pg8::bf16_t*)hb; E.L = F.lds; E.PART = PARTB(0); E.pm0 = 0; GEMMW((pg8::EpiResid<true, 0, 1>), big, ws + WS_W1OUT, DM, FF, E, FFOUT_WGM); }
    GRID_BAR();
    { ln_table(F, PARTB(0), NIN); pg8::EpiInProj E; E.QKV = (pg8::bf16_t*)big; E.G = (pg8::bf16_t*)(ws + WS_GATES); E.qscale = QSCALE; E.NRM = (float*)(ws + WS_NRM); E.L = F.lds; E.CS = CSV(CV1); E.DS = DSV(CV1); GEMM(pg8::EpiInProj, hb, ws + WS_WIN, NIN, DM, E); }
    GRID_BAR();
    attention_phase(F, kp, (char*)lds);
    GRID_BAR();
    combine_phase(F, (const bf16*)(ws + WS_DILP), (const float*)(ws + WS_LSE), (bf16*)(ws + WS_OA));
    GRID_BAR();
    { pg8::EpiGateAB E{(const pg8::bf16_t*)(ws + WS_GATES), (pg8::bf16_t*)(ws + WS_Y)}; GEMM(pg8::EpiGateAB, ws + WS_OA, ws + WS_WA, DM, 3072, E); }
    GRID_BAR();
    { pg8::EpiResid<false, 4, 0> E; E.pm0 = ln_table(F, PARTB(0), DM); E.X = nullptr; E.HB = (pg8::bf16_t*)hb; E.L = F.lds; E.PART = PARTB(1); GEMM((pg8::EpiResid<false, 4, 0>), ws + WS_Y, ws + WS_WOUT, DM, DM, E); }
    GRID_BAR();
    { ln_table(F, PARTB(1), 2 * FF); pg8::EpiSwiglu<true> E; E.O = (pg8::bf16_t*)big; E.ldc = FF; E.L = F.lds; E.CS = CSV(CV2); E.DS = DSV(CV2);
      constexpr int NU2 = (M / 256) * (2 * FF / 256); static_assert(NU2 % 256 == 128, "the split tail is written for 128 left-over units on 256 workgroups");
      { pg8::Gemm g_{(const pg8::bf16_t*)hb, (const pg8::bf16_t*)(ws + WS_W2IN), M, 2 * FF, DM, DM}; pg8::StaticOrder S_; S_.init(M, 2 * FF, F.G, (int)blockIdx.x); S_.imax = NU2 / 256;
        pg8::gemm_phase<pg8::EpiSwiglu<true>, pg8::StaticOrder, PG8_ALIGN, PG8_SP2>(F.lds + RING_OFF, g_, S_, E, F.wave); }
      const int v = (int)blockIdx.x & 127, role = (int)blockIdx.x >> 7;
      pg8::StaticOrder S0; S0.init(M, 2 * FF, F.G, v); pg8::OneUnit T; S0.next(NU2 / 256, T.u);
      pg8::EpiSwigluTail E2; E2.O = (pg8::bf16_t*)big; E2.ldc = FF; E2.L = F.lds; E2.CS = CSV(CV2); E2.DS = DSV(CV2); E2.P = (float*)(ws + WS_SCR) + (size_t)v * 65536; E2.FLAG = (unsigned*)(ws + WS_CTL) + CW_SPLIT + v; E2.role = role;
      pg8::Gemm g2{(const pg8::bf16_t*)hb + role * (DM / 2), (const pg8::bf16_t*)(ws + WS_W2IN) + role * (DM / 2), M, 2 * FF, DM / 2, DM};
      pg8::gemm_phase<pg8::EpiSwigluTail, pg8::OneUnit, PG8_ALIGN, PG8_SP2>(F.lds + RING_OFF, g2, T, E2, F.wave); }
    GRID_BAR();
    { pg8::EpiResid<false, 15, 1> E; E.pm0 = ln_table(F, PARTB(1), DM, FFOUT_WGM); E.X = nullptr; E.HB = (pg8::bf16_t*)hb; E.L = F.lds; E.PART = PARTB(2); GEMMW((pg8::EpiResid<false, 15, 1>), big, ws + WS_W2OUT, DM, FF, E, FFOUT_WGM); }
    GRID_BAR();
    { ln_table(F, PARTB(2), DM); pg8::EpiPle E; E.HB = (const pg8::bf16_t*)hb; E.out = (pg8::bf16_t*)big; E.PP = (const pg8::bf16_t*)(ws + WS_PP); E.L = F.lds; E.CS = CSV(CV3); E.DS = DSV(CV3); GEMM(pg8::EpiPle, hb, ws + WS_WG, DM, DM, E); }
    GRID_BAR();
    ln4_phase(F, big, hf, kp->in[23], kp->in[24]);
#undef GEMM
#undef GEMMW
#undef GRID_BAR
#undef hf
#undef hb
#undef big
#undef PARTB
#undef CSV
#undef DSV
}

extern "C" void kernel_launch(void* const* d_in, const int* in_sizes, int n_in, void* d_out, int out_size, void* d_ws, size_t ws_size, hipStream_t stream) {
    static int grid = 0;
    if (grid == 0) {
        if (n_in != 25 || in_sizes[0] != M * DM || out_size != M * DM || ws_size < WS_END) { fprintf(stderr, "kernel_launch: shape mismatch: n_in %d in0 %d out %d ws %zu (need %zu)\n", n_in, n_in > 0 ? in_sizes[0] : -1, out_size, ws_size, (size_t)WS_END); grid = -1; return; }
        int dev = 0, cus = 0;
        if (hipGetDevice(&dev) != hipSuccess || hipDeviceGetAttribute(&cus, hipDeviceAttributeMultiprocessorCount, dev) != hipSuccess) { grid = -1; return; }
        if (hipFuncSetAttribute((const void*)mega_fwd, hipFuncAttributeMaxDynamicSharedMemorySize, LDS_BYTES) != hipSuccess) { fprintf(stderr, "kernel_launch: hipFuncSetAttribute failed\n"); grid = -1; return; }
        int per_cu = 0;
        if (hipOccupancyMaxActiveBlocksPerMultiprocessor(&per_cu, (const void*)mega_fwd, NWAVES * 64, LDS_BYTES) != hipSuccess || per_cu < 1) fprintf(stderr, "kernel_launch: occupancy query reports %d\n", per_cu);
        (void)hipGetLastError();
        if (cus != 256) { fprintf(stderr, "kernel_launch: built for 256 CUs (every workgroup owns one 256-row panel per GEMM phase); this device has %d; nothing launched\n", cus); grid = -1; return; }
        grid = cus;
    }
    if (grid < 0) return;
    if (hipMemsetAsync((char*)d_ws + WS_CTL, 0, CTL_ZERO_BYTES, stream) != hipSuccess) return;
    Args a{};
    for (int i = 0; i < 25; ++i) a.in[i] = (const float*)d_in[i];
    a.out = (float*)d_out; a.ws = (unsigned char*)d_ws;
    hipLaunchKernelGGL(mega_fwd, dim3(grid), dim3(NWAVES * 64), LDS_BYTES, stream, a);
    const hipError_t le = hipPeekAtLastError();
    if (le != hipSuccess) fprintf(stderr, "kernel_launch: launch failed: %s\n", hipGetErrorName(le));
}
```
